# Optimizing an MI355X kernel written in HIP

```python
import math
import jax, jax.numpy as jnp
from jax import lax
import numpy as np

D_MODEL = 2048
BATCH = 8
SEQ = 2048
DEPTH = 4

N_HEADS = 16
HEAD_DIM = D_MODEL // N_HEADS
D_FF = 256 * ((8 * D_MODEL // 3 + 255) // 256)
N_MIXERS = 3
Q_BLOCK = 128
REL_BUCKETS = 32
REL_MAX_DIST = 2048
DILATED_BRANCHES = ((128, 1), (512, 4), (2048, 16))
RMS_EPS = 1e-6
FFN_HALF = 0.5

kernel_name = "hybrid_fox_dilated_stickbreaking_macaron"


def rms_norm(x, g):
    xf = x.astype(jnp.float32)
    y = xf * lax.rsqrt(jnp.mean(xf * xf, axis=-1, keepdims=True) + RMS_EPS)
    return (y * g.astype(jnp.float32)).astype(x.dtype)


def swiglu(x, w_gate, w_up, w_down):
    return (jax.nn.silu(x @ w_gate) * (x @ w_up)) @ w_down


def split_heads(t):
    b, s, _ = t.shape
    return t.reshape(b, s, N_HEADS, HEAD_DIM).transpose(0, 2, 1, 3)


def merge_heads(o):
    b, h, s, dh = o.shape
    return o.transpose(0, 2, 1, 3).reshape(b, s, h * dh)


def to_query_blocks(t):
    b, h, s = t.shape[:3]
    t = t.reshape((b, h, s // Q_BLOCK, Q_BLOCK) + t.shape[3:])
    return jnp.moveaxis(t, 2, 0)


def from_query_blocks(o):
    nb, b, h, q, dh = o.shape
    return jnp.moveaxis(o, 0, 2).reshape(b, h, nb * q, dh)


def t5_bucket(dist):
    max_exact = REL_BUCKETS // 2
    d = jnp.maximum(dist, 1).astype(jnp.float32)
    large = max_exact + (jnp.log(d / max_exact) / math.log(REL_MAX_DIST / max_exact)
                         * (REL_BUCKETS - max_exact)).astype(jnp.int32)
    large = jnp.minimum(large, REL_BUCKETS - 1)
    return jnp.where(dist < max_exact, dist, large)


def forgetting_attention(h, w_in, b_f):
    proj = h @ w_in
    q, k, v = [split_heads(t) for t in jnp.split(proj[..., :3 * D_MODEL], 3, axis=-1)]
    log_f = jax.nn.log_sigmoid((proj[..., 3 * D_MODEL:] + b_f).astype(jnp.float32))
    c = jnp.cumsum(log_f, axis=1).transpose(0, 2, 1)
    seq = h.shape[1]
    nb = seq // Q_BLOCK
    scale = HEAD_DIM ** -0.5
    kpos = jnp.arange(seq)

    def block(args):
        qb, cb, n = args
        qpos = n * Q_BLOCK + jnp.arange(Q_BLOCK)
        s = jnp.einsum('bhqd,bhkd->bhqk', qb, k).astype(jnp.float32) * scale
        s = s + cb[..., :, None] - c[..., None, :]
        s = jnp.where(kpos[None, :] <= qpos[:, None], s, -jnp.inf)
        p = jax.nn.softmax(s, axis=-1).astype(v.dtype)
        return jnp.einsum('bhqk,bhkd->bhqd', p, v)

    o = lax.map(block, (to_query_blocks(q), to_query_blocks(c), jnp.arange(nb)))
    return merge_heads(from_query_blocks(o))


def dilated_branch(q, k, v, rel_bias, window, dilation):
    b, h, seq, dh = q.shape
    span = window // dilation
    length = seq // dilation
    padded = -(-length // Q_BLOCK) * Q_BLOCK
    nb = padded // Q_BLOCK

    def strided(t):
        t = t.reshape(b, h, length, dilation, dh).transpose(0, 1, 3, 2, 4)
        t = jnp.pad(t, ((0, 0), (0, 0), (0, 0), (0, padded - length), (0, 0)))
        return t.reshape(b, h, dilation, nb, Q_BLOCK, dh)

    def with_prev(t):
        prev = jnp.pad(t, ((0, 0), (0, 0), (0, 0), (1, 0), (0, 0), (0, 0)))[:, :, :, :-1]
        return jnp.concatenate([prev, t], axis=-2)

    qs = strided(q)
    kb = with_prev(strided(k))
    vb = with_prev(strided(v))
    qi = jnp.arange(Q_BLOCK)[:, None]
    kj = jnp.arange(2 * Q_BLOCK)[None, :]
    off = Q_BLOCK + qi - kj
    band = (off >= 0) & (off <= span)
    key_idx = jnp.arange(nb)[:, None, None] * Q_BLOCK - Q_BLOCK + kj[None]
    valid = band[None] & (key_idx >= 0)
    bias = rel_bias[:, t5_bucket(jnp.clip(off, 0) * dilation)].astype(jnp.float32)
    s = jnp.einsum('bhrnqd,bhrnkd->bhrnqk', qs, kb).astype(jnp.float32) * (HEAD_DIM ** -0.5)
    s = jnp.where(valid, s + bias[:, None, None], -jnp.inf)
    m = jnp.max(s, axis=-1, keepdims=True)
    e = jnp.exp(s - m)
    den = jnp.sum(e, axis=-1, keepdims=True)
    lse = (m + jnp.log(den))[..., 0]
    o = jnp.einsum('bhrnqk,bhrnkd->bhrnqd', (e / den).astype(v.dtype), vb)

    def unstride(t):
        t = t.reshape((b, h, dilation, padded) + t.shape[5:])[:, :, :, :length]
        t = jnp.swapaxes(t, 2, 3)
        return t.reshape((b, h, seq) + t.shape[4:])

    return unstride(o), unstride(lse)


def dilated_attention(h, w_in, rel_bias):
    proj = h @ w_in
    q, k, v = [split_heads(t) for t in jnp.split(proj, 3, axis=-1)]
    outs, lses = [], []
    for window, dilation in DILATED_BRANCHES:
        o, lse = dilated_branch(q, k, v, rel_bias, window, dilation)
        outs.append(o)
        lses.append(lse)
    weights = jax.nn.softmax(jnp.stack(lses, axis=0), axis=0)
    o = sum(weights[g][..., None].astype(v.dtype) * outs[g] for g in range(len(outs)))
    return merge_heads(o)


def stick_breaking_attention(h, w_in):
    proj = h @ w_in
    q, k, v = [split_heads(t) for t in jnp.split(proj, 3, axis=-1)]
    seq = h.shape[1]
    nb = seq // Q_BLOCK
    scale = HEAD_DIM ** -0.5
    kpos = jnp.arange(seq)

    def block(args):
        qb, n = args
        qpos = n * Q_BLOCK + jnp.arange(Q_BLOCK)
        z = jnp.einsum('bhqd,bhkd->bhqk', qb, k).astype(jnp.float32) * scale
        causal = kpos[None, :] < qpos[:, None]
        log_beta = jax.nn.log_sigmoid(z)
        log_one_minus = jnp.where(causal, jax.nn.log_sigmoid(-z), 0.0)
        after = lax.cumsum(log_one_minus, axis=3, reverse=True) - log_one_minus
        a = jnp.where(causal, jnp.exp(log_beta + after), 0.0)
        return jnp.einsum('bhqk,bhkd->bhqd', a.astype(v.dtype), v)

    o = lax.map(block, (to_query_blocks(q), jnp.arange(nb)))
    return merge_heads(from_query_blocks(o))


def setup_inputs(seed: int = 0) -> dict:
    key = jax.random.key(seed)
    ks = jax.random.split(key, 14)
    f32 = jnp.float32
    D, F, H = D_MODEL, D_FF, N_HEADS

    def dense(k, shape, fan_in):
        return jax.random.normal(k, shape, f32) * fan_in ** -0.5

    return {
        "x": jax.random.normal(ks[0], (BATCH, SEQ, D), f32),
        "norm_g": 1.0 + 0.05 * jax.random.normal(ks[1], (DEPTH, 3, D), f32),
        "ffn_w_gate": dense(ks[2], (DEPTH, 2, D, F), D),
        "ffn_w_up": dense(ks[3], (DEPTH, 2, D, F), D),
        "ffn_w_down": dense(ks[4], (DEPTH, 2, F, D), F),
        "w_in_0": dense(ks[5], (D, 3 * D + H), D),
        "b_f_0": 2.0 + 0.1 * jax.random.normal(ks[6], (H,), f32),
        "w_in_1": dense(ks[7], (D, 3 * D), D),
        "w_in_2": dense(ks[8], (D, 3 * D), D),
        "w_in_3": dense(ks[9], (D, 3 * D + H), D),
        "b_f_3": 2.0 + 0.1 * jax.random.normal(ks[10], (H,), f32),
        "w_out": dense(ks[11], (DEPTH, D, D), D),
        "rel_bias": 0.5 * jax.random.normal(ks[12], (H, REL_BUCKETS), f32),
        "final_g": 1.0 + 0.05 * jax.random.normal(ks[13], (D,), f32),
    }


def reference(x, norm_g, ffn_w_gate, ffn_w_up, ffn_w_down, w_in_0, b_f_0, w_in_1, w_in_2,
              w_in_3, b_f_3, w_out, rel_bias, final_g):
    w_ins = (w_in_0, w_in_1, w_in_2, w_in_3)
    forget_biases = {0: b_f_0, 3: b_f_3}
    for i in range(DEPTH):
        x = x + FFN_HALF * swiglu(rms_norm(x, norm_g[i, 0]),
                                  ffn_w_gate[i, 0], ffn_w_up[i, 0], ffn_w_down[i, 0])
        h = rms_norm(x, norm_g[i, 1])
        mixer = i % N_MIXERS
        if mixer == 0:
            m = forgetting_attention(h, w_ins[i], forget_biases[i])
        elif mixer == 1:
            m = dilated_attention(h, w_ins[i], rel_bias)
        else:
            m = stick_breaking_attention(h, w_ins[i])
        x = x + m @ w_out[i]
        x = x + FFN_HALF * swiglu(rms_norm(x, norm_g[i, 2]),
                                  ffn_w_gate[i, 1], ffn_w_up[i, 1], ffn_w_down[i, 1])
    return rms_norm(x, final_g)
```

```cpp
#include <hip/hip_runtime.h>
#include <cstdio>
#include <cstdint>

#ifndef MK_ONE_LAUNCH
#define MK_ONE_LAUNCH 1
#endif

namespace pg8 {
#define PG8_LAS __attribute__((address_space(3)))
typedef unsigned short bf16_t;
typedef short bf16x8 __attribute__((ext_vector_type(8)));
typedef float f32x4 __attribute__((ext_vector_type(4)));
typedef unsigned u32x4 __attribute__((ext_vector_type(4)));
constexpr int BM = 256, BK = 64, HALF = 128, HTB = HALF * BK * 2, STAGE_BYTES = 8 * HTB, NXCD = 8, WGM = 8;

__host__ __device__ __forceinline__ int lds_byte(int r, int c) { const int st = (r >> 4) * 2 + (c >> 5), rr = r & 15, cc = c & 31, ob = rr * 64 + cc * 2; return st * 1024 + (ob ^ (((ob >> 9) & 1) << 5)); }
__host__ __device__ __forceinline__ void stage_rc(int b, int& R, int& C) { const int st = b / 1024, sb = b % 1024, swz = sb ^ (((sb >> 9) & 1) << 5); R = (st >> 1) * 16 + swz / 64; C = (st & 1) * 32 + (swz % 64) / 2; }
__host__ __device__ __forceinline__ int perm32(int rho) { const int n = rho >> 4, i = rho & 15; return 8 * (i >> 2) + 4 * n + (i & 3); }

struct Unit { int pm, pn; };
struct Gemm { const bf16_t* A; const bf16_t* Bt; int M, N, K; };

struct StaticOrder {
    int nM, nN, nwg, G, c;
    __host__ __device__ void init(int M, int N, int G_, int c_) { nM = M / BM; nN = N / BM; nwg = nM * nN; G = G_; c = c_; }
    __host__ __device__ bool next(int i, Unit& u) const {
        const long L = (long)i * G + c; if (L >= nwg) return false;
        int wgid = (int)L; { const int q = nwg / NXCD, r = nwg % NXCD, xcd = wgid % NXCD, off = wgid / NXCD; wgid = (xcd < r ? xcd * (q + 1) : r * (q + 1) + (xcd - r) * q) + off; }
        const int nig = WGM * nN, gid = wgid / nig, fm = gid * WGM, gsz = (nM - fm) < WGM ? (nM - fm) : WGM;
        u.pm = fm + ((wgid % nig) % gsz); u.pn = (wgid % nig) / gsz; return true;
    }
    __device__ __forceinline__ void a_ready(const Unit&) const {}
    __device__ __forceinline__ void done(const Unit&) const {}
};

__device__ __forceinline__ unsigned cvt_pk_bf16(float lo, float hi) { unsigned r; asm volatile("v_cvt_pk_bf16_f32 %0, %1, %2" : "=v"(r) : "v"(lo), "v"(hi)); return r; }

struct EpiBf16 {
    static constexpr bool PERM = true, AFTER_DRAIN = false;
    bf16_t* O; int ldc;
    __device__ __forceinline__ void operator()(const f32x4 (&acc)[2][2][4][2], const Unit& u, int wr, int wc, int fr, int fq) const {
        const int row0 = u.pm * BM + wr * 64 + fr, col0 = u.pn * BM + wc * 32 + 8 * fq;
#pragma unroll
        for (int ai = 0; ai < 2; ++ai)
#pragma unroll
            for (int m = 0; m < 4; ++m) { bf16_t* rowp = O + (size_t)(row0 + ai * HALF + m * 16) * ldc + col0;
#pragma unroll
                for (int bj = 0; bj < 2; ++bj) { const f32x4 v0 = acc[ai][bj][m][0], v1 = acc[ai][bj][m][1];
                    u32x4 w; w.x = cvt_pk_bf16(v0[0], v0[1]); w.y = cvt_pk_bf16(v0[2], v0[3]); w.z = cvt_pk_bf16(v1[0], v1[1]); w.w = cvt_pk_bf16(v1[2], v1[3]);
                    *(u32x4*)(rowp + bj * HALF) = w; } }
    }
};
__device__ __forceinline__ float silu_mul(float g, float u) { const float e = __builtin_amdgcn_exp2f(g * -1.4426950408889634f); return g * __builtin_amdgcn_rcpf(1.0f + e) * u; }
struct EpiSwiGLU {
    static constexpr bool PERM = true, AFTER_DRAIN = false;
    bf16_t* O; int ldc;
    __device__ __forceinline__ void operator()(const f32x4 (&acc)[2][2][4][2], const Unit& u, int wr, int wc, int fr, int fq) const {
        const int row0 = u.pm * BM + wr * 64 + fr, col0 = u.pn * HALF + wc * 32 + 8 * fq;
#pragma unroll
        for (int ai = 0; ai < 2; ++ai)
#pragma unroll
            for (int m = 0; m < 4; ++m) { bf16_t* rowp = O + (size_t)(row0 + ai * HALF + m * 16) * ldc + col0;
                const f32x4 g0 = acc[ai][0][m][0], g1 = acc[ai][0][m][1], u0 = acc[ai][1][m][0], u1 = acc[ai][1][m][1];
                u32x4 w; w.x = cvt_pk_bf16(silu_mul(g0[0], u0[0]), silu_mul(g0[1], u0[1])); w.y = cvt_pk_bf16(silu_mul(g0[2], u0[2]), silu_mul(g0[3], u0[3]));
                w.z = cvt_pk_bf16(silu_mul(g1[0], u1[0]), silu_mul(g1[1], u1[1])); w.w = cvt_pk_bf16(silu_mul(g1[2], u1[2]), silu_mul(g1[3], u1[3]));
                *(u32x4*)rowp = w; }
    }
};
struct EpiResid {
    static constexpr bool PERM = false, AFTER_DRAIN = false;
    const float* base; float* out; int ldc; float alpha;
    __device__ __forceinline__ void operator()(const f32x4 (&acc)[2][2][4][2], const Unit& u, int wr, int wc, int fr, int fq) const {
        const int row0 = u.pm * BM + wr * 64 + fr, col0 = u.pn * BM + wc * 32 + 4 * fq;
#pragma unroll
        for (int ai = 0; ai < 2; ++ai)
#pragma unroll
            for (int m = 0; m < 4; ++m) { const size_t off = (size_t)(row0 + ai * HALF + m * 16) * ldc + col0;
#pragma unroll
                for (int bj = 0; bj < 2; ++bj)
#pragma unroll
                    for (int n = 0; n < 2; ++n) { const f32x4 bs = *(const f32x4*)(base + off + bj * HALF + n * 16); *(f32x4*)(out + off + bj * HALF + n * 16) = bs + alpha * acc[ai][bj][m][n]; }
                if (m & 1) asm volatile("" ::: "memory"); }
    }
};

template <class Epi, class Sched, bool ALIGN_EPI = false, bool SP2 = false>
__device__ __forceinline__ void gemm_phase(PG8_LAS unsigned char* lds, const Gemm g, const Sched& S, const Epi& E) {
    int tid = threadIdx.x; asm volatile("" : "+v"(tid));
    const int wid = __builtin_amdgcn_readfirstlane(tid >> 6), lane = tid & 63, wr = wid >> 2, wc = wid & 3, fr = lane & 15, fq = lane >> 4;
    const int K = g.K, nt = K / BK;
    unsigned voffA[2], voffB[2];
#pragma unroll
    for (int i = 0; i < 2; ++i) { int R, C; stage_rc(tid * 16 + i * 8192, R, C); const int Rb = Epi::PERM ? ((R & ~31) + perm32(R & 31)) : R;
        voffA[i] = (unsigned)(R * K + C) * 2u; voffB[i] = (unsigned)(Rb * K + C) * 2u; }
    const size_t kstep = (size_t)(BK * 2);
    const size_t hstep = (size_t)HALF * K * 2;
    const size_t tstep = 2 * hstep;
    const unsigned ldsw = (unsigned)wid * 1024u;
    const int aoff = lds_byte(wr * 64 + fr, fq * 8), boff = lds_byte(wc * 32 + fr, fq * 8);
#define PG8_SA(b, h) (((b) * 2 + (h)) * HTB)
#define PG8_SB(b, h) ((4 + (b) * 2 + (h)) * HTB)
#define PG8_STAGE(bufoff, gbase, voff) do { _Pragma("unroll") for (int _i = 0; _i < 2; ++_i) \
        __builtin_amdgcn_global_load_lds((const unsigned*)((const char*)(gbase) + (voff)[_i]), (PG8_LAS unsigned*)(lds + (bufoff) + ldsw + _i * 8192), 16, 0, 0); } while (0)
#define PG8_LDA(dst, b, h) do { _Pragma("unroll") for (int m = 0; m < 4; ++m) _Pragma("unroll") for (int k = 0; k < 2; ++k) dst[m][k] = *(const PG8_LAS bf16x8*)(lds + PG8_SA(b, h) + aoff + m * 2048 + k * 1024); } while (0)
#define PG8_LDB(dst, b, h) do { _Pragma("unroll") for (int n = 0; n < 2; ++n) _Pragma("unroll") for (int k = 0; k < 2; ++k) dst[n][k] = *(const PG8_LAS bf16x8*)(lds + PG8_SB(b, h) + boff + n * 2048 + k * 1024); } while (0)
#define PG8_MMA(ai, bj, At, Bt) do { __builtin_amdgcn_s_setprio(1); _Pragma("unroll") for (int m = 0; m < 4; ++m) _Pragma("unroll") for (int n = 0; n < 2; ++n) _Pragma("unroll") for (int k = 0; k < 2; ++k) \
        acc[ai][bj][m][n] = __builtin_amdgcn_mfma_f32_16x16x32_bf16(Bt[n][k], At[m][k], acc[ai][bj][m][n], 0, 0, 0); __builtin_amdgcn_s_setprio(0); } while (0)
#define PG8_WAIT_V(n) asm volatile("s_waitcnt vmcnt(" #n ")" ::: "memory")
#define PG8_WAIT_L(n) asm volatile("s_waitcnt lgkmcnt(" #n ")" ::: "memory")
#define PG8_BAR __builtin_amdgcn_s_barrier()
#define PG8_SCHED __builtin_amdgcn_sched_barrier(0)
    Unit cur, nxt; int ui = 0;
    if (!S.next(0, cur)) return;
    f32x4 acc[2][2][4][2];
#pragma unroll
    for (int a = 0; a < 2; ++a)
#pragma unroll
        for (int b = 0; b < 2; ++b)
#pragma unroll
            for (int m = 0; m < 4; ++m)
#pragma unroll
                for (int n = 0; n < 2; ++n) acc[a][b][m][n] = (f32x4){0.f, 0.f, 0.f, 0.f};
    bf16x8 At[4][2], B0[2][2], B1[2][2];
    const char* cA = (const char*)g.A + (size_t)cur.pm * tstep; const char* cB = (const char*)g.Bt + (size_t)cur.pn * tstep;
    S.a_ready(cur);
    if constexpr (SP2) {
        PG8_STAGE(PG8_SB(0, 0), cB, voffB); PG8_STAGE(PG8_SB(0, 1), cB + hstep, voffB); PG8_STAGE(PG8_SA(0, 0), cA, voffA); PG8_STAGE(PG8_SA(0, 1), cA + hstep, voffA);
        if (wr == 1) PG8_BAR;
        PG8_WAIT_V(2); PG8_BAR;
        PG8_STAGE(PG8_SB(1, 0), cB + kstep, voffB); PG8_STAGE(PG8_SA(1, 0), cA + kstep, voffA); PG8_STAGE(PG8_SB(1, 1), cB + hstep + kstep, voffB);
        PG8_WAIT_V(6); PG8_BAR;
    } else {
        PG8_STAGE(PG8_SB(0, 0), cB, voffB); PG8_STAGE(PG8_SA(0, 0), cA, voffA); PG8_STAGE(PG8_SB(0, 1), cB + hstep, voffB); PG8_STAGE(PG8_SA(0, 1), cA + hstep, voffA);
        if (wr == 1) PG8_BAR;
        PG8_WAIT_V(4); PG8_BAR;
        PG8_STAGE(PG8_SB(1, 0), cB + kstep, voffB); PG8_STAGE(PG8_SA(1, 0), cA + kstep, voffA); PG8_STAGE(PG8_SB(1, 1), cB + hstep + kstep, voffB);
        PG8_WAIT_V(6); PG8_BAR;
    }
    for (;;) {
        const bool has_next = S.next(ui + 1, nxt);
        const char* nA = has_next ? (const char*)g.A + (size_t)nxt.pm * tstep : cA; const char* nB = has_next ? (const char*)g.Bt + (size_t)nxt.pn * tstep : cB;
        for (int t = 0; t < nt; t += 2) {
            const bool last = (t == nt - 2);
            const char* a1 = cA + (size_t)(t + 1) * kstep;
            const char* a2 = last ? nA : cA + (size_t)(t + 2) * kstep; const char* b2 = last ? nB : cB + (size_t)(t + 2) * kstep;
            const char* a3 = a2 + kstep; const char* b3 = b2 + kstep;
            if (last && has_next) S.a_ready(nxt);
            if constexpr (SP2) {
            PG8_LDB(B0, 0, 0); PG8_LDB(B1, 0, 1); PG8_SCHED; PG8_LDA(At, 0, 0); PG8_STAGE(PG8_SA(1, 1), a1 + hstep, voffA);
            PG8_WAIT_V(8); PG8_WAIT_L(0); PG8_BAR; PG8_MMA(0, 0, At, B0); PG8_MMA(0, 1, At, B1); PG8_BAR; PG8_SCHED;
            PG8_LDA(At, 0, 1); PG8_STAGE(PG8_SB(0, 0), b2, voffB); PG8_STAGE(PG8_SB(0, 1), b2 + hstep, voffB); PG8_STAGE(PG8_SA(0, 0), a2, voffA);
            PG8_WAIT_V(8); PG8_WAIT_L(0); PG8_BAR; PG8_MMA(1, 0, At, B0); PG8_MMA(1, 1, At, B1); PG8_BAR; PG8_SCHED;
            PG8_LDB(B0, 1, 0); PG8_LDB(B1, 1, 1); PG8_SCHED; PG8_LDA(At, 1, 0); PG8_STAGE(PG8_SA(0, 1), a2 + hstep, voffA);
            PG8_WAIT_V(8); PG8_WAIT_L(0); PG8_BAR; PG8_MMA(0, 0, At, B0); PG8_MMA(0, 1, At, B1); PG8_BAR; PG8_SCHED;
            PG8_LDA(At, 1, 1); PG8_STAGE(PG8_SB(1, 0), b3, voffB); PG8_STAGE(PG8_SB(1, 1), b3 + hstep, voffB); PG8_STAGE(PG8_SA(1, 0), a3, voffA);
            PG8_WAIT_V(8); PG8_WAIT_L(0); PG8_BAR; PG8_MMA(1, 0, At, B0); PG8_MMA(1, 1, At, B1); PG8_BAR; PG8_SCHED;
            } else {
            PG8_LDB(B0, 0, 0); PG8_SCHED; PG8_LDA(At, 0, 0); PG8_STAGE(PG8_SA(1, 1), a1 + hstep, voffA);
            PG8_WAIT_L(8); PG8_BAR; PG8_WAIT_L(0); PG8_MMA(0, 0, At, B0); PG8_BAR; PG8_SCHED;
            PG8_LDB(B1, 0, 1); PG8_STAGE(PG8_SB(0, 0), b2, voffB);
            PG8_BAR; PG8_WAIT_L(0); PG8_MMA(0, 1, At, B1); PG8_BAR;
            PG8_LDA(At, 0, 1); PG8_STAGE(PG8_SA(0, 0), a2, voffA);
            PG8_BAR; PG8_WAIT_L(0); PG8_MMA(1, 0, At, B0); PG8_BAR; PG8_SCHED;
            PG8_STAGE(PG8_SB(0, 1), b2 + hstep, voffB);
            PG8_WAIT_V(6); PG8_BAR; PG8_MMA(1, 1, At, B1); PG8_BAR;
            PG8_LDB(B0, 1, 0); PG8_SCHED; PG8_LDA(At, 1, 0); PG8_STAGE(PG8_SA(0, 1), a2 + hstep, voffA);
            PG8_WAIT_L(8); PG8_BAR; PG8_WAIT_L(0); PG8_MMA(0, 0, At, B0); PG8_BAR; PG8_SCHED;
            PG8_LDB(B1, 1, 1); PG8_STAGE(PG8_SB(1, 0), b3, voffB);
            PG8_BAR; PG8_WAIT_L(0); PG8_MMA(0, 1, At, B1); PG8_BAR;
            PG8_LDA(At, 1, 1); PG8_STAGE(PG8_SA(1, 0), a3, voffA);
            PG8_BAR; PG8_WAIT_L(0); PG8_MMA(1, 0, At, B0); PG8_BAR; PG8_SCHED;
            PG8_STAGE(PG8_SB(1, 1), b3 + hstep, voffB);
            PG8_WAIT_V(6); PG8_BAR; PG8_MMA(1, 1, At, B1); PG8_BAR;
            }
        }
        if constexpr (ALIGN_EPI) { if (wr == 0) PG8_BAR; }
        if constexpr (!Epi::AFTER_DRAIN) { E(acc, cur, wr, wc, fr, fq); S.done(cur); }
        if (!has_next) break;
#pragma unroll
        for (int a = 0; a < 2; ++a)
#pragma unroll
            for (int b = 0; b < 2; ++b)
#pragma unroll
                for (int m = 0; m < 4; ++m)
#pragma unroll
                    for (int n = 0; n < 2; ++n) acc[a][b][m][n] = (f32x4){0.f, 0.f, 0.f, 0.f};
        cur = nxt; cA = nA; cB = nB; ++ui;
        if constexpr (ALIGN_EPI) { if (wr == 1) PG8_BAR; }
    }
    PG8_WAIT_V(0);
    if constexpr (!ALIGN_EPI) { if (wr == 0) PG8_BAR; }
    PG8_BAR;
#undef PG8_SA
#undef PG8_SB
#undef PG8_STAGE
#undef PG8_LDA
#undef PG8_LDB
#undef PG8_MMA
#undef PG8_WAIT_V
#undef PG8_WAIT_L
#undef PG8_BAR
#undef PG8_SCHED
}
}

constexpr int DM = 2048, NBATCH = 8, SEQ = 2048, DEPTH = 4, NH = 16, HD = 128, FF = 5632;
constexpr int M = NBATCH * SEQ;
constexpr int NGU = 2 * FF, NQKV = 3 * DM;
constexpr float RMS_EPS = 1e-6f;
constexpr int NWAVES = 8;

constexpr size_t MiB = 1u << 20;
constexpr size_t WS_CTL = 0, CTL_ZERO_BYTES = 1 * MiB;
constexpr size_t WS_LF = 1 * MiB;
constexpr size_t WS_WGU = 2 * MiB;
constexpr size_t SZ_WGU = (size_t)NGU * DM * 2;
constexpr size_t WS_WD = WS_WGU + 8 * SZ_WGU;
constexpr size_t SZ_WD = (size_t)DM * FF * 2;
constexpr size_t WS_WQKV = WS_WD + 8 * SZ_WD;
constexpr size_t SZ_WQKV = (size_t)NQKV * DM * 2;
constexpr size_t WS_WO = WS_WQKV + 4 * SZ_WQKV;
constexpr size_t SZ_WO = (size_t)DM * DM * 2;
constexpr size_t WS_H = WS_WO + 4 * SZ_WO;
constexpr size_t WS_AO = WS_H + (size_t)M * DM * 2;
constexpr size_t WS_ACT = WS_AO + (size_t)M * DM * 2;
constexpr size_t WS_END = WS_ACT + (size_t)M * NQKV * 2;
static_assert(WS_WGU % 256 == 0 && WS_WD % 256 == 0 && WS_WQKV % 256 == 0 && WS_WO % 256 == 0 && WS_H % 256 == 0 && WS_ACT % 256 == 0, "alignment");

constexpr int CW_TMO = 0;
constexpr int CW_BAR = 4096;

constexpr int RING_OFF = 0, RING_BYTES = 131072;
constexpr int LDS_BYTES = 147456;
constexpr int MISC_OFF = LDS_BYTES - 256;

#define GAS __attribute__((address_space(1)))
#define LAS __attribute__((address_space(3)))
typedef unsigned short bf16;
typedef unsigned v4u __attribute__((ext_vector_type(4)));
typedef unsigned v2u __attribute__((ext_vector_type(2)));
typedef float f32x4 __attribute__((ext_vector_type(4)));
typedef float f32x16 __attribute__((ext_vector_type(16)));
typedef short bf16x8 __attribute__((ext_vector_type(8)));
typedef short s16x4 __attribute__((ext_vector_type(4)));
typedef GAS unsigned gu32;
#define RLX_AGENT __ATOMIC_RELAXED, __HIP_MEMORY_SCOPE_AGENT
#define LDS_WAIT() asm volatile("s_waitcnt lgkmcnt(0)" ::: "memory")
#define VM_WAIT() asm volatile("s_waitcnt vmcnt(0)" ::: "memory")
__device__ __forceinline__ unsigned cvtpk(float lo, float hi) { unsigned r; asm volatile("v_cvt_pk_bf16_f32 %0, %1, %2" : "=v"(r) : "v"(lo), "v"(hi)); return r; }

#define XB_TMO      128
#define XB_XCNT(j)  (256  + 64 * (j))
#define XB_XSUB(j)  (1280 + 64 * (j))
#define XB_XGEN(j)  (2304 + 64 * (j))
#define XB_TOP      3328
#define XB_TOPGEN   3392
#define XCD_BAR_WORDS 3456
#define XB_SPIN_CAP (1u << 18)
__device__ __forceinline__ unsigned xb_ld(unsigned* p)              { return __hip_atomic_load(p, __ATOMIC_RELAXED, __HIP_MEMORY_SCOPE_AGENT); }
__device__ __forceinline__ unsigned xb_add(unsigned* p, unsigned v) { return __hip_atomic_fetch_add(p, v, __ATOMIC_RELAXED, __HIP_MEMORY_SCOPE_AGENT); }
__device__ __forceinline__ unsigned xb_xcc_id() { return (unsigned)__builtin_amdgcn_s_getreg((3 << 11) | 20) & 0xFu; }
#define XB_SPIN(cond, bar) do { unsigned _sp = 0; while (cond) { __builtin_amdgcn_s_sleep(1); \
    if ((++_sp & 255u) == 0u) { if (xb_ld(&(bar)[XB_TMO])) break; if (_sp > XB_SPIN_CAP) { atomicAdd(&(bar)[XB_TMO], 1u); break; } } } } while (0)
struct XcdBarrier { unsigned* bar; unsigned x; volatile LAS unsigned* st; };
__device__ __forceinline__ XcdBarrier xcd_barrier_post(unsigned* bar, volatile LAS unsigned* st) {
    XcdBarrier b; b.bar = bar; b.x = xb_xcc_id(); b.st = st;
    if (threadIdx.x == 0) (void)xb_add(&bar[XB_XCNT(b.x)], 1u);
    return b;
}
__device__ __forceinline__ void xcd_barrier_complete(unsigned* bar, unsigned x, unsigned& nloc, unsigned& nx) {
    const unsigned G = gridDim.x * gridDim.y * gridDim.z;
    unsigned sum, cnt, mine, sp = 0u;
    for (;;) {
        sum = 0u; cnt = 0u; mine = 0u;
#pragma unroll
        for (unsigned j = 0; j < 16; ++j) { const unsigned c = xb_ld(&bar[XB_XCNT(j)]); sum += c; cnt += (c > 0u) ? 1u : 0u; mine = (j == x) ? c : mine; }
        if (sum == G) break;
        __builtin_amdgcn_s_sleep(1);
        if ((++sp & 255u) == 0u) { if (xb_ld(&bar[XB_TMO])) break; if (sp > XB_SPIN_CAP) { atomicAdd(&bar[XB_TMO], 1u); break; } }
    }
    nloc = mine > 0u ? mine : 1u; nx = cnt > 0u ? cnt : 1u;
}
__device__ __forceinline__ void xcd_barrier(const XcdBarrier& b) {
    asm volatile("s_waitcnt vmcnt(0)" ::: "memory");
    __syncthreads();
    if (threadIdx.x == 0) {
        unsigned* bar = b.bar;
        __builtin_amdgcn_s_waitcnt(0);
        unsigned nloc = b.st[0], nx = b.st[1];
        if (nloc == 0u) { xcd_barrier_complete(bar, b.x, nloc, nx); b.st[0] = nloc; b.st[1] = nx; }
        const unsigned old = xb_add(&bar[XB_XSUB(b.x)], 1u);
        const unsigned gen = old / nloc;
        if (old + 1u == (gen + 1u) * nloc) {
            __builtin_amdgcn_fence(__ATOMIC_RELEASE, "agent");
            asm volatile("s_waitcnt vmcnt(0)" ::: "memory");
            const unsigned og = xb_add(&bar[XB_TOP], 1u);
            const unsigned tg = og / nx;
            if (og + 1u == (tg + 1u) * nx) xb_add(&bar[XB_TOPGEN], 1u);
            else XB_SPIN(xb_ld(&bar[XB_TOPGEN]) == tg, bar);
            __builtin_amdgcn_fence(__ATOMIC_ACQUIRE, "agent");
            xb_add(&bar[XB_XGEN(b.x)], 1u);
            asm volatile("s_waitcnt vmcnt(0)" ::: "memory");
        } else {
            XB_SPIN(xb_ld(&bar[XB_XGEN(b.x)]) == gen, bar);
            __builtin_amdgcn_fence(__ATOMIC_ACQUIRE, "agent");
            asm volatile("s_waitcnt vmcnt(0)" ::: "memory");
        }
    }
    __syncthreads();
}

__device__ __forceinline__ int opaque_tid() { int t = threadIdx.x; asm volatile("" : "+v"(t)); return t; }
__device__ __forceinline__ float wave_sum(float v) {
#pragma unroll
    for (int o = 1; o < 64; o <<= 1) v += __shfl_xor(v, o);
    return v;
}

__device__ __forceinline__ void transpose_item(const float* __restrict__ W, int ldw, int Kdim, bf16* __restrict__ WT, int k0, int n0, int drow0, LAS float* scr, int lane) {
    const int nl = (lane & 15) * 4, kl = lane >> 4;
    f32x4 v[16];
#pragma unroll
    for (int i = 0; i < 16; ++i) v[i] = *(const GAS f32x4*)(W + (size_t)(k0 + 4 * i + kl) * ldw + n0 + nl);
#pragma unroll
    for (int i = 0; i < 16; ++i) { LAS float* s = scr + (4 * i + kl) * 65 + nl; s[0] = v[i].x; s[1] = v[i].y; s[2] = v[i].z; s[3] = v[i].w; }
    LDS_WAIT(); asm volatile("" ::: "memory");
    const int c = lane & 7;
#pragma unroll
    for (int j = 0; j < 8; ++j) { const int n = (lane >> 3) + 8 * j; const LAS float* s = scr + (8 * c) * 65 + n;
        v4u o; o.x = cvtpk(s[0 * 65], s[1 * 65]); o.y = cvtpk(s[2 * 65], s[3 * 65]); o.z = cvtpk(s[4 * 65], s[5 * 65]); o.w = cvtpk(s[6 * 65], s[7 * 65]);
        *(GAS v4u*)(WT + (size_t)(drow0 + n) * Kdim + k0 + 8 * c) = o; }
    LDS_WAIT(); asm volatile("" ::: "memory");
}

namespace att {
constexpr int D = 128, NW = 8, QBLK = 32, KVBLK = 64, QB = 256;
constexpr int SHM_K = KVBLK * D * 2, SHM_V = KVBLK * D * 2;
constexpr int L_V = 0, L_K = 2 * SHM_V, L_WS = L_K + 2 * SHM_K, L_TAB = L_WS + NW * 64 * 4, L_SCAN = L_TAB + 2304 * 4, L_END = L_SCAN + 64;
constexpr int TAB_N = 2304;
constexpr int QPITCH = NQKV, OPITCH = DM;
constexpr float SCALE = 0.08838834764831845f;
constexpr float C2 = 1.4426950408889634f * SCALE;
constexpr float THR = 8.f;

#define KSWZ(row, colB) ((row) * 256 + ((colB) ^ (((row) & 7) << 4)))
#define SBAR() __builtin_amdgcn_sched_barrier(0)
__device__ __forceinline__ int v_st(int k, int c) { const int kk = (k & ~0xC) | ((k & 4) << 1) | ((k & 8) >> 1); return ((kk >> 3) * 4 + (c >> 5)) * 512 + ((kk & 7) * 32 + (c & 31)) * 2; }
__device__ __forceinline__ int v_rd_base(int lane) { return ((lane & 3) << 3) | (((lane >> 2) & 3) << 6) | (((lane >> 4) & 1) << 5) | (((lane >> 5) & 1) << 8); }
constexpr int v_rd_off(int d0, int ks, int half) { return d0 * 512 + ks * 4096 + half * 2048; }
__device__ __forceinline__ int crow(int r, int hi) { return (r & 3) + 8 * (r >> 2) + 4 * hi; }

template <bool STRICT>
__device__ __forceinline__ void mask_tile(f32x16& p0, f32x16& p1, int dq) {
    const float NEG = -__builtin_inff();
    const int lim = STRICT ? 1 : 0;
#pragma unroll
    for (int r = 0; r < 16; ++r) {
        const int c = (r & 3) + 8 * (r >> 2);
        if (dq - c < lim) p0[r] = NEG;
        if (dq - c - 32 < lim) p1[r] = NEG;
    }
}
__device__ __forceinline__ void partialSM(f32x16& p0, f32x16& p1, float& m_reg, float& mn, float& alpha) {
    float pmax = p0[0];
#pragma unroll
    for (int r = 1; r < 16; ++r) pmax = fmaxf(pmax, p0[r]);
#pragma unroll
    for (int r = 0; r < 16; ++r) pmax = fmaxf(pmax, p1[r]);
    { auto rr = __builtin_amdgcn_permlane32_swap(__float_as_uint(pmax), __float_as_uint(pmax), false, false);
      pmax = fmaxf(__uint_as_float(rr[0]), __uint_as_float(rr[1])); }
    if (__builtin_expect(__all((pmax - m_reg) * SCALE <= THR), 1)) { mn = m_reg; alpha = 1.f; }
    else { mn = fmaxf(m_reg, pmax); alpha = __builtin_amdgcn_exp2f((m_reg - mn) * C2); m_reg = mn; }
    const float mnL = -mn * C2;
#pragma unroll
    for (int r = 0; r < 16; ++r) p0[r] = fmaf(p0[r], C2, mnL);
#pragma unroll
    for (int r = 0; r < 16; ++r) p1[r] = fmaf(p1[r], C2, mnL);
#pragma unroll
    for (int r = 0; r < 16; ++r) p0[r] = __builtin_amdgcn_exp2f(p0[r]);
}
#define PK4(P, B_, OUT) do { unsigned a0 = cvtpk(P[B_+0], P[B_+1]), a1 = cvtpk(P[B_+2], P[B_+3]);                          \
        unsigned b0 = cvtpk(P[B_+4], P[B_+5]), b1 = cvtpk(P[B_+6], P[B_+7]);                                             \
        auto r0 = __builtin_amdgcn_permlane32_swap(a0, b0, false, false); auto r1 = __builtin_amdgcn_permlane32_swap(a1, b1, false, false); \
        v4u w = {r0[0], r1[0], r0[1], r1[1]}; OUT = __builtin_bit_cast(bf16x8, w); } while (0)
__device__ __forceinline__ void finishSM(f32x16& p0, f32x16& p1, float alpha, float& l_reg, bf16x8& pa0, bf16x8& pa1, bf16x8& pa2, bf16x8& pa3) {
#pragma unroll
    for (int r = 0; r < 16; ++r) p1[r] = __builtin_amdgcn_exp2f(p1[r]);
    float ps = 0;
#pragma unroll
    for (int r = 0; r < 16; ++r) ps += p0[r];
#pragma unroll
    for (int r = 0; r < 16; ++r) ps += p1[r];
    { auto rr = __builtin_amdgcn_permlane32_swap(__float_as_uint(ps), __float_as_uint(ps), false, false);
      ps = __uint_as_float(rr[0]) + __uint_as_float(rr[1]); }
    l_reg = l_reg * alpha + ps;
    PK4(p0, 0, pa0); PK4(p0, 8, pa1); PK4(p1, 0, pa2); PK4(p1, 8, pa3);
}
template <int KB>
__device__ __forceinline__ void qkt(f32x16& p0, f32x16& p1, const LAS char* K_lds, int r32, int hi, const bf16x8* qr) {
    const LAS char* kb[4];
#pragma unroll
    for (int dd = 0; dd < 4; ++dd) kb[dd] = K_lds + KB * SHM_K + KSWZ(r32, (dd * 16 + hi * 8) * 2);
#pragma unroll
    for (int d0 = 0; d0 < 8; ++d0) { const LAS char* a = kb[d0 & 3] + (d0 >> 2) * 128;
        bf16x8 b0 = *reinterpret_cast<const LAS bf16x8*>(a);
        bf16x8 b1 = *reinterpret_cast<const LAS bf16x8*>(a + 32 * 256);
        p0 = __builtin_amdgcn_mfma_f32_32x32x16_bf16(b0, qr[d0], p0, 0, 0, 0);
        p1 = __builtin_amdgcn_mfma_f32_32x32x16_bf16(b1, qr[d0], p1, 0, 0, 0); }
}
template <int VB>
__device__ __forceinline__ void pv_tile(f32x16* o, int vb0, bf16x8 pa0, bf16x8 pa1, bf16x8 pa2, bf16x8 pa3) {
#define TRRD(dst, off) asm volatile("ds_read_b64_tr_b16 %0, %1 offset:%2" : "=&v"(dst) : "v"(vb0), "i"(off) : "memory")
#define PV_D0(d0) do { s16x4 l0, l1, l2, l3, h0, h1, h2, h3; constexpr int b_ = VB * SHM_V + v_rd_off(d0, 0, 0); \
        TRRD(l0, b_); TRRD(h0, b_ + 2048); TRRD(l1, b_ + 4096); TRRD(h1, b_ + 6144); TRRD(l2, b_ + 8192); TRRD(h2, b_ + 10240); TRRD(l3, b_ + 12288); TRRD(h3, b_ + 14336); \
        asm volatile("s_waitcnt lgkmcnt(0)" ::: "memory"); SBAR();   \
        o[d0] = __builtin_amdgcn_mfma_f32_32x32x16_bf16(pa0, (bf16x8){l0[0], l0[1], l0[2], l0[3], h0[0], h0[1], h0[2], h0[3]}, o[d0], 0, 0, 0);   \
        o[d0] = __builtin_amdgcn_mfma_f32_32x32x16_bf16(pa1, (bf16x8){l1[0], l1[1], l1[2], l1[3], h1[0], h1[1], h1[2], h1[3]}, o[d0], 0, 0, 0);   \
        o[d0] = __builtin_amdgcn_mfma_f32_32x32x16_bf16(pa2, (bf16x8){l2[0], l2[1], l2[2], l2[3], h2[0], h2[1], h2[2], h2[3]}, o[d0], 0, 0, 0);   \
        o[d0] = __builtin_amdgcn_mfma_f32_32x32x16_bf16(pa3, (bf16x8){l3[0], l3[1], l3[2], l3[3], h3[0], h3[1], h3[2], h3[3]}, o[d0], 0, 0, 0); } while (0)
    PV_D0(0); PV_D0(1); PV_D0(2); PV_D0(3);
#undef PV_D0
#undef TRRD
}
__device__ __forceinline__ float suffix32(const f32x16& x, f32x16& aft, float base, int hi) {
    float c0[4], c1[4];
#pragma unroll
    for (int g = 0; g < 4; ++g) { const float c = (x[4 * g] + x[4 * g + 1]) + (x[4 * g + 2] + x[4 * g + 3]);
        auto rr = __builtin_amdgcn_permlane32_swap(__float_as_uint(c), __float_as_uint(c), false, false);
        c0[g] = __uint_as_float(rr[0]); c1[g] = __uint_as_float(rr[1]); }
    float s = base;
#pragma unroll
    for (int g = 3; g >= 0; --g) { const float sx1 = s; s += c1[g]; const float sx0 = s; s += c0[g];
        const float sx = hi ? sx1 : sx0;
        aft[4 * g + 3] = sx; aft[4 * g + 2] = aft[4 * g + 3] + x[4 * g + 3]; aft[4 * g + 1] = aft[4 * g + 2] + x[4 * g + 2]; aft[4 * g] = aft[4 * g + 1] + x[4 * g + 1]; }
    return s;
}

template <int MODE>
__device__ __forceinline__ void attn_block(const bf16* __restrict__ Qb, const bf16* __restrict__ Kh, const bf16* __restrict__ Vh, bf16* __restrict__ Ob, int P0, LAS char* lds, int toff_mul, int toff_add) {
    int tid = threadIdx.x; asm volatile("" : "+v"(tid));
    const int wid = __builtin_amdgcn_readfirstlane(tid >> 6), lane = tid & 63, r32 = lane & 31, hi = lane >> 5;
    LAS char* V_lds = lds + L_V; LAS char* K_lds = lds + L_K;
    LAS float* wsf = (LAS float*)(lds + L_WS) + wid * 64; LAS float* li_l = wsf; LAS float* al_l = wsf + 32;
    const LAS float* tab = (const LAS float*)(lds + L_TAB);
    bf16x8 qr[8];
    { const bf16* qrow = Qb + (size_t)(wid * QBLK + r32) * QPITCH + hi * 8;
#pragma unroll
      for (int d0 = 0; d0 < 8; ++d0) qr[d0] = *(const GAS bf16x8*)(qrow + d0 * 16); }
    const int qlo = P0 + wid * QBLK, qpos = qlo + r32, qm = qpos - 4 * hi;
    const int NT = P0 / KVBLK + 4;
    const int sr = tid >> 4, sc = (tid & 15) * 8;
    const int kws = KSWZ(sr, sc * 2), vst0 = v_st(sr, sc), vst1 = v_st(32 + sr, sc);
    const int vb0 = (int)(unsigned)(uintptr_t)V_lds + v_rd_base(lane);
    const int tl = toff_mul * qpos + toff_add + 4 * hi;
    float m_reg = -1e30f, l_reg = 0.f, R = 0.f;
    f32x16 o[4];
#pragma unroll
    for (int d = 0; d < 4; ++d)
#pragma unroll
        for (int r = 0; r < 16; ++r) o[d][r] = 0.f;
    for (int it = 0; it < NT; ++it) {
        const int t = (MODE == 1) ? NT - 1 - it : it;
        const int kb = t * KVBLK;
        __syncthreads();
        { const bf16* kp = Kh + (size_t)(kb + sr) * QPITCH + sc; const bf16* vp = Vh + (size_t)(kb + sr) * QPITCH + sc;
          const bf16x8 k0 = *(const GAS bf16x8*)kp, k1 = *(const GAS bf16x8*)(kp + (size_t)32 * QPITCH);
          const bf16x8 v0 = *(const GAS bf16x8*)vp, v1 = *(const GAS bf16x8*)(vp + (size_t)32 * QPITCH);
          *(LAS bf16x8*)(K_lds + kws) = k0; *(LAS bf16x8*)(K_lds + kws + 32 * 256) = k1;
          *(LAS bf16x8*)(V_lds + vst0) = v0; *(LAS bf16x8*)(V_lds + vst1) = v1; }
        __syncthreads();
        if (kb <= qlo + QBLK - 1) {
            f32x16 p0, p1; bf16x8 pa0, pa1, pa2, pa3;
            if (MODE == 0) {
                const LAS float* tp = tab + (tl + kb);
#pragma unroll
                for (int r = 0; r < 16; ++r) { const int c = (r & 3) + 8 * (r >> 2); p0[r] = tp[c]; p1[r] = tp[c + 32]; }
            } else {
#pragma unroll
                for (int r = 0; r < 16; ++r) { p0[r] = 0.f; p1[r] = 0.f; }
            }
            qkt<0>(p0, p1, K_lds, r32, hi, qr);
            if (MODE == 0) {
                if (kb + KVBLK - 1 > qlo) mask_tile<false>(p0, p1, qm - kb);
                float mn, alpha;
                partialSM(p0, p1, m_reg, mn, alpha);
                if (__any(alpha < 1.f)) { if (hi == 0) al_l[r32] = alpha; LDS_WAIT();
#pragma unroll
                    for (int d_ = 0; d_ < 4; ++d_)
#pragma unroll
                        for (int r = 0; r < 16; ++r) o[d_][r] *= al_l[crow(r, hi)]; }
                finishSM(p0, p1, alpha, l_reg, pa0, pa1, pa2, pa3);
            } else {
                f32x16 x0, x1;
#pragma unroll
                for (int r = 0; r < 16; ++r) { const float y = p0[r] * C2; const float L = __builtin_amdgcn_logf(1.0f + __builtin_amdgcn_exp2f(-fabsf(y))); const float lb = fminf(y, 0.f) - L; p0[r] = lb; x0[r] = lb - y; }
#pragma unroll
                for (int r = 0; r < 16; ++r) { const float y = p1[r] * C2; const float L = __builtin_amdgcn_logf(1.0f + __builtin_amdgcn_exp2f(-fabsf(y))); const float lb = fminf(y, 0.f) - L; p1[r] = lb; x1[r] = lb - y; }
                if (kb + KVBLK - 1 >= qlo) {
                    const int dq = qm - kb; const float NEG = -__builtin_inff();
#pragma unroll
                    for (int r = 0; r < 16; ++r) { const int c = (r & 3) + 8 * (r >> 2);
                        if (dq - c < 1) { p0[r] = NEG; x0[r] = 0.f; }
                        if (dq - c - 32 < 1) { p1[r] = NEG; x1[r] = 0.f; } }
                }
                f32x16 a0, a1;
                const float s1 = suffix32(x1, a1, R, hi);
                const float s0 = suffix32(x0, a0, s1, hi);
                R = s0;
#pragma unroll
                for (int r = 0; r < 16; ++r) { p0[r] = __builtin_amdgcn_exp2f(p0[r] + a0[r]); p1[r] = __builtin_amdgcn_exp2f(p1[r] + a1[r]); }
                PK4(p0, 0, pa0); PK4(p0, 8, pa1); PK4(p1, 0, pa2); PK4(p1, 8, pa3);
            }
            SBAR();
            pv_tile<0>(o, vb0, pa0, pa1, pa2, pa3);
        }
    }
    float rli[16];
    if (MODE == 0) {
        if (hi == 0) li_l[r32] = l_reg; LDS_WAIT();
#pragma unroll
        for (int r = 0; r < 16; ++r) rli[r] = __builtin_amdgcn_rcpf(li_l[crow(r, hi)]);
    } else {
#pragma unroll
        for (int r = 0; r < 16; ++r) rli[r] = 1.f;
    }
    bf16* Ow = Ob + (size_t)(wid * QBLK) * OPITCH;
#pragma unroll
    for (int r = 0; r < 16; ++r) { const int orow = crow(r, hi);
#pragma unroll
        for (int d0 = 0; d0 < 4; ++d0) { const float v = o[d0][r] * rli[r];
            const float vn = __shfl_xor(v, 1);
            if ((r32 & 1) == 0) *(GAS unsigned*)(Ow + (size_t)orow * OPITCH + d0 * 32 + r32) = cvtpk(v, vn); } }
}
#undef PK4
}

__device__ __forceinline__ int t5_bucket(int d) {
    if (d < 16) return d;
    int b = 16;
    b += (d >= 22); b += (d >= 30); b += (d >= 40); b += (d >= 54); b += (d >= 73); b += (d >= 99); b += (d >= 134); b += (d >= 182);
    b += (d >= 246); b += (d >= 332); b += (d >= 450); b += (d >= 609); b += (d >= 825); b += (d >= 1117); b += (d >= 1513);
    return b;
}

struct Args {
    const float* x; const float* norm_g; const float* w_gate; const float* w_up; const float* w_down;
    const float* w_in[4]; const float* b_f0; const float* b_f3; const float* w_out; const float* rel_bias; const float* final_g;
    float* out; unsigned char* ws; int ph_lo, ph_hi;
};
static_assert(sizeof(Args) == 16 * 8 + 8, "Args has no padding");

__global__ void __launch_bounds__(NWAVES * 64, 2) mk_fwd(Args a) {
    extern __shared__ __attribute__((aligned(16))) unsigned char lds_raw[];
    LAS unsigned char* lds = (LAS unsigned char*)lds_raw;
    volatile LAS unsigned* MISC = (volatile LAS unsigned*)(lds + MISC_OFF);
    const int G = gridDim.x; const int bx = blockIdx.x; const int vcu = (G % 8 == 0) ? (bx % 8) * (G / 8) + bx / 8 : bx;
    unsigned char* ws = a.ws;
    gu32* ctl = (gu32*)(ws + WS_CTL);
    if (threadIdx.x < 64) MISC[threadIdx.x] = 0u;
    __syncthreads();
    const int lo = a.ph_lo, hi = a.ph_hi;
    XcdBarrier bar; bar.bar = (unsigned*)(ctl + CW_BAR); bar.x = 0; bar.st = nullptr;
    if (hi - lo > 1) bar = xcd_barrier_post((unsigned*)(ctl + CW_BAR), MISC + 8);
#define RUN(k) (lo <= (k) && (k) < hi)
#define SEAM(k) do { if (RUN(k) && RUN((k) + 1)) xcd_barrier(bar); } while (0)

    bf16* const Hb = (bf16*)(ws + WS_H); bf16* const AO = (bf16*)(ws + WS_AO); bf16* const ACT = (bf16*)(ws + WS_ACT); bf16* const QKV = (bf16*)(ws + WS_ACT);
    float* const LF = (float*)(ws + WS_LF);
    const int NGW = G * NWAVES;
    int ph = 0;
#define LANE_IDS() const int tid = opaque_tid(), lane = tid & 63, wave = __builtin_amdgcn_readfirstlane(tid >> 6), gw = vcu * NWAVES + wave; (void)lane; (void)gw

    if (RUN(ph)) {
        LANE_IDS();
        LAS float* scr = (LAS float*)(lds + wave * 16640);
        constexpr int I_G = (DM / 64) * (FF / 64), I_D = (FF / 64) * (DM / 64), I_Q = (DM / 64) * (NQKV / 64), I_O = (DM / 64) * (DM / 64);
        constexpr int PER_LAYER = 6 * I_G + I_Q + I_O;
        static_assert(I_G == I_D, "items");
        for (int it = gw; it < DEPTH * PER_LAYER; it += NGW) {
            const int l = it / PER_LAYER; int r = it - l * PER_LAYER;
            if (r < 6 * I_G) {
                const int mm = r / I_G, idx = r - mm * I_G, kind = mm >> 1, f = mm & 1;
                if (kind < 2) {
                    const float* W = (kind == 0 ? a.w_gate : a.w_up) + (size_t)(l * 2 + f) * DM * FF;
                    const int nblk = FF / 64, kb = idx / nblk, nb = idx - kb * nblk, n0 = nb * 64;
                    transpose_item(W, FF, DM, (bf16*)(ws + WS_WGU + (size_t)(l * 2 + f) * SZ_WGU), kb * 64, n0, (n0 >> 7) * 256 + (n0 & 127) + kind * 128, scr, lane);
                } else {
                    const float* W = a.w_down + (size_t)(l * 2 + f) * FF * DM;
                    const int nblk = DM / 64, kb = idx / nblk, nb = idx - kb * nblk;
                    transpose_item(W, DM, FF, (bf16*)(ws + WS_WD + (size_t)(l * 2 + f) * SZ_WD), kb * 64, nb * 64, nb * 64, scr, lane);
                }
            } else { r -= 6 * I_G;
                if (r < I_Q) {
                    const float* W = a.w_in[l]; const int ldw = (l == 0 || l == 3) ? NQKV + NH : NQKV;
                    const int nblk = NQKV / 64, kb = r / nblk, nb = r - kb * nblk;
                    transpose_item(W, ldw, DM, (bf16*)(ws + WS_WQKV + (size_t)l * SZ_WQKV), kb * 64, nb * 64, nb * 64, scr, lane);
                } else { r -= I_Q;
                    const float* W = a.w_out + (size_t)l * DM * DM;
                    const int nblk = DM / 64, kb = r / nblk, nb = r - kb * nblk;
                    transpose_item(W, DM, DM, (bf16*)(ws + WS_WO + (size_t)l * SZ_WO), kb * 64, nb * 64, nb * 64, scr, lane);
                }
            }
        }
    }
    SEAM(ph); ++ph;

    for (int sb = 0; sb < 3 * DEPTH; ++sb) {
        const int l = sb / 3, ty = sb - 3 * l;
        const float* xsrc = (sb == 0) ? a.x : (const float*)a.out;
        if (RUN(ph)) {
            LANE_IDS();
            const float* g = a.norm_g + (size_t)(l * 3 + ty) * DM;
            const bool fg = (ty == 1) && (l == 0 || l == 3);
            const float* Wf = a.w_in[l] + NQKV; const float* bfp = (l == 0) ? a.b_f0 : a.b_f3;
            f32x4 gv[8];
#pragma unroll
            for (int j = 0; j < 8; ++j) gv[j] = *((const GAS f32x4*)g + lane + 64 * j);
            for (int m = gw; m < M; m += NGW) {
                const GAS f32x4* xr = (const GAS f32x4*)(xsrc + (size_t)m * DM) + lane;
                f32x4 v[8]; float ss = 0.f;
#pragma unroll
                for (int j = 0; j < 8; ++j) { v[j] = xr[64 * j]; ss += (v[j].x * v[j].x + v[j].y * v[j].y) + (v[j].z * v[j].z + v[j].w * v[j].w); }
                const float rstd = 1.0f / sqrtf(wave_sum(ss) * (1.0f / DM) + RMS_EPS);
                GAS v2u* o8 = (GAS v2u*)(Hb + (size_t)m * DM) + lane;
#pragma unroll
                for (int j = 0; j < 8; ++j) { v[j] = v[j] * rstd * gv[j]; v2u w; w.x = cvtpk(v[j].x, v[j].y); w.y = cvtpk(v[j].z, v[j].w); o8[64 * j] = w; }
                if (fg) {
                    float an[16];
#pragma unroll
                    for (int n = 0; n < 16; ++n) an[n] = 0.f;
#pragma unroll
                    for (int j = 0; j < 8; ++j)
#pragma unroll
                        for (int i = 0; i < 4; ++i) { const int k = 4 * lane + 256 * j + i; const GAS f32x4* wp = (const GAS f32x4*)(Wf + (size_t)k * (NQKV + NH)); const float yv = v[j][i];
#pragma unroll
                            for (int q = 0; q < 4; ++q) { const f32x4 w4 = wp[q]; an[4 * q] += yv * w4.x; an[4 * q + 1] += yv * w4.y; an[4 * q + 2] += yv * w4.z; an[4 * q + 3] += yv * w4.w; } }
                    float z = 0.f;
#pragma unroll
                    for (int n = 0; n < 16; ++n) { const float s = wave_sum(an[n]); z = (lane == n) ? s : z; }
                    if (lane < 16) { z += bfp[lane]; const float ls = fminf(z, 0.f) - __logf(1.0f + __expf(-fabsf(z))); LF[(size_t)m * 16 + lane] = ls; }
                }
            }
        }
        SEAM(ph); ++ph;

        if (ty != 1) {
            const int f = ty >> 1;
            if (RUN(ph)) {
                pg8::Gemm g{Hb, (const bf16*)(ws + WS_WGU + (size_t)(l * 2 + f) * SZ_WGU), M, NGU, DM}; pg8::StaticOrder S; S.init(M, NGU, G, bx);
                pg8::EpiSwiGLU E{ACT, FF};
                pg8::gemm_phase<pg8::EpiSwiGLU, pg8::StaticOrder, true, true>(lds + RING_OFF, g, S, E);
            }
            SEAM(ph); ++ph;
            if (RUN(ph)) {
                pg8::Gemm g{ACT, (const bf16*)(ws + WS_WD + (size_t)(l * 2 + f) * SZ_WD), M, DM, FF}; pg8::StaticOrder S; S.init(M, DM, G, bx);
                pg8::EpiResid E{xsrc, a.out, DM, 0.5f};
                pg8::gemm_phase<pg8::EpiResid, pg8::StaticOrder, true, true>(lds + RING_OFF, g, S, E);
            }
            SEAM(ph); ++ph;
        } else {
            if (RUN(ph)) {
                pg8::Gemm g{Hb, (const bf16*)(ws + WS_WQKV + (size_t)l * SZ_WQKV), M, NQKV, DM}; pg8::StaticOrder S; S.init(M, NQKV, G, bx);
                pg8::EpiBf16 E{QKV, NQKV};
                pg8::gemm_phase<pg8::EpiBf16, pg8::StaticOrder, true, true>(lds + RING_OFF, g, S, E);
            }
            SEAM(ph); ++ph;
            if (RUN(ph)) {
                LANE_IDS();
                const int mixer = l % 3;
                LAS char* al = (LAS char*)(lds + RING_OFF);
                LAS float* tab = (LAS float*)(al + att::L_TAB);
                LAS float* scan = (LAS float*)(al + att::L_SCAN);
                for (int L = vcu; L < NBATCH * NH * 4; L += G) {
                    const int bh = L >> 2, xq = L & 3, b = bh >> 4, h = bh & 15;
                    const bf16* Qh = QKV + (size_t)b * SEQ * NQKV + h * HD; const bf16* Kh = Qh + DM; const bf16* Vh = Qh + 2 * DM;
                    bf16* Oh = AO + (size_t)b * SEQ * DM + h * HD;
                    __syncthreads();
                    int tmul = 0, tadd = 0;
                    if (mixer == 0) {
                        const float* lf = LF + (size_t)b * SEQ * 16 + h;
                        const float v0 = lf[(size_t)(4 * tid) * 16], v1 = lf[(size_t)(4 * tid + 1) * 16], v2 = lf[(size_t)(4 * tid + 2) * 16], v3 = lf[(size_t)(4 * tid + 3) * 16];
                        const float a0 = v0, a1 = a0 + v1, a2 = a1 + v2, a3 = a2 + v3;
                        float inc = a3;
#pragma unroll
                        for (int d = 1; d < 64; d <<= 1) { const float y = __shfl_up(inc, d); if (lane >= d) inc += y; }
                        if (lane == 63) scan[wave] = inc;
                        __syncthreads();
                        float pre = inc - a3;
                        for (int w = 0; w < wave; ++w) pre += scan[w];
                        const float ns = -11.313708498984761f;
                        tab[4 * tid] = (pre + a0) * ns; tab[4 * tid + 1] = (pre + a1) * ns; tab[4 * tid + 2] = (pre + a2) * ns; tab[4 * tid + 3] = (pre + a3) * ns;
                    } else if (mixer == 1) {
                        const float* rb = a.rel_bias + h * 32;
                        for (int j = tid; j < att::TAB_N; j += NWAVES * 64) {
                            const int d = 2047 - j; float v = 0.f;
                            if (d >= 0) { const int mult = (d <= 128 ? 1 : 0) + (((d & 3) == 0 && d <= 512) ? 1 : 0) + (((d & 15) == 0) ? 1 : 0);
                                v = (mult == 0) ? -__builtin_inff() : (rb[t5_bucket(d)] + (mult == 1 ? 0.f : (mult == 2 ? 0.6931471805599453f : 1.0986122886681098f))) * 11.313708498984761f; }
                            tab[j] = v; }
                        tmul = -1; tadd = 2047;
                    }
#pragma unroll 1
                    for (int pass = 0; pass < 2; ++pass) {
                        const int qb = pass ? 7 - xq : xq, P0 = qb * att::QB;
                        if (mixer == 2) att::attn_block<1>(Qh + (size_t)P0 * NQKV, Kh, Vh, Oh + (size_t)P0 * DM, P0, al, 0, 0);
                        else att::attn_block<0>(Qh + (size_t)P0 * NQKV, Kh, Vh, Oh + (size_t)P0 * DM, P0, al, tmul, tadd);
                    }
                }
            }
            SEAM(ph); ++ph;
            if (RUN(ph)) {
                pg8::Gemm g{AO, (const bf16*)(ws + WS_WO + (size_t)l * SZ_WO), M, DM, DM}; pg8::StaticOrder S; S.init(M, DM, G, bx);
                pg8::EpiResid E{a.out, a.out, DM, 1.0f};
                pg8::gemm_phase<pg8::EpiResid, pg8::StaticOrder, true, true>(lds + RING_OFF, g, S, E);
            }
            SEAM(ph); ++ph;
        }
    }
    if (RUN(ph)) {
        LANE_IDS();
        f32x4 gv[8];
#pragma unroll
        for (int j = 0; j < 8; ++j) gv[j] = *((const GAS f32x4*)a.final_g + lane + 64 * j);
        for (int m = gw; m < M; m += NGW) {
            GAS f32x4* xr = (GAS f32x4*)(a.out + (size_t)m * DM) + lane;
            f32x4 v[8]; float ss = 0.f;
#pragma unroll
            for (int j = 0; j < 8; ++j) { v[j] = xr[64 * j]; ss += (v[j].x * v[j].x + v[j].y * v[j].y) + (v[j].z * v[j].z + v[j].w * v[j].w); }
            const float rstd = 1.0f / sqrtf(wave_sum(ss) * (1.0f / DM) + RMS_EPS);
#pragma unroll
            for (int j = 0; j < 8; ++j) xr[64 * j] = v[j] * rstd * gv[j];
        }
    }
#undef RUN
#undef SEAM
}
constexpr int N_PHASES = 1 + DEPTH * 10 + 1;

extern "C" void kernel_launch(void* const* d_in, const int* in_sizes, int n_in, void* d_out, int out_size, void* d_ws, size_t ws_size, hipStream_t stream) {
    static int grid = 0;
    if (grid == 0) {
        if (n_in != 14 || in_sizes[0] != M * DM || out_size != M * DM || ws_size < WS_END) {
            fprintf(stderr, "kernel_launch: unexpected shapes (n_in %d, in0 %d, out %d, ws %zu < %zu?); nothing launched\n", n_in, n_in > 0 ? in_sizes[0] : -1, out_size, ws_size, (size_t)WS_END); grid = -1; return; }
        int dev = 0, cus = 0;
        if (hipGetDevice(&dev) != hipSuccess || hipDeviceGetAttribute(&cus, hipDeviceAttributeMultiprocessorCount, dev) != hipSuccess) { grid = -1; return; }
        if (hipFuncSetAttribute((const void*)mk_fwd, hipFuncAttributeMaxDynamicSharedMemorySize, LDS_BYTES) != hipSuccess) { fprintf(stderr, "kernel_launch: hipFuncSetAttribute failed\n"); grid = -1; return; }
        int per_cu = 0;
        if (hipOccupancyMaxActiveBlocksPerMultiprocessor(&per_cu, (const void*)mk_fwd, NWAVES * 64, LDS_BYTES) != hipSuccess || per_cu < 1)
            fprintf(stderr, "kernel_launch: note: occupancy query reports %d workgroups per CU\n", per_cu);
        (void)hipGetLastError();
        grid = cus;
    }
    if (grid < 0) return;
    if (hipMemsetAsync((char*)d_ws + WS_CTL, 0, CTL_ZERO_BYTES, stream) != hipSuccess) return;
    Args a{};
    a.x = (const float*)d_in[0]; a.norm_g = (const float*)d_in[1]; a.w_gate = (const float*)d_in[2]; a.w_up = (const float*)d_in[3]; a.w_down = (const float*)d_in[4];
    a.w_in[0] = (const float*)d_in[5]; a.b_f0 = (const float*)d_in[6]; a.w_in[1] = (const float*)d_in[7]; a.w_in[2] = (const float*)d_in[8]; a.w_in[3] = (const float*)d_in[9];
    a.b_f3 = (const float*)d_in[10]; a.w_out = (const float*)d_in[11]; a.rel_bias = (const float*)d_in[12]; a.final_g = (const float*)d_in[13];
    a.out = (float*)d_out; a.ws = (unsigned char*)d_ws;
#if MK_ONE_LAUNCH
    a.ph_lo = 0; a.ph_hi = N_PHASES;
    hipLaunchKernelGGL(mk_fwd, dim3(grid), dim3(NWAVES * 64), LDS_BYTES, stream, a);
#else
    for (int p = 0; p < N_PHASES; ++p) { a.ph_lo = p; a.ph_hi = p + 1; hipLaunchKernelGGL(mk_fwd, dim3(grid), dim3(NWAVES * 64), LDS_BYTES, stream, a); }
#endif
    const hipError_t le = hipPeekAtLastError();
    if (le != hipSuccess) fprintf(stderr, "kernel_launch: launch failed: %s\n", hipGetErrorName(le));
}
```

```cpp
#include <hip/hip_runtime.h>
#include <cstdio>
#include <cstdint>

#ifndef PROBE_DUP
#define PROBE_DUP 0
#endif
#define REP(k) _Pragma("unroll 1") for (int rep_ = 0; rep_ < ((PROBE_DUP == (k)) ? 2 : 1); ++rep_)
#ifndef MK_ONE_LAUNCH
#define MK_ONE_LAUNCH 1
#endif

namespace pg8 {
#define PG8_LAS __attribute__((address_space(3)))
typedef unsigned short bf16_t;
typedef short bf16x8 __attribute__((ext_vector_type(8)));
typedef float f32x4 __attribute__((ext_vector_type(4)));
typedef unsigned u32x4 __attribute__((ext_vector_type(4)));
constexpr int BM = 256, BK = 64, HALF = 128, HTB = HALF * BK * 2, STAGE_BYTES = 8 * HTB, NXCD = 8, WGM = 8;

__host__ __device__ __forceinline__ int lds_byte(int r, int c) { const int st = (r >> 4) * 2 + (c >> 5), rr = r & 15, cc = c & 31, ob = rr * 64 + cc * 2; return st * 1024 + (ob ^ (((ob >> 9) & 1) << 5)); }
__host__ __device__ __forceinline__ void stage_rc(int b, int& R, int& C) { const int st = b / 1024, sb = b % 1024, swz = sb ^ (((sb >> 9) & 1) << 5); R = (st >> 1) * 16 + swz / 64; C = (st & 1) * 32 + (swz % 64) / 2; }
__host__ __device__ __forceinline__ int perm32(int rho) { const int n = rho >> 4, i = rho & 15; return 8 * (i >> 2) + 4 * n + (i & 3); }

struct Unit { int pm, pn; };
struct Gemm { const bf16_t* A; const bf16_t* Bt; int M, N, K; };

struct StaticOrder {
    int nM, nN, nwg, G, c;
    __host__ __device__ void init(int M, int N, int G_, int c_) { nM = M / BM; nN = N / BM; nwg = nM * nN; G = G_; c = c_; }
    __host__ __device__ bool next(int i, Unit& u) const {
        const long L = (long)i * G + c; if (L >= nwg) return false;
        int wgid = (int)L; { const int q = nwg / NXCD, r = nwg % NXCD, xcd = wgid % NXCD, off = wgid / NXCD; wgid = (xcd < r ? xcd * (q + 1) : r * (q + 1) + (xcd - r) * q) + off; }
        const int nig = WGM * nN, gid = wgid / nig, fm = gid * WGM, gsz = (nM - fm) < WGM ? (nM - fm) : WGM;
        u.pm = fm + ((wgid % nig) % gsz); u.pn = (wgid % nig) / gsz; return true;
    }
    __device__ __forceinline__ void a_ready(const Unit&) const {}
    __device__ __forceinline__ void done(const Unit&) const {}
};

__device__ __forceinline__ unsigned cvt_pk_bf16(float lo, float hi) { unsigned r; asm volatile("v_cvt_pk_bf16_f32 %0, %1, %2" : "=v"(r) : "v"(lo), "v"(hi)); return r; }

__device__ __forceinline__ float fq_sum(float s) {
    { auto rr = __builtin_amdgcn_permlane16_swap(__float_as_uint(s), __float_as_uint(s), false, false); s = __uint_as_float(rr[0]) + __uint_as_float(rr[1]); }
    { auto rr = __builtin_amdgcn_permlane32_swap(__float_as_uint(s), __float_as_uint(s), false, false); s = __uint_as_float(rr[0]) + __uint_as_float(rr[1]); }
    return s;
}
__device__ __forceinline__ float row_rstd(const float* part, int row, int fq) {
    const f32x4 a = *(const f32x4*)(part + (size_t)row * 32 + fq * 8), b = *(const f32x4*)(part + (size_t)row * 32 + fq * 8 + 4);
    const float s = fq_sum(((a[0] + a[1]) + (a[2] + a[3])) + ((b[0] + b[1]) + (b[2] + b[3])));
    return __builtin_amdgcn_rsqf(s * (1.0f / 2048.0f) + 1e-6f);
}
__device__ __forceinline__ void build_rstd_table(PG8_LAS float* rst, const float* part, int pm0, int tid) {
    if (tid < 256) { const f32x4* p = (const f32x4*)(part + (size_t)(pm0 * BM + tid) * 32); float s = 0.f;
#pragma unroll
        for (int j = 0; j < 8; ++j) { const f32x4 v = p[j]; s += (v[0] + v[1]) + (v[2] + v[3]); }
        rst[tid] = __builtin_amdgcn_rsqf(s * (1.0f / 2048.0f) + 1e-6f); }
    __syncthreads();
}
struct EpiBf16 {
    static constexpr bool PERM = true, AFTER_DRAIN = false;
    bf16_t* O; int ldc; const float* part; const PG8_LAS float* rst; int pm0;
    __device__ __forceinline__ void operator()(const f32x4 (&acc)[2][2][4][2], const Unit& u, int wr, int wc, int fr, int fq) const {
        const int row0 = u.pm * BM + wr * 64 + fr, col0 = u.pn * BM + wc * 32 + 8 * fq;
        float rs[2][4];
        if (u.pm == pm0) {
#pragma unroll
            for (int ai = 0; ai < 2; ++ai)
#pragma unroll
                for (int m = 0; m < 4; ++m) rs[ai][m] = rst[wr * 64 + fr + ai * HALF + m * 16];
        } else {
#pragma unroll
            for (int ai = 0; ai < 2; ++ai)
#pragma unroll
                for (int m = 0; m < 4; ++m) rs[ai][m] = row_rstd(part, row0 + ai * HALF + m * 16, fq);
        }
#pragma unroll
        for (int ai = 0; ai < 2; ++ai)
#pragma unroll
            for (int m = 0; m < 4; ++m) { bf16_t* rowp = O + (size_t)(row0 + ai * HALF + m * 16) * ldc + col0; const float r = rs[ai][m];
#pragma unroll
                for (int bj = 0; bj < 2; ++bj) { const f32x4 v0 = acc[ai][bj][m][0] * r, v1 = acc[ai][bj][m][1] * r;
                    u32x4 w; w.x = cvt_pk_bf16(v0[0], v0[1]); w.y = cvt_pk_bf16(v0[2], v0[3]); w.z = cvt_pk_bf16(v1[0], v1[1]); w.w = cvt_pk_bf16(v1[2], v1[3]);
                    *(u32x4*)(rowp + bj * HALF) = w; } }
    }
};
__device__ __forceinline__ float silu_mul(float g, float u) { const float e = __builtin_amdgcn_exp2f(g * -1.4426950408889634f); return g * __builtin_amdgcn_rcpf(1.0f + e) * u; }
struct EpiSwiGLU {
    static constexpr bool PERM = true, AFTER_DRAIN = false;
    bf16_t* O; int ldc; const float* part; const PG8_LAS float* rst; int pm0;
    __device__ __forceinline__ void operator()(const f32x4 (&acc)[2][2][4][2], const Unit& u, int wr, int wc, int fr, int fq) const {
        const int row0 = u.pm * BM + wr * 64 + fr, col0 = u.pn * HALF + wc * 32 + 8 * fq;
        float rs[2][4];
        if (u.pm == pm0) {
#pragma unroll
            for (int ai = 0; ai < 2; ++ai)
#pragma unroll
                for (int m = 0; m < 4; ++m) rs[ai][m] = rst[wr * 64 + fr + ai * HALF + m * 16];
        } else {
#pragma unroll
            for (int ai = 0; ai < 2; ++ai)
#pragma unroll
                for (int m = 0; m < 4; ++m) rs[ai][m] = row_rstd(part, row0 + ai * HALF + m * 16, fq);
        }
#pragma unroll
        for (int ai = 0; ai < 2; ++ai)
#pragma unroll
            for (int m = 0; m < 4; ++m) { bf16_t* rowp = O + (size_t)(row0 + ai * HALF + m * 16) * ldc + col0; const float r = rs[ai][m];
                const f32x4 g0 = acc[ai][0][m][0] * r, g1 = acc[ai][0][m][1] * r, u0 = acc[ai][1][m][0] * r, u1 = acc[ai][1][m][1] * r;
                u32x4 w; w.x = cvt_pk_bf16(silu_mul(g0[0], u0[0]), silu_mul(g0[1], u0[1])); w.y = cvt_pk_bf16(silu_mul(g0[2], u0[2]), silu_mul(g0[3], u0[3]));
                w.z = cvt_pk_bf16(silu_mul(g1[0], u1[0]), silu_mul(g1[1], u1[1])); w.w = cvt_pk_bf16(silu_mul(g1[2], u1[2]), silu_mul(g1[3], u1[3]));
                *(u32x4*)rowp = w; }
    }
};
struct EpiResid {
    static constexpr bool PERM = true, AFTER_DRAIN = false;
    const float* base; float* out; bf16_t* xb; float* part; int ldc; float alpha;
    __device__ __forceinline__ void operator()(const f32x4 (&acc)[2][2][4][2], const Unit& u, int wr, int wc, int fr, int fq) const {
        const int row0 = u.pm * BM + wr * 64 + fr, col0 = u.pn * BM + wc * 32 + 8 * fq;
#pragma unroll
        for (int ai = 0; ai < 2; ++ai)
#pragma unroll
            for (int m = 0; m < 4; ++m) { const int row = row0 + ai * HALF + m * 16; const size_t off = (size_t)row * ldc + col0; float s = 0.f;
#pragma unroll
                for (int bj = 0; bj < 2; ++bj) { const f32x4 b0 = *(const f32x4*)(base + off + bj * HALF), b1 = *(const f32x4*)(base + off + bj * HALF + 4);
                    const f32x4 o0 = b0 + alpha * acc[ai][bj][m][0], o1 = b1 + alpha * acc[ai][bj][m][1];
                    *(f32x4*)(out + off + bj * HALF) = o0; *(f32x4*)(out + off + bj * HALF + 4) = o1;
                    u32x4 w; w.x = cvt_pk_bf16(o0[0], o0[1]); w.y = cvt_pk_bf16(o0[2], o0[3]); w.z = cvt_pk_bf16(o1[0], o1[1]); w.w = cvt_pk_bf16(o1[2], o1[3]);
                    *(u32x4*)(xb + off + bj * HALF) = w;
                    s += ((o0[0] * o0[0] + o0[1] * o0[1]) + (o0[2] * o0[2] + o0[3] * o0[3])) + ((o1[0] * o1[0] + o1[1] * o1[1]) + (o1[2] * o1[2] + o1[3] * o1[3])); }
                s = fq_sum(s);
                if (fq == 0) part[(size_t)row * 32 + u.pn * 4 + wc] = s;
                if (m & 1) asm volatile("" ::: "memory"); }
    }
};

template <class Epi, class Sched, bool ALIGN_EPI = false, bool SP2 = false>
__device__ __forceinline__ void gemm_phase(PG8_LAS unsigned char* lds, const Gemm g, const Sched& S, const Epi& E) {
    int tid = threadIdx.x; asm volatile("" : "+v"(tid));
    const int wid = __builtin_amdgcn_readfirstlane(tid >> 6), lane = tid & 63, wr = wid >> 2, wc = wid & 3, fr = lane & 15, fq = lane >> 4;
    const int K = g.K, nt = K / BK;
    unsigned voffA[2], voffB[2];
#pragma unroll
    for (int i = 0; i < 2; ++i) { int R, C; stage_rc(tid * 16 + i * 8192, R, C); const int Rb = Epi::PERM ? ((R & ~31) + perm32(R & 31)) : R;
        voffA[i] = (unsigned)(R * K + C) * 2u; voffB[i] = (unsigned)(Rb * K + C) * 2u; }
    const size_t kstep = (size_t)(BK * 2);
    const size_t hstep = (size_t)HALF * K * 2;
    const size_t tstep = 2 * hstep;
    const unsigned ldsw = (unsigned)wid * 1024u;
    const int aoff = lds_byte(wr * 64 + fr, fq * 8), boff = lds_byte(wc * 32 + fr, fq * 8);
#define PG8_SA(b, h) (((b) * 2 + (h)) * HTB)
#define PG8_SB(b, h) ((4 + (b) * 2 + (h)) * HTB)
#define PG8_STAGE(bufoff, gbase, voff) do { _Pragma("unroll") for (int _i = 0; _i < 2; ++_i) \
        __builtin_amdgcn_global_load_lds((const unsigned*)((const char*)(gbase) + (voff)[_i]), (PG8_LAS unsigned*)(lds + (bufoff) + ldsw + _i * 8192), 16, 0, 0); } while (0)
#define PG8_LDA(dst, b, h) do { _Pragma("unroll") for (int m = 0; m < 4; ++m) _Pragma("unroll") for (int k = 0; k < 2; ++k) dst[m][k] = *(const PG8_LAS bf16x8*)(lds + PG8_SA(b, h) + aoff + m * 2048 + k * 1024); } while (0)
#define PG8_LDB(dst, b, h) do { _Pragma("unroll") for (int n = 0; n < 2; ++n) _Pragma("unroll") for (int k = 0; k < 2; ++k) dst[n][k] = *(const PG8_LAS bf16x8*)(lds + PG8_SB(b, h) + boff + n * 2048 + k * 1024); } while (0)
#define PG8_MMA(ai, bj, At, Bt) do { __builtin_amdgcn_s_setprio(1); _Pragma("unroll") for (int m = 0; m < 4; ++m) _Pragma("unroll") for (int n = 0; n < 2; ++n) _Pragma("unroll") for (int k = 0; k < 2; ++k) \
        acc[ai][bj][m][n] = __builtin_amdgcn_mfma_f32_16x16x32_bf16(Bt[n][k], At[m][k], acc[ai][bj][m][n], 0, 0, 0); __builtin_amdgcn_s_setprio(0); } while (0)
#define PG8_WAIT_V(n) asm volatile("s_waitcnt vmcnt(" #n ")" ::: "memory")
#define PG8_WAIT_L(n) asm volatile("s_waitcnt lgkmcnt(" #n ")" ::: "memory")
#define PG8_BAR __builtin_amdgcn_s_barrier()
#define PG8_SCHED __builtin_amdgcn_sched_barrier(0)
    Unit cur, nxt; int ui = 0;
    if (!S.next(0, cur)) return;
    f32x4 acc[2][2][4][2];
#pragma unroll
    for (int a = 0; a < 2; ++a)
#pragma unroll
        for (int b = 0; b < 2; ++b)
#pragma unroll
            for (int m = 0; m < 4; ++m)
#pragma unroll
                for (int n = 0; n < 2; ++n) acc[a][b][m][n] = (f32x4){0.f, 0.f, 0.f, 0.f};
    bf16x8 At[4][2], B0[2][2], B1[2][2];
    const char* cA = (const char*)g.A + (size_t)cur.pm * tstep; const char* cB = (const char*)g.Bt + (size_t)cur.pn * tstep;
    S.a_ready(cur);
    if constexpr (SP2) {
        PG8_STAGE(PG8_SB(0, 0), cB, voffB); PG8_STAGE(PG8_SB(0, 1), cB + hstep, voffB); PG8_STAGE(PG8_SA(0, 0), cA, voffA); PG8_STAGE(PG8_SA(0, 1), cA + hstep, voffA);
        if (wr == 1) PG8_BAR;
        PG8_WAIT_V(2); PG8_BAR;
        PG8_STAGE(PG8_SB(1, 0), cB + kstep, voffB); PG8_STAGE(PG8_SA(1, 0), cA + kstep, voffA); PG8_STAGE(PG8_SB(1, 1), cB + hstep + kstep, voffB);
        PG8_WAIT_V(6); PG8_BAR;
    } else {
        PG8_STAGE(PG8_SB(0, 0), cB, voffB); PG8_STAGE(PG8_SA(0, 0), cA, voffA); PG8_STAGE(PG8_SB(0, 1), cB + hstep, voffB); PG8_STAGE(PG8_SA(0, 1), cA + hstep, voffA);
        if (wr == 1) PG8_BAR;
        PG8_WAIT_V(4); PG8_BAR;
        PG8_STAGE(PG8_SB(1, 0), cB + kstep, voffB); PG8_STAGE(PG8_SA(1, 0), cA + kstep, voffA); PG8_STAGE(PG8_SB(1, 1), cB + hstep + kstep, voffB);
        PG8_WAIT_V(6); PG8_BAR;
    }
    for (;;) {
        const bool has_next = S.next(ui + 1, nxt);
        const char* nA = has_next ? (const char*)g.A + (size_t)nxt.pm * tstep : cA; const char* nB = has_next ? (const char*)g.Bt + (size_t)nxt.pn * tstep : cB;
        for (int t = 0; t < nt; t += 2) {
            const bool last = (t == nt - 2);
            const char* a1 = cA + (size_t)(t + 1) * kstep;
            const char* a2 = last ? nA : cA + (size_t)(t + 2) * kstep; const char* b2 = last ? nB : cB + (size_t)(t + 2) * kstep;
            const char* a3 = a2 + kstep; const char* b3 = b2 + kstep;
            if (last && has_next) S.a_ready(nxt);
            if constexpr (SP2) {
            PG8_LDB(B0, 0, 0); PG8_LDB(B1, 0, 1); PG8_SCHED; PG8_LDA(At, 0, 0); PG8_STAGE(PG8_SA(1, 1), a1 + hstep, voffA);
            PG8_WAIT_V(8); PG8_WAIT_L(0); PG8_BAR; PG8_MMA(0, 0, At, B0); PG8_MMA(0, 1, At, B1); PG8_BAR; PG8_SCHED;
            PG8_LDA(At, 0, 1); PG8_STAGE(PG8_SB(0, 0), b2, voffB); PG8_STAGE(PG8_SB(0, 1), b2 + hstep, voffB); PG8_STAGE(PG8_SA(0, 0), a2, voffA);
            PG8_WAIT_V(8); PG8_WAIT_L(0); PG8_BAR; PG8_MMA(1, 0, At, B0); PG8_MMA(1, 1, At, B1); PG8_BAR; PG8_SCHED;
            PG8_LDB(B0, 1, 0); PG8_LDB(B1, 1, 1); PG8_SCHED; PG8_LDA(At, 1, 0); PG8_STAGE(PG8_SA(0, 1), a2 + hstep, voffA);
            PG8_WAIT_V(8); PG8_WAIT_L(0); PG8_BAR; PG8_MMA(0, 0, At, B0); PG8_MMA(0, 1, At, B1); PG8_BAR; PG8_SCHED;
            PG8_LDA(At, 1, 1); PG8_STAGE(PG8_SB(1, 0), b3, voffB); PG8_STAGE(PG8_SB(1, 1), b3 + hstep, voffB); PG8_STAGE(PG8_SA(1, 0), a3, voffA);
            PG8_WAIT_V(8); PG8_WAIT_L(0); PG8_BAR; PG8_MMA(1, 0, At, B0); PG8_MMA(1, 1, At, B1); PG8_BAR; PG8_SCHED;
            } else {
            PG8_LDB(B0, 0, 0); PG8_SCHED; PG8_LDA(At, 0, 0); PG8_STAGE(PG8_SA(1, 1), a1 + hstep, voffA);
            PG8_WAIT_L(8); PG8_BAR; PG8_WAIT_L(0); PG8_MMA(0, 0, At, B0); PG8_BAR; PG8_SCHED;
            PG8_LDB(B1, 0, 1); PG8_STAGE(PG8_SB(0, 0), b2, voffB);
            PG8_BAR; PG8_WAIT_L(0); PG8_MMA(0, 1, At, B1); PG8_BAR;
            PG8_LDA(At, 0, 1); PG8_STAGE(PG8_SA(0, 0), a2, voffA);
            PG8_BAR; PG8_WAIT_L(0); PG8_MMA(1, 0, At, B0); PG8_BAR; PG8_SCHED;
            PG8_STAGE(PG8_SB(0, 1), b2 + hstep, voffB);
            PG8_WAIT_V(6); PG8_BAR; PG8_MMA(1, 1, At, B1); PG8_BAR;
            PG8_LDB(B0, 1, 0); PG8_SCHED; PG8_LDA(At, 1, 0); PG8_STAGE(PG8_SA(0, 1), a2 + hstep, voffA);
            PG8_WAIT_L(8); PG8_BAR; PG8_WAIT_L(0); PG8_MMA(0, 0, At, B0); PG8_BAR; PG8_SCHED;
            PG8_LDB(B1, 1, 1); PG8_STAGE(PG8_SB(1, 0), b3, voffB);
            PG8_BAR; PG8_WAIT_L(0); PG8_MMA(0, 1, At, B1); PG8_BAR;
            PG8_LDA(At, 1, 1); PG8_STAGE(PG8_SA(1, 0), a3, voffA);
            PG8_BAR; PG8_WAIT_L(0); PG8_MMA(1, 0, At, B0); PG8_BAR; PG8_SCHED;
            PG8_STAGE(PG8_SB(1, 1), b3 + hstep, voffB);
            PG8_WAIT_V(6); PG8_BAR; PG8_MMA(1, 1, At, B1); PG8_BAR;
            }
        }
        if constexpr (ALIGN_EPI) { if (wr == 0) PG8_BAR; }
        if constexpr (!Epi::AFTER_DRAIN) { E(acc, cur, wr, wc, fr, fq); S.done(cur); }
        if (!has_next) break;
#pragma unroll
        for (int a = 0; a < 2; ++a)
#pragma unroll
            for (int b = 0; b < 2; ++b)
#pragma unroll
                for (int m = 0; m < 4; ++m)
#pragma unroll
                    for (int n = 0; n < 2; ++n) acc[a][b][m][n] = (f32x4){0.f, 0.f, 0.f, 0.f};
        cur = nxt; cA = nA; cB = nB; ++ui;
        if constexpr (ALIGN_EPI) { if (wr == 1) PG8_BAR; }
    }
    PG8_WAIT_V(0);
    if constexpr (!ALIGN_EPI) { if (wr == 0) PG8_BAR; }
    PG8_BAR;
#undef PG8_SA
#undef PG8_SB
#undef PG8_STAGE
#undef PG8_LDA
#undef PG8_LDB
#undef PG8_MMA
#undef PG8_WAIT_V
#undef PG8_WAIT_L
#undef PG8_BAR
#undef PG8_SCHED
}
}

constexpr int DM = 2048, NBATCH = 8, SEQ = 2048, DEPTH = 4, NH = 16, HD = 128, FF = 5632;
constexpr int M = NBATCH * SEQ;
constexpr int NGU = 2 * FF, NQKV = 3 * DM;
constexpr float RMS_EPS = 1e-6f;
constexpr int NWAVES = 8;

constexpr size_t MiB = 1u << 20;
constexpr size_t WS_CTL = 0, CTL_ZERO_BYTES = 1 * MiB;
constexpr size_t WS_LF = 1 * MiB;
constexpr size_t WS_PART = 2 * MiB;
constexpr size_t WS_WF = 4 * MiB;
constexpr size_t WS_WGU = 5 * MiB;
constexpr size_t SZ_WGU = (size_t)NGU * DM * 2;
constexpr size_t WS_WD = WS_WGU + 8 * SZ_WGU;
constexpr size_t SZ_WD = (size_t)DM * FF * 2;
constexpr size_t WS_WQKV = WS_WD + 8 * SZ_WD;
constexpr size_t SZ_WQKV = (size_t)NQKV * DM * 2;
constexpr size_t WS_WO = WS_WQKV + 4 * SZ_WQKV;
constexpr size_t SZ_WO = (size_t)DM * DM * 2;
constexpr size_t WS_H = WS_WO + 4 * SZ_WO;
constexpr size_t WS_AO = WS_H + (size_t)M * DM * 2;
constexpr size_t WS_ACT = WS_AO + (size_t)M * DM * 2;
constexpr size_t WS_END = WS_ACT + (size_t)M * NQKV * 2;
static_assert(WS_WGU % 256 == 0 && WS_WD % 256 == 0 && WS_WQKV % 256 == 0 && WS_WO % 256 == 0 && WS_H % 256 == 0 && WS_ACT % 256 == 0, "alignment");

constexpr int CW_TMO = 0;
constexpr int CW_BAR = 4096;

constexpr int RING_OFF = 0, RING_BYTES = 131072;
constexpr int LDS_BYTES = 147456;
constexpr int RST_OFF = RING_BYTES;
constexpr int MISC_OFF = LDS_BYTES - 256;

#define GAS __attribute__((address_space(1)))
#define LAS __attribute__((address_space(3)))
typedef unsigned short bf16;
typedef unsigned v4u __attribute__((ext_vector_type(4)));
typedef unsigned v2u __attribute__((ext_vector_type(2)));
typedef float f32x4 __attribute__((ext_vector_type(4)));
typedef float f32x16 __attribute__((ext_vector_type(16)));
typedef short bf16x8 __attribute__((ext_vector_type(8)));
typedef short s16x4 __attribute__((ext_vector_type(4)));
typedef GAS unsigned gu32;
#define RLX_AGENT __ATOMIC_RELAXED, __HIP_MEMORY_SCOPE_AGENT
#define LDS_WAIT() asm volatile("s_waitcnt lgkmcnt(0)" ::: "memory")
#define VM_WAIT() asm volatile("s_waitcnt vmcnt(0)" ::: "memory")
__device__ __forceinline__ unsigned cvtpk(float lo, float hi) { unsigned r; asm volatile("v_cvt_pk_bf16_f32 %0, %1, %2" : "=v"(r) : "v"(lo), "v"(hi)); return r; }

#define XB_TMO      128
#define XB_XCNT(j)  (256  + 64 * (j))
#define XB_XSUB(j)  (1280 + 64 * (j))
#define XB_XGEN(j)  (2304 + 64 * (j))
#define XB_TOP      3328
#define XB_TOPGEN   3392
#define XCD_BAR_WORDS 3456
#define XB_SPIN_CAP (1u << 18)
__device__ __forceinline__ unsigned xb_ld(unsigned* p)              { return __hip_atomic_load(p, __ATOMIC_RELAXED, __HIP_MEMORY_SCOPE_AGENT); }
__device__ __forceinline__ unsigned xb_add(unsigned* p, unsigned v) { return __hip_atomic_fetch_add(p, v, __ATOMIC_RELAXED, __HIP_MEMORY_SCOPE_AGENT); }
__device__ __forceinline__ unsigned xb_xcc_id() { return (unsigned)__builtin_amdgcn_s_getreg((3 << 11) | 20) & 0xFu; }
#define XB_SPIN(cond, bar) do { unsigned _sp = 0; while (cond) { __builtin_amdgcn_s_sleep(1); \
    if ((++_sp & 255u) == 0u) { if (xb_ld(&(bar)[XB_TMO])) break; if (_sp > XB_SPIN_CAP) { atomicAdd(&(bar)[XB_TMO], 1u); break; } } } } while (0)
struct XcdBarrier { unsigned* bar; unsigned x; volatile LAS unsigned* st; };
__device__ __forceinline__ XcdBarrier xcd_barrier_post(unsigned* bar, volatile LAS unsigned* st) {
    XcdBarrier b; b.bar = bar; b.x = xb_xcc_id(); b.st = st;
    if (threadIdx.x == 0) (void)xb_add(&bar[XB_XCNT(b.x)], 1u);
    return b;
}
__device__ __forceinline__ void xcd_barrier_complete(unsigned* bar, unsigned x, unsigned& nloc, unsigned& nx) {
    const unsigned G = gridDim.x * gridDim.y * gridDim.z;
    unsigned sum, cnt, mine, sp = 0u;
    for (;;) {
        sum = 0u; cnt = 0u; mine = 0u;
#pragma unroll
        for (unsigned j = 0; j < 16; ++j) { const unsigned c = xb_ld(&bar[XB_XCNT(j)]); sum += c; cnt += (c > 0u) ? 1u : 0u; mine = (j == x) ? c : mine; }
        if (sum == G) break;
        __builtin_amdgcn_s_sleep(1);
        if ((++sp & 255u) == 0u) { if (xb_ld(&bar[XB_TMO])) break; if (sp > XB_SPIN_CAP) { atomicAdd(&bar[XB_TMO], 1u); break; } }
    }
    nloc = mine > 0u ? mine : 1u; nx = cnt > 0u ? cnt : 1u;
}
__device__ __forceinline__ void xcd_barrier(const XcdBarrier& b) {
    asm volatile("s_waitcnt vmcnt(0)" ::: "memory");
    __syncthreads();
    if (threadIdx.x == 0) {
        unsigned* bar = b.bar;
        __builtin_amdgcn_s_waitcnt(0);
        unsigned nloc = b.st[0], nx = b.st[1];
        if (nloc == 0u) { xcd_barrier_complete(bar, b.x, nloc, nx); b.st[0] = nloc; b.st[1] = nx; }
        const unsigned old = xb_add(&bar[XB_XSUB(b.x)], 1u);
        const unsigned gen = old / nloc;
        if (old + 1u == (gen + 1u) * nloc) {
            __builtin_amdgcn_fence(__ATOMIC_RELEASE, "agent");
            asm volatile("s_waitcnt vmcnt(0)" ::: "memory");
            const unsigned og = xb_add(&bar[XB_TOP], 1u);
            const unsigned tg = og / nx;
            if (og + 1u == (tg + 1u) * nx) xb_add(&bar[XB_TOPGEN], 1u);
            else XB_SPIN(xb_ld(&bar[XB_TOPGEN]) == tg, bar);
            __builtin_amdgcn_fence(__ATOMIC_ACQUIRE, "agent");
            xb_add(&bar[XB_XGEN(b.x)], 1u);
            asm volatile("s_waitcnt vmcnt(0)" ::: "memory");
        } else {
            XB_SPIN(xb_ld(&bar[XB_XGEN(b.x)]) == gen, bar);
            __builtin_amdgcn_fence(__ATOMIC_ACQUIRE, "agent");
            asm volatile("s_waitcnt vmcnt(0)" ::: "memory");
        }
    }
    __syncthreads();
}

__device__ __forceinline__ int opaque_tid() { int t = threadIdx.x; asm volatile("" : "+v"(t)); return t; }
__device__ __forceinline__ float wave_sum(float v) {
#pragma unroll
    for (int o = 1; o < 64; o <<= 1) v += __shfl_xor(v, o);
    return v;
}

__device__ __forceinline__ void transpose_item(const float* __restrict__ W, int ldw, int Kdim, bf16* __restrict__ WT, int k0, int n0, int drow0, const float* __restrict__ gk, LAS float* scr, int lane) {
    const int nl = (lane & 15) * 4, kl = lane >> 4;
    f32x4 v[16];
#pragma unroll
    for (int i = 0; i < 16; ++i) v[i] = *(const GAS f32x4*)(W + (size_t)(k0 + 4 * i + kl) * ldw + n0 + nl);
#pragma unroll
    for (int i = 0; i < 16; ++i) { const float gg = gk ? gk[k0 + 4 * i + kl] : 1.0f; LAS float* s = scr + (4 * i + kl) * 65 + nl; s[0] = v[i].x * gg; s[1] = v[i].y * gg; s[2] = v[i].z * gg; s[3] = v[i].w * gg; }
    LDS_WAIT(); asm volatile("" ::: "memory");
    const int c = lane & 7;
#pragma unroll
    for (int j = 0; j < 8; ++j) { const int n = (lane >> 3) + 8 * j; const LAS float* s = scr + (8 * c) * 65 + n;
        v4u o; o.x = cvtpk(s[0 * 65], s[1 * 65]); o.y = cvtpk(s[2 * 65], s[3 * 65]); o.z = cvtpk(s[4 * 65], s[5 * 65]); o.w = cvtpk(s[6 * 65], s[7 * 65]);
        *(GAS v4u*)(WT + (size_t)(drow0 + n) * Kdim + k0 + 8 * c) = o; }
    LDS_WAIT(); asm volatile("" ::: "memory");
}

namespace att {
constexpr int D = 128, NW = 8, QBLK = 32, KVBLK = 64, QB = 256;
constexpr int SHM_K = KVBLK * D * 2, SHM_V = KVBLK * D * 2;
constexpr int L_V = 0, L_K = 2 * SHM_V, L_WS = L_K + 2 * SHM_K, L_TAB = L_WS + NW * 64 * 4, L_SCAN = L_TAB + 2304 * 4, L_END = L_SCAN + 64;
constexpr int TAB_N = 2304;
constexpr int QPITCH = NQKV, OPITCH = DM;
constexpr float SCALE = 0.08838834764831845f;
constexpr float C2 = 1.4426950408889634f * SCALE;
constexpr float THR = 8.f;

#define KSWZ(row, colB) ((row) * 256 + ((colB) ^ (((row) & 7) << 4)))
#define SBAR() __builtin_amdgcn_sched_barrier(0)
__device__ __forceinline__ int v_st(int k, int c) { const int kk = (k & ~0xC) | ((k & 4) << 1) | ((k & 8) >> 1); return ((kk >> 3) * 4 + (c >> 5)) * 512 + ((kk & 7) * 32 + (c & 31)) * 2; }
__device__ __forceinline__ int v_rd_base(int lane) { return ((lane & 3) << 3) | (((lane >> 2) & 3) << 6) | (((lane >> 4) & 1) << 5) | (((lane >> 5) & 1) << 8); }
constexpr int v_rd_off(int d0, int ks, int half) { return d0 * 512 + ks * 4096 + half * 2048; }
__device__ __forceinline__ int crow(int r, int hi) { return (r & 3) + 8 * (r >> 2) + 4 * hi; }

template <bool STRICT>
__device__ __forceinline__ void mask_tile(f32x16& p0, f32x16& p1, int dq) {
    const float NEG = -__builtin_inff();
    const int lim = STRICT ? 1 : 0;
#pragma unroll
    for (int r = 0; r < 16; ++r) {
        const int c = (r & 3) + 8 * (r >> 2);
        if (dq - c < lim) p0[r] = NEG;
        if (dq - c - 32 < lim) p1[r] = NEG;
    }
}
__device__ __forceinline__ void partialSM(f32x16& p0, f32x16& p1, float& m_reg, float& mn, float& alpha) {
    float pmax = p0[0];
#pragma unroll
    for (int r = 1; r < 16; ++r) pmax = fmaxf(pmax, p0[r]);
#pragma unroll
    for (int r = 0; r < 16; ++r) pmax = fmaxf(pmax, p1[r]);
    { auto rr = __builtin_amdgcn_permlane32_swap(__float_as_uint(pmax), __float_as_uint(pmax), false, false);
      pmax = fmaxf(__uint_as_float(rr[0]), __uint_as_float(rr[1])); }
    if (__builtin_expect(__all((pmax - m_reg) * SCALE <= THR), 1)) { mn = m_reg; alpha = 1.f; }
    else { mn = fmaxf(m_reg, pmax); alpha = __builtin_amdgcn_exp2f((m_reg - mn) * C2); m_reg = mn; }
    const float mnL = -mn * C2;
#pragma unroll
    for (int r = 0; r < 16; ++r) p0[r] = fmaf(p0[r], C2, mnL);
#pragma unroll
    for (int r = 0; r < 16; ++r) p1[r] = fmaf(p1[r], C2, mnL);
#pragma unroll
    for (int r = 0; r < 16; ++r) p0[r] = __builtin_amdgcn_exp2f(p0[r]);
}
#define PK4(P, B_, OUT) do { unsigned a0 = cvtpk(P[B_+0], P[B_+1]), a1 = cvtpk(P[B_+2], P[B_+3]);                          \
        unsigned b0 = cvtpk(P[B_+4], P[B_+5]), b1 = cvtpk(P[B_+6], P[B_+7]);                                             \
        auto r0 = __builtin_amdgcn_permlane32_swap(a0, b0, false, false); auto r1 = __builtin_amdgcn_permlane32_swap(a1, b1, false, false); \
        v4u w = {r0[0], r1[0], r0[1], r1[1]}; OUT = __builtin_bit_cast(bf16x8, w); } while (0)
__device__ __forceinline__ void finishSM(f32x16& p0, f32x16& p1, float alpha, float& l_reg, bf16x8& pa0, bf16x8& pa1, bf16x8& pa2, bf16x8& pa3) {
#pragma unroll
    for (int r = 0; r < 16; ++r) p1[r] = __builtin_amdgcn_exp2f(p1[r]);
    float ps = 0;
#pragma unroll
    for (int r = 0; r < 16; ++r) ps += p0[r];
#pragma unroll
    for (int r = 0; r < 16; ++r) ps += p1[r];
    { auto rr = __builtin_amdgcn_permlane32_swap(__float_as_uint(ps), __float_as_uint(ps), false, false);
      ps = __uint_as_float(rr[0]) + __uint_as_float(rr[1]); }
    l_reg = l_reg * alpha + ps;
    PK4(p0, 0, pa0); PK4(p0, 8, pa1); PK4(p1, 0, pa2); PK4(p1, 8, pa3);
}
template <int KB>
__device__ __forceinline__ void qkt(f32x16& p0, f32x16& p1, const LAS char* K_lds, int r32, int hi, const bf16x8* qr) {
    const LAS char* kb[4];
#pragma unroll
    for (int dd = 0; dd < 4; ++dd) kb[dd] = K_lds + KB * SHM_K + KSWZ(r32, (dd * 16 + hi * 8) * 2);
#pragma unroll
    for (int d0 = 0; d0 < 8; ++d0) { const LAS char* a = kb[d0 & 3] + (d0 >> 2) * 128;
        bf16x8 b0 = *reinterpret_cast<const LAS bf16x8*>(a);
        bf16x8 b1 = *reinterpret_cast<const LAS bf16x8*>(a + 32 * 256);
        p0 = __builtin_amdgcn_mfma_f32_32x32x16_bf16(b0, qr[d0], p0, 0, 0, 0);
        p1 = __builtin_amdgcn_mfma_f32_32x32x16_bf16(b1, qr[d0], p1, 0, 0, 0); }
}
template <int VB>
__device__ __forceinline__ void pv_tile(f32x16* o, int vb0, bf16x8 pa0, bf16x8 pa1, bf16x8 pa2, bf16x8 pa3) {
#define TRRD(dst, off) asm volatile("ds_read_b64_tr_b16 %0, %1 offset:%2" : "=&v"(dst) : "v"(vb0), "i"(off) : "memory")
#define PV_D0(d0) do { s16x4 l0, l1, l2, l3, h0, h1, h2, h3; constexpr int b_ = VB * SHM_V + v_rd_off(d0, 0, 0); \
        TRRD(l0, b_); TRRD(h0, b_ + 2048); TRRD(l1, b_ + 4096); TRRD(h1, b_ + 6144); TRRD(l2, b_ + 8192); TRRD(h2, b_ + 10240); TRRD(l3, b_ + 12288); TRRD(h3, b_ + 14336); \
        asm volatile("s_waitcnt lgkmcnt(0)" ::: "memory"); SBAR();   \
        o[d0] = __builtin_amdgcn_mfma_f32_32x32x16_bf16(pa0, (bf16x8){l0[0], l0[1], l0[2], l0[3], h0[0], h0[1], h0[2], h0[3]}, o[d0], 0, 0, 0);   \
        o[d0] = __builtin_amdgcn_mfma_f32_32x32x16_bf16(pa1, (bf16x8){l1[0], l1[1], l1[2], l1[3], h1[0], h1[1], h1[2], h1[3]}, o[d0], 0, 0, 0);   \
        o[d0] = __builtin_amdgcn_mfma_f32_32x32x16_bf16(pa2, (bf16x8){l2[0], l2[1], l2[2], l2[3], h2[0], h2[1], h2[2], h2[3]}, o[d0], 0, 0, 0);   \
        o[d0] = __builtin_amdgcn_mfma_f32_32x32x16_bf16(pa3, (bf16x8){l3[0], l3[1], l3[2], l3[3], h3[0], h3[1], h3[2], h3[3]}, o[d0], 0, 0, 0); } while (0)
    PV_D0(0); PV_D0(1); PV_D0(2); PV_D0(3);
#undef PV_D0
#undef TRRD
}
__device__ __forceinline__ float suffix32(const f32x16& x, f32x16& aft, float base, int hi) {
    float c0[4], c1[4];
#pragma unroll
    for (int g = 0; g < 4; ++g) { const float c = (x[4 * g] + x[4 * g + 1]) + (x[4 * g + 2] + x[4 * g + 3]);
        auto rr = __builtin_amdgcn_permlane32_swap(__float_as_uint(c), __float_as_uint(c), false, false);
        c0[g] = __uint_as_float(rr[0]); c1[g] = __uint_as_float(rr[1]); }
    float s = base;
#pragma unroll
    for (int g = 3; g >= 0; --g) { const float sx1 = s; s += c1[g]; const float sx0 = s; s += c0[g];
        const float sx = hi ? sx1 : sx0;
        aft[4 * g + 3] = sx; aft[4 * g + 2] = aft[4 * g + 3] + x[4 * g + 3]; aft[4 * g + 1] = aft[4 * g + 2] + x[4 * g + 2]; aft[4 * g] = aft[4 * g + 1] + x[4 * g + 1]; }
    return s;
}

template <int MODE>
__device__ __forceinline__ void attn_block(const bf16* __restrict__ Qb, const bf16* __restrict__ Kh, const bf16* __restrict__ Vh, bf16* __restrict__ Ob, int P0, LAS char* lds, int toff_mul, int toff_add) {
    int tid = threadIdx.x; asm volatile("" : "+v"(tid));
    const int wid = __builtin_amdgcn_readfirstlane(tid >> 6), lane = tid & 63, r32 = lane & 31, hi = lane >> 5;
    LAS char* V_lds = lds + L_V; LAS char* K_lds = lds + L_K;
    LAS float* wsf = (LAS float*)(lds + L_WS) + wid * 64; LAS float* li_l = wsf; LAS float* al_l = wsf + 32;
    const LAS float* tab = (const LAS float*)(lds + L_TAB);
    bf16x8 qr[8];
    { const bf16* qrow = Qb + (size_t)(wid * QBLK + r32) * QPITCH + hi * 8;
#pragma unroll
      for (int d0 = 0; d0 < 8; ++d0) qr[d0] = *(const GAS bf16x8*)(qrow + d0 * 16); }
    const int qlo = P0 + wid * QBLK, qpos = qlo + r32, qm = qpos - 4 * hi;
    const int NT = P0 / KVBLK + 4;
    const int sr = tid >> 4, sc = (tid & 15) * 8;
    const int kws = KSWZ(sr, sc * 2), vst0 = v_st(sr, sc), vst1 = v_st(32 + sr, sc);
    const int vb0 = (int)(unsigned)(uintptr_t)V_lds + v_rd_base(lane);
    const int tl = toff_mul * qpos + toff_add + 4 * hi;
    float m_reg = -1e30f, l_reg = 0.f, R = 0.f;
    f32x16 o[4];
#pragma unroll
    for (int d = 0; d < 4; ++d)
#pragma unroll
        for (int r = 0; r < 16; ++r) o[d][r] = 0.f;
    for (int it = 0; it < NT; ++it) {
        const int t = (MODE == 1) ? NT - 1 - it : it;
        const int kb = t * KVBLK;
        __syncthreads();
        { const bf16* kp = Kh + (size_t)(kb + sr) * QPITCH + sc; const bf16* vp = Vh + (size_t)(kb + sr) * QPITCH + sc;
          const bf16x8 k0 = *(const GAS bf16x8*)kp, k1 = *(const GAS bf16x8*)(kp + (size_t)32 * QPITCH);
          const bf16x8 v0 = *(const GAS bf16x8*)vp, v1 = *(const GAS bf16x8*)(vp + (size_t)32 * QPITCH);
          *(LAS bf16x8*)(K_lds + kws) = k0; *(LAS bf16x8*)(K_lds + kws + 32 * 256) = k1;
          *(LAS bf16x8*)(V_lds + vst0) = v0; *(LAS bf16x8*)(V_lds + vst1) = v1; }
        __syncthreads();
        if (kb <= qlo + QBLK - 1) {
            f32x16 p0, p1; bf16x8 pa0, pa1, pa2, pa3;
            if (MODE == 0) {
                const LAS float* tp = tab + (tl + kb);
#pragma unroll
                for (int r = 0; r < 16; ++r) { const int c = (r & 3) + 8 * (r >> 2); p0[r] = tp[c]; p1[r] = tp[c + 32]; }
            } else {
#pragma unroll
                for (int r = 0; r < 16; ++r) { p0[r] = 0.f; p1[r] = 0.f; }
            }
            qkt<0>(p0, p1, K_lds, r32, hi, qr);
            if (MODE == 0) {
                if (kb + KVBLK - 1 > qlo) mask_tile<false>(p0, p1, qm - kb);
                float mn, alpha;
                partialSM(p0, p1, m_reg, mn, alpha);
                if (__any(alpha < 1.f)) { if (hi == 0) al_l[r32] = alpha; LDS_WAIT();
#pragma unroll
                    for (int d_ = 0; d_ < 4; ++d_)
#pragma unroll
                        for (int r = 0; r < 16; ++r) o[d_][r] *= al_l[crow(r, hi)]; }
                finishSM(p0, p1, alpha, l_reg, pa0, pa1, pa2, pa3);
            } else {
                f32x16 x0, x1;
#pragma unroll
                for (int r = 0; r < 16; ++r) { const float y = p0[r] * C2; const float L = __builtin_amdgcn_logf(1.0f + __builtin_amdgcn_exp2f(-fabsf(y))); const float lb = fminf(y, 0.f) - L; p0[r] = lb; x0[r] = lb - y; }
#pragma unroll
                for (int r = 0; r < 16; ++r) { const float y = p1[r] * C2; const float L = __builtin_amdgcn_logf(1.0f + __builtin_amdgcn_exp2f(-fabsf(y))); const float lb = fminf(y, 0.f) - L; p1[r] = lb; x1[r] = lb - y; }
                if (kb + KVBLK - 1 >= qlo) {
                    const int dq = qm - kb; const float NEG = -__builtin_inff();
#pragma unroll
                    for (int r = 0; r < 16; ++r) { const int c = (r & 3) + 8 * (r >> 2);
                        if (dq - c < 1) { p0[r] = NEG; x0[r] = 0.f; }
                        if (dq - c - 32 < 1) { p1[r] = NEG; x1[r] = 0.f; } }
                }
                f32x16 a0, a1;
                const float s1 = suffix32(x1, a1, R, hi);
                const float s0 = suffix32(x0, a0, s1, hi);
                R = s0;
#pragma unroll
                for (int r = 0; r < 16; ++r) { p0[r] = __builtin_amdgcn_exp2f(p0[r] + a0[r]); p1[r] = __builtin_amdgcn_exp2f(p1[r] + a1[r]); }
                PK4(p0, 0, pa0); PK4(p0, 8, pa1); PK4(p1, 0, pa2); PK4(p1, 8, pa3);
            }
            SBAR();
            pv_tile<0>(o, vb0, pa0, pa1, pa2, pa3);
        }
    }
    float rli[16];
    if (MODE == 0) {
        if (hi == 0) li_l[r32] = l_reg; LDS_WAIT();
#pragma unroll
        for (int r = 0; r < 16; ++r) rli[r] = __builtin_amdgcn_rcpf(li_l[crow(r, hi)]);
    } else {
#pragma unroll
        for (int r = 0; r < 16; ++r) rli[r] = 1.f;
    }
    bf16* Ow = Ob + (size_t)(wid * QBLK) * OPITCH;
#pragma unroll
    for (int r = 0; r < 16; ++r) { const int orow = crow(r, hi);
#pragma unroll
        for (int d0 = 0; d0 < 4; ++d0) { const float v = o[d0][r] * rli[r];
            const float vn = __shfl_xor(v, 1);
            if ((r32 & 1) == 0) *(GAS unsigned*)(Ow + (size_t)orow * OPITCH + d0 * 32 + r32) = cvtpk(v, vn); } }
}
#undef PK4
}

__device__ __forceinline__ int t5_bucket(int d) {
    if (d < 16) return d;
    int b = 16;
    b += (d >= 22); b += (d >= 30); b += (d >= 40); b += (d >= 54); b += (d >= 73); b += (d >= 99); b += (d >= 134); b += (d >= 182);
    b += (d >= 246); b += (d >= 332); b += (d >= 450); b += (d >= 609); b += (d >= 825); b += (d >= 1117); b += (d >= 1513);
    return b;
}

struct Args {
    const float* x; const float* norm_g; const float* w_gate; const float* w_up; const float* w_down;
    const float* w_in[4]; const float* b_f0; const float* b_f3; const float* w_out; const float* rel_bias; const float* final_g;
    float* out; unsigned char* ws; int ph_lo, ph_hi;
};
static_assert(sizeof(Args) == 16 * 8 + 8, "Args has no padding");

__global__ void __launch_bounds__(NWAVES * 64, 2) mk_fwd(Args a) {
    extern __shared__ __attribute__((aligned(16))) unsigned char lds_raw[];
    LAS unsigned char* lds = (LAS unsigned char*)lds_raw;
    volatile LAS unsigned* MISC = (volatile LAS unsigned*)(lds + MISC_OFF);
    const int G = gridDim.x; const int bx = blockIdx.x; const int vcu = (G % 8 == 0) ? (bx % 8) * (G / 8) + bx / 8 : bx;
    unsigned char* ws = a.ws;
    gu32* ctl = (gu32*)(ws + WS_CTL);
    if (threadIdx.x < 64) MISC[threadIdx.x] = 0u;
    __syncthreads();
    const int lo = a.ph_lo, hi = a.ph_hi;
    XcdBarrier bar; bar.bar = (unsigned*)(ctl + CW_BAR); bar.x = 0; bar.st = nullptr;
    if (hi - lo > 1) bar = xcd_barrier_post((unsigned*)(ctl + CW_BAR), MISC + 8);
#define RUN(k) (lo <= (k) && (k) < hi)
#define SEAM(k) do { if (RUN(k) && RUN((k) + 1)) xcd_barrier(bar); } while (0)

    bf16* const Hb = (bf16*)(ws + WS_H); bf16* const AO = (bf16*)(ws + WS_AO); bf16* const ACT = (bf16*)(ws + WS_ACT); bf16* const QKV = (bf16*)(ws + WS_ACT);
    float* const LF = (float*)(ws + WS_LF);
    const int NGW = G * NWAVES;
    int ph = 0;
#define LANE_IDS() const int tid = opaque_tid(), lane = tid & 63, wave = __builtin_amdgcn_readfirstlane(tid >> 6), gw = vcu * NWAVES + wave; (void)lane; (void)gw

    if (RUN(ph)) REP(1) {
        LANE_IDS();
        LAS float* scr = (LAS float*)(lds + wave * 16640);
        constexpr int I_G = (DM / 64) * (FF / 64), I_D = (FF / 64) * (DM / 64), I_Q = (DM / 64) * (NQKV / 64), I_O = (DM / 64) * (DM / 64);
        constexpr int PER_LAYER = 6 * I_G + I_Q + I_O;
        static_assert(I_G == I_D, "items");
        for (int it = gw; it < DEPTH * PER_LAYER; it += NGW) {
            const int l = it / PER_LAYER; int r = it - l * PER_LAYER;
            if (r < 6 * I_G) {
                const int mm = r / I_G, idx = r - mm * I_G, kind = mm >> 1, f = mm & 1;
                if (kind < 2) {
                    const float* W = (kind == 0 ? a.w_gate : a.w_up) + (size_t)(l * 2 + f) * DM * FF;
                    const int nblk = FF / 64, kb = idx / nblk, nb = idx - kb * nblk, n0 = nb * 64;
                    transpose_item(W, FF, DM, (bf16*)(ws + WS_WGU + (size_t)(l * 2 + f) * SZ_WGU), kb * 64, n0, (n0 >> 7) * 256 + (n0 & 127) + kind * 128, a.norm_g + (size_t)(l * 3 + 2 * f) * DM, scr, lane);
                } else {
                    const float* W = a.w_down + (size_t)(l * 2 + f) * FF * DM;
                    const int nblk = DM / 64, kb = idx / nblk, nb = idx - kb * nblk;
                    transpose_item(W, DM, FF, (bf16*)(ws + WS_WD + (size_t)(l * 2 + f) * SZ_WD), kb * 64, nb * 64, nb * 64, nullptr, scr, lane);
                }
            } else { r -= 6 * I_G;
                if (r < I_Q) {
                    const float* W = a.w_in[l]; const int ldw = (l == 0 || l == 3) ? NQKV + NH : NQKV;
                    const int nblk = NQKV / 64, kb = r / nblk, nb = r - kb * nblk;
                    transpose_item(W, ldw, DM, (bf16*)(ws + WS_WQKV + (size_t)l * SZ_WQKV), kb * 64, nb * 64, nb * 64, a.norm_g + (size_t)(l * 3 + 1) * DM, scr, lane);
                } else { r -= I_Q;
                    const float* W = a.w_out + (size_t)l * DM * DM;
                    const int nblk = DM / 64, kb = r / nblk, nb = r - kb * nblk;
                    transpose_item(W, DM, DM, (bf16*)(ws + WS_WO + (size_t)l * SZ_WO), kb * 64, nb * 64, nb * 64, nullptr, scr, lane);
                }
            }
        }
    }
    if (RUN(ph)) REP(1) {
        LANE_IDS();
        for (int idx = bx * (NWAVES * 64) + tid; idx < 2 * 16 * DM; idx += G * NWAVES * 64) {
            const int sl = idx >> 15, n = (idx >> 11) & 15, k = idx & (DM - 1), l = sl ? 3 : 0;
            const float w = a.w_in[l][(size_t)k * (NQKV + NH) + NQKV + n] * a.norm_g[(size_t)(l * 3 + 1) * DM + k];
            ((bf16*)(ws + WS_WF))[idx] = (bf16)(cvtpk(w, 0.f) & 0xffffu);
        }
        float* const part = (float*)(ws + WS_PART);
        for (int m = gw; m < M; m += NGW) {
            const GAS f32x4* xr = (const GAS f32x4*)(a.x + (size_t)m * DM) + lane;
            f32x4 v[8]; float ss = 0.f;
#pragma unroll
            for (int j = 0; j < 8; ++j) { v[j] = xr[64 * j]; ss += (v[j].x * v[j].x + v[j].y * v[j].y) + (v[j].z * v[j].z + v[j].w * v[j].w); }
            ss = wave_sum(ss);
            GAS v2u* o8 = (GAS v2u*)(Hb + (size_t)m * DM) + lane;
#pragma unroll
            for (int j = 0; j < 8; ++j) { v2u w; w.x = cvtpk(v[j].x, v[j].y); w.y = cvtpk(v[j].z, v[j].w); o8[64 * j] = w; }
            if (lane < 32) part[(size_t)m * 32 + lane] = (lane == 0) ? ss : 0.f;
        }
    }
    SEAM(ph); ++ph;

    for (int sb = 0; sb < 3 * DEPTH; ++sb) {
        const int l = sb / 3, ty = sb - 3 * l;
        const float* xsrc = (sb == 0) ? a.x : (const float*)a.out;
        if (ty != 1) {
            const int f = ty >> 1;
            if (RUN(ph)) REP(3) {
                pg8::Gemm g{Hb, (const bf16*)(ws + WS_WGU + (size_t)(l * 2 + f) * SZ_WGU), M, NGU, DM}; pg8::StaticOrder S; S.init(M, NGU, G, bx);
                pg8::Unit u0; S.next(0, u0); pg8::build_rstd_table((LAS float*)(lds + RST_OFF), (const float*)(ws + WS_PART), u0.pm, opaque_tid());
                pg8::EpiSwiGLU E{ACT, FF, (const float*)(ws + WS_PART), (const LAS float*)(lds + RST_OFF), u0.pm};
                pg8::gemm_phase<pg8::EpiSwiGLU, pg8::StaticOrder, true, true>(lds + RING_OFF, g, S, E);
            }
            SEAM(ph); ++ph;
            if (RUN(ph)) REP(6) {
                pg8::Gemm g{ACT, (const bf16*)(ws + WS_WD + (size_t)(l * 2 + f) * SZ_WD), M, DM, FF}; pg8::StaticOrder S; S.init(M, DM, G, bx);
                pg8::EpiResid E{xsrc, (PROBE_DUP == 6 && rep_ == 0) ? (float*)(ws + WS_END) : a.out, Hb, (float*)(ws + WS_PART), DM, 0.5f};
                pg8::gemm_phase<pg8::EpiResid, pg8::StaticOrder, true, true>(lds + RING_OFF, g, S, E);
            }
            SEAM(ph); ++ph;
        } else {
            if (RUN(ph) && (l == 0 || l == 3)) {
                LANE_IDS();
                const int fr = lane & 15, fq = lane >> 4;
                const bf16* wf = (const bf16*)(ws + WS_WF) + (size_t)(l ? 1 : 0) * 16 * DM + (size_t)fr * DM + 8 * fq;
                const float* bfp = (l == 0) ? a.b_f0 : a.b_f3;
                for (int rg = gw; rg < M / 16; rg += NGW) {
                    const bf16* ap = Hb + (size_t)(rg * 16 + fr) * DM + 8 * fq;
                    f32x4 acc = {0.f, 0.f, 0.f, 0.f};
#pragma unroll 8
                    for (int k0 = 0; k0 < DM; k0 += 32) { const bf16x8 av = *(const GAS bf16x8*)(ap + k0), bv = *(const GAS bf16x8*)(wf + k0);
                        acc = __builtin_amdgcn_mfma_f32_16x16x32_bf16(bv, av, acc, 0, 0, 0); }
                    const float r = pg8::row_rstd((const float*)(ws + WS_PART), rg * 16 + fr, fq);
                    const f32x4 bb = *(const GAS f32x4*)(bfp + 4 * fq);
                    f32x4 o;
#pragma unroll
                    for (int i = 0; i < 4; ++i) { const float z = acc[i] * r + bb[i]; o[i] = fminf(z, 0.f) - __logf(1.0f + __expf(-fabsf(z))); }
                    *(GAS f32x4*)(LF + (size_t)(rg * 16 + fr) * 16 + 4 * fq) = o;
                }
            }
            if (RUN(ph)) REP(4) {
                pg8::Gemm g{Hb, (const bf16*)(ws + WS_WQKV + (size_t)l * SZ_WQKV), M, NQKV, DM}; pg8::StaticOrder S; S.init(M, NQKV, G, bx);
                pg8::Unit u0; S.next(0, u0); pg8::build_rstd_table((LAS float*)(lds + RST_OFF), (const float*)(ws + WS_PART), u0.pm, opaque_tid());
                pg8::EpiBf16 E{QKV, NQKV, (const float*)(ws + WS_PART), (const LAS float*)(lds + RST_OFF), u0.pm};
                pg8::gemm_phase<pg8::EpiBf16, pg8::StaticOrder, true, true>(lds + RING_OFF, g, S, E);
            }
            SEAM(ph); ++ph;
            if (RUN(ph)) REP(5) {
                LANE_IDS();
                const int mixer = l % 3;
                LAS char* al = (LAS char*)(lds + RING_OFF);
                LAS float* tab = (LAS float*)(al + att::L_TAB);
                LAS float* scan = (LAS float*)(al + att::L_SCAN);
                for (int L = vcu; L < NBATCH * NH * 4; L += G) {
                    const int bh = L >> 2, xq = L & 3, b = bh >> 4, h = bh & 15;
                    const bf16* Qh = QKV + (size_t)b * SEQ * NQKV + h * HD; const bf16* Kh = Qh + DM; const bf16* Vh = Qh + 2 * DM;
                    bf16* Oh = AO + (size_t)b * SEQ * DM + h * HD;
                    __syncthreads();
                    int tmul = 0, tadd = 0;
                    if (mixer == 0) {
                        const float* lf = LF + (size_t)b * SEQ * 16 + h;
                        const float v0 = lf[(size_t)(4 * tid) * 16], v1 = lf[(size_t)(4 * tid + 1) * 16], v2 = lf[(size_t)(4 * tid + 2) * 16], v3 = lf[(size_t)(4 * tid + 3) * 16];
                        const float a0 = v0, a1 = a0 + v1, a2 = a1 + v2, a3 = a2 + v3;
                        float inc = a3;
#pragma unroll
                        for (int d = 1; d < 64; d <<= 1) { const float y = __shfl_up(inc, d); if (lane >= d) inc += y; }
                        if (lane == 63) scan[wave] = inc;
                        __syncthreads();
                        float pre = inc - a3;
                        for (int w = 0; w < wave; ++w) pre += scan[w];
                        const float ns = -11.313708498984761f;
                        tab[4 * tid] = (pre + a0) * ns; tab[4 * tid + 1] = (pre + a1) * ns; tab[4 * tid + 2] = (pre + a2) * ns; tab[4 * tid + 3] = (pre + a3) * ns;
                    } else if (mixer == 1) {
                        const float* rb = a.rel_bias + h * 32;
                        for (int j = tid; j < att::TAB_N; j += NWAVES * 64) {
                            const int d = 2047 - j; float v = 0.f;
                            if (d >= 0) { const int mult = (d <= 128 ? 1 : 0) + (((d & 3) == 0 && d <= 512) ? 1 : 0) + (((d & 15) == 0) ? 1 : 0);
                                v = (mult == 0) ? -__builtin_inff() : (rb[t5_bucket(d)] + (mult == 1 ? 0.f : (mult == 2 ? 0.6931471805599453f : 1.0986122886681098f))) * 11.313708498984761f; }
                            tab[j] = v; }
                        tmul = -1; tadd = 2047;
                    }
#pragma unroll 1
                    for (int pass = 0; pass < 2; ++pass) {
                        const int qb = pass ? 7 - xq : xq, P0 = qb * att::QB;
                        if (mixer == 2) att::attn_block<1>(Qh + (size_t)P0 * NQKV, Kh, Vh, Oh + (size_t)P0 * DM, P0, al, 0, 0);
                        else att::attn_block<0>(Qh + (size_t)P0 * NQKV, Kh, Vh, Oh + (size_t)P0 * DM, P0, al, tmul, tadd);
                    }
                }
            }
            SEAM(ph); ++ph;
            if (RUN(ph)) REP(7) {
                pg8::Gemm g{AO, (const bf16*)(ws + WS_WO + (size_t)l * SZ_WO), M, DM, DM}; pg8::StaticOrder S; S.init(M, DM, G, bx);
                pg8::EpiResid E{a.out, (PROBE_DUP == 7 && rep_ == 0) ? (float*)(ws + WS_ACT) : a.out, Hb, (float*)(ws + WS_PART), DM, 1.0f};
                pg8::gemm_phase<pg8::EpiResid, pg8::StaticOrder, true, true>(lds + RING_OFF, g, S, E);
            }
            SEAM(ph); ++ph;
        }
    }
    if (RUN(ph)) {
        LANE_IDS();
        f32x4 gv[8];
#pragma unroll
        for (int j = 0; j < 8; ++j) gv[j] = *((const GAS f32x4*)a.final_g + lane + 64 * j);
        for (int m = gw; m < M; m += NGW) {
            GAS f32x4* xr = (GAS f32x4*)(a.out + (size_t)m * DM) + lane;
            f32x4 v[8]; float ss = 0.f;
#pragma unroll
            for (int j = 0; j < 8; ++j) { v[j] = xr[64 * j]; ss += (v[j].x * v[j].x + v[j].y * v[j].y) + (v[j].z * v[j].z + v[j].w * v[j].w); }
            const float rstd = 1.0f / sqrtf(wave_sum(ss) * (1.0f / DM) + RMS_EPS);
#pragma unroll
            for (int j = 0; j < 8; ++j) xr[64 * j] = v[j] * rstd * gv[j];
        }
    }
#undef RUN
#undef SEAM
}
constexpr int N_PHASES = 1 + DEPTH * 7 + 1;

extern "C" void kernel_launch(void* const* d_in, const int* in_sizes, int n_in, void* d_out, int out_size, void* d_ws, size_t ws_size, hipStream_t stream) {
    static int grid = 0;
    if (grid == 0) {
        if (n_in != 14 || in_sizes[0] != M * DM || out_size != M * DM || ws_size < WS_END + (PROBE_DUP == 6 ? (size_t)M * DM * 4 : 0)) {
            fprintf(stderr, "kernel_launch: unexpected shapes (n_in %d, in0 %d, out %d, ws %zu < %zu?); nothing launched\n", n_in, n_in > 0 ? in_sizes[0] : -1, out_size, ws_size, (size_t)WS_END); grid = -1; return; }
        int dev = 0, cus = 0;
        if (hipGetDevice(&dev) != hipSuccess || hipDeviceGetAttribute(&cus, hipDeviceAttributeMultiprocessorCount, dev) != hipSuccess) { grid = -1; return; }
        if (hipFuncSetAttribute((const void*)mk_fwd, hipFuncAttributeMaxDynamicSharedMemorySize, LDS_BYTES) != hipSuccess) { fprintf(stderr, "kernel_launch: hipFuncSetAttribute failed\n"); grid = -1; return; }
        int per_cu = 0;
        if (hipOccupancyMaxActiveBlocksPerMultiprocessor(&per_cu, (const void*)mk_fwd, NWAVES * 64, LDS_BYTES) != hipSuccess || per_cu < 1)
            fprintf(stderr, "kernel_launch: note: occupancy query reports %d workgroups per CU\n", per_cu);
        (void)hipGetLastError();
        grid = cus;
    }
    if (grid < 0) return;
    if (hipMemsetAsync((char*)d_ws + WS_CTL, 0, CTL_ZERO_BYTES, stream) != hipSuccess) return;
    Args a{};
    a.x = (const float*)d_in[0]; a.norm_g = (const float*)d_in[1]; a.w_gate = (const float*)d_in[2]; a.w_up = (const float*)d_in[3]; a.w_down = (const float*)d_in[4];
    a.w_in[0] = (const float*)d_in[5]; a.b_f0 = (const float*)d_in[6]; a.w_in[1] = (const float*)d_in[7]; a.w_in[2] = (const float*)d_in[8]; a.w_in[3] = (const float*)d_in[9];
    a.b_f3 = (const float*)d_in[10]; a.w_out = (const float*)d_in[11]; a.rel_bias = (const float*)d_in[12]; a.final_g = (const float*)d_in[13];
    a.out = (float*)d_out; a.ws = (unsigned char*)d_ws;
#if MK_ONE_LAUNCH
    a.ph_lo = 0; a.ph_hi = N_PHASES;
    hipLaunchKernelGGL(mk_fwd, dim3(grid), dim3(NWAVES * 64), LDS_BYTES, stream, a);
#else
    for (int p = 0; p < N_PHASES; ++p) { a.ph_lo = p; a.ph_hi = p + 1; hipLaunchKernelGGL(mk_fwd, dim3(grid), dim3(NWAVES * 64), LDS_BYTES, stream, a); }
#endif
    const hipError_t le = hipPeekAtLastError();
    if (le != hipSuccess) fprintf(stderr, "kernel_launch: launch failed: %s\n", hipGetErrorName(le));
}
```

```cpp
#include <hip/hip_runtime.h>
#include <cstdio>
#include <cstdint>

#ifndef PROBE_DUP
#define PROBE_DUP 0
#endif
#define REP(k) _Pragma("unroll 1") for (int rep_ = 0; rep_ < ((PROBE_DUP == (k)) ? 2 : 1); ++rep_)
#ifndef MK_ONE_LAUNCH
#define MK_ONE_LAUNCH 1
#endif

namespace pg8 {
#define PG8_LAS __attribute__((address_space(3)))
typedef unsigned short bf16_t;
typedef short bf16x8 __attribute__((ext_vector_type(8)));
typedef float f32x4 __attribute__((ext_vector_type(4)));
typedef unsigned u32x4 __attribute__((ext_vector_type(4)));
constexpr int BM = 256, BK = 64, HALF = 128, HTB = HALF * BK * 2, STAGE_BYTES = 8 * HTB, NXCD = 8, WGM = 8;

__host__ __device__ __forceinline__ int lds_byte(int r, int c) { const int st = (r >> 4) * 2 + (c >> 5), rr = r & 15, cc = c & 31, ob = rr * 64 + cc * 2; return st * 1024 + (ob ^ (((ob >> 9) & 1) << 5)); }
__host__ __device__ __forceinline__ void stage_rc(int b, int& R, int& C) { const int st = b / 1024, sb = b % 1024, swz = sb ^ (((sb >> 9) & 1) << 5); R = (st >> 1) * 16 + swz / 64; C = (st & 1) * 32 + (swz % 64) / 2; }
__host__ __device__ __forceinline__ int perm32(int rho) { const int n = rho >> 4, i = rho & 15; return 8 * (i >> 2) + 4 * n + (i & 3); }

struct Unit { int pm, pn; };
struct Gemm { const bf16_t* A; const bf16_t* Bt; int M, N, K; };

struct StaticOrder {
    int nM, nN, nwg, G, c;
    __host__ __device__ void init(int M, int N, int G_, int c_) { nM = M / BM; nN = N / BM; nwg = nM * nN; G = G_; c = c_; }
    __host__ __device__ bool next(int i, Unit& u) const {
        const long L = (long)i * G + c; if (L >= nwg) return false;
        int wgid = (int)L; { const int q = nwg / NXCD, r = nwg % NXCD, xcd = wgid % NXCD, off = wgid / NXCD; wgid = (xcd < r ? xcd * (q + 1) : r * (q + 1) + (xcd - r) * q) + off; }
        const int nig = WGM * nN, gid = wgid / nig, fm = gid * WGM, gsz = (nM - fm) < WGM ? (nM - fm) : WGM;
        u.pm = fm + ((wgid % nig) % gsz); u.pn = (wgid % nig) / gsz; return true;
    }
    __device__ __forceinline__ void a_ready(const Unit&) const {}
    __device__ __forceinline__ void done(const Unit&) const {}
};

__device__ __forceinline__ unsigned cvt_pk_bf16(float lo, float hi) { unsigned r; asm volatile("v_cvt_pk_bf16_f32 %0, %1, %2" : "=v"(r) : "v"(lo), "v"(hi)); return r; }

__device__ __forceinline__ float fq_sum(float s) {
    { auto rr = __builtin_amdgcn_permlane16_swap(__float_as_uint(s), __float_as_uint(s), false, false); s = __uint_as_float(rr[0]) + __uint_as_float(rr[1]); }
    { auto rr = __builtin_amdgcn_permlane32_swap(__float_as_uint(s), __float_as_uint(s), false, false); s = __uint_as_float(rr[0]) + __uint_as_float(rr[1]); }
    return s;
}
__device__ __forceinline__ float row_rstd(const float* part, int row, int fq) {
    const f32x4 a = *(const f32x4*)(part + (size_t)row * 32 + fq * 8), b = *(const f32x4*)(part + (size_t)row * 32 + fq * 8 + 4);
    const float s = fq_sum(((a[0] + a[1]) + (a[2] + a[3])) + ((b[0] + b[1]) + (b[2] + b[3])));
    return __builtin_amdgcn_rsqf(s * (1.0f / 2048.0f) + 1e-6f);
}
__device__ __forceinline__ void build_rstd_table(PG8_LAS float* rst, const float* part, int pm0, int tid) {
    if (tid < 256) { const f32x4* p = (const f32x4*)(part + (size_t)(pm0 * BM + tid) * 32); float s = 0.f;
#pragma unroll
        for (int j = 0; j < 8; ++j) { const f32x4 v = p[j]; s += (v[0] + v[1]) + (v[2] + v[3]); }
        rst[tid] = __builtin_amdgcn_rsqf(s * (1.0f / 2048.0f) + 1e-6f); }
    __syncthreads();
}
struct EpiBf16 {
    static constexpr bool PERM = true, AFTER_DRAIN = false;
    bf16_t* O; int ldc; const float* part; const PG8_LAS float* rst; int pm0;
    __device__ __forceinline__ void operator()(const f32x4 (&acc)[2][2][4][2], const Unit& u, int wr, int wc, int fr, int fq) const {
        const int row0 = u.pm * BM + wr * 64 + fr, col0 = u.pn * BM + wc * 32 + 8 * fq;
        float rs[2][4];
        if (u.pm == pm0) {
#pragma unroll
            for (int ai = 0; ai < 2; ++ai)
#pragma unroll
                for (int m = 0; m < 4; ++m) rs[ai][m] = rst[wr * 64 + fr + ai * HALF + m * 16];
        } else {
#pragma unroll
            for (int ai = 0; ai < 2; ++ai)
#pragma unroll
                for (int m = 0; m < 4; ++m) rs[ai][m] = row_rstd(part, row0 + ai * HALF + m * 16, fq);
        }
#pragma unroll
        for (int ai = 0; ai < 2; ++ai)
#pragma unroll
            for (int m = 0; m < 4; ++m) { bf16_t* rowp = O + (size_t)(row0 + ai * HALF + m * 16) * ldc + col0; const float r = rs[ai][m];
#pragma unroll
                for (int bj = 0; bj < 2; ++bj) { const f32x4 v0 = acc[ai][bj][m][0] * r, v1 = acc[ai][bj][m][1] * r;
                    u32x4 w; w.x = cvt_pk_bf16(v0[0], v0[1]); w.y = cvt_pk_bf16(v0[2], v0[3]); w.z = cvt_pk_bf16(v1[0], v1[1]); w.w = cvt_pk_bf16(v1[2], v1[3]);
                    *(u32x4*)(rowp + bj * HALF) = w; } }
    }
};
__device__ __forceinline__ float silu_mul(float g, float u) { const float e = __builtin_amdgcn_exp2f(g * -1.4426950408889634f); return g * __builtin_amdgcn_rcpf(1.0f + e) * u; }
struct EpiSwiGLU {
    static constexpr bool PERM = true, AFTER_DRAIN = false;
    bf16_t* O; int ldc; const float* part; const PG8_LAS float* rst; int pm0;
    __device__ __forceinline__ void operator()(const f32x4 (&acc)[2][2][4][2], const Unit& u, int wr, int wc, int fr, int fq) const {
        const int row0 = u.pm * BM + wr * 64 + fr, col0 = u.pn * HALF + wc * 32 + 8 * fq;
        float rs[2][4];
        if (u.pm == pm0) {
#pragma unroll
            for (int ai = 0; ai < 2; ++ai)
#pragma unroll
                for (int m = 0; m < 4; ++m) rs[ai][m] = rst[wr * 64 + fr + ai * HALF + m * 16];
        } else {
#pragma unroll
            for (int ai = 0; ai < 2; ++ai)
#pragma unroll
                for (int m = 0; m < 4; ++m) rs[ai][m] = row_rstd(part, row0 + ai * HALF + m * 16, fq);
        }
#pragma unroll
        for (int ai = 0; ai < 2; ++ai)
#pragma unroll
            for (int m = 0; m < 4; ++m) { bf16_t* rowp = O + (size_t)(row0 + ai * HALF + m * 16) * ldc + col0; const float r = rs[ai][m];
                const f32x4 g0 = acc[ai][0][m][0] * r, g1 = acc[ai][0][m][1] * r, u0 = acc[ai][1][m][0] * r, u1 = acc[ai][1][m][1] * r;
                u32x4 w; w.x = cvt_pk_bf16(silu_mul(g0[0], u0[0]), silu_mul(g0[1], u0[1])); w.y = cvt_pk_bf16(silu_mul(g0[2], u0[2]), silu_mul(g0[3], u0[3]));
                w.z = cvt_pk_bf16(silu_mul(g1[0], u1[0]), silu_mul(g1[1], u1[1])); w.w = cvt_pk_bf16(silu_mul(g1[2], u1[2]), silu_mul(g1[3], u1[3]));
                *(u32x4*)rowp = w; }
    }
};
struct EpiResid {
    static constexpr bool PERM = true, AFTER_DRAIN = false;
    const float* base; float* out; bf16_t* xb; float* part; int ldc; float alpha;
    __device__ __forceinline__ void operator()(const f32x4 (&acc)[2][2][4][2], const Unit& u, int wr, int wc, int fr, int fq) const {
        const int row0 = u.pm * BM + wr * 64 + fr, col0 = u.pn * BM + wc * 32 + 8 * fq;
#pragma unroll
        for (int ai = 0; ai < 2; ++ai)
#pragma unroll
            for (int m = 0; m < 4; ++m) { const int row = row0 + ai * HALF + m * 16; const size_t off = (size_t)row * ldc + col0; float s = 0.f;
#pragma unroll
                for (int bj = 0; bj < 2; ++bj) { const f32x4 b0 = *(const f32x4*)(base + off + bj * HALF), b1 = *(const f32x4*)(base + off + bj * HALF + 4);
                    const f32x4 o0 = b0 + alpha * acc[ai][bj][m][0], o1 = b1 + alpha * acc[ai][bj][m][1];
                    *(f32x4*)(out + off + bj * HALF) = o0; *(f32x4*)(out + off + bj * HALF + 4) = o1;
                    u32x4 w; w.x = cvt_pk_bf16(o0[0], o0[1]); w.y = cvt_pk_bf16(o0[2], o0[3]); w.z = cvt_pk_bf16(o1[0], o1[1]); w.w = cvt_pk_bf16(o1[2], o1[3]);
                    *(u32x4*)(xb + off + bj * HALF) = w;
                    s += ((o0[0] * o0[0] + o0[1] * o0[1]) + (o0[2] * o0[2] + o0[3] * o0[3])) + ((o1[0] * o1[0] + o1[1] * o1[1]) + (o1[2] * o1[2] + o1[3] * o1[3])); }
                s = fq_sum(s);
                if (fq == 0) part[(size_t)row * 32 + u.pn * 4 + wc] = s;
                if (m & 1) asm volatile("" ::: "memory"); }
    }
};

template <class Epi, class Sched, bool ALIGN_EPI = false, bool SP2 = false>
__device__ __forceinline__ void gemm_phase(PG8_LAS unsigned char* lds, const Gemm g, const Sched& S, const Epi& E) {
    int tid = threadIdx.x; asm volatile("" : "+v"(tid));
    const int wid = __builtin_amdgcn_readfirstlane(tid >> 6), lane = tid & 63, wr = wid >> 2, wc = wid & 3, fr = lane & 15, fq = lane >> 4;
    const int K = g.K, nt = K / BK;
    unsigned voffA[2], voffB[2];
#pragma unroll
    for (int i = 0; i < 2; ++i) { int R, C; stage_rc(tid * 16 + i * 8192, R, C); const int Rb = Epi::PERM ? ((R & ~31) + perm32(R & 31)) : R;
        voffA[i] = (unsigned)(R * K + C) * 2u; voffB[i] = (unsigned)(Rb * K + C) * 2u; }
    const size_t kstep = (size_t)(BK * 2);
    const size_t hstep = (size_t)HALF * K * 2;
    const size_t tstep = 2 * hstep;
    const unsigned ldsw = (unsigned)wid * 1024u;
    const int aoff = lds_byte(wr * 64 + fr, fq * 8), boff = lds_byte(wc * 32 + fr, fq * 8);
#define PG8_SA(b, h) (((b) * 2 + (h)) * HTB)
#define PG8_SB(b, h) ((4 + (b) * 2 + (h)) * HTB)
#define PG8_STAGE(bufoff, gbase, voff) do { _Pragma("unroll") for (int _i = 0; _i < 2; ++_i) \
        __builtin_amdgcn_global_load_lds((const unsigned*)((const char*)(gbase) + (voff)[_i]), (PG8_LAS unsigned*)(lds + (bufoff) + ldsw + _i * 8192), 16, 0, 0); } while (0)
#define PG8_LDA(dst, b, h) do { _Pragma("unroll") for (int m = 0; m < 4; ++m) _Pragma("unroll") for (int k = 0; k < 2; ++k) dst[m][k] = *(const PG8_LAS bf16x8*)(lds + PG8_SA(b, h) + aoff + m * 2048 + k * 1024); } while (0)
#define PG8_LDB(dst, b, h) do { _Pragma("unroll") for (int n = 0; n < 2; ++n) _Pragma("unroll") for (int k = 0; k < 2; ++k) dst[n][k] = *(const PG8_LAS bf16x8*)(lds + PG8_SB(b, h) + boff + n * 2048 + k * 1024); } while (0)
#define PG8_MMA(ai, bj, At, Bt) do { __builtin_amdgcn_s_setprio(1); _Pragma("unroll") for (int m = 0; m < 4; ++m) _Pragma("unroll") for (int n = 0; n < 2; ++n) _Pragma("unroll") for (int k = 0; k < 2; ++k) \
        acc[ai][bj][m][n] = __builtin_amdgcn_mfma_f32_16x16x32_bf16(Bt[n][k], At[m][k], acc[ai][bj][m][n], 0, 0, 0); __builtin_amdgcn_s_setprio(0); } while (0)
#define PG8_WAIT_V(n) asm volatile("s_waitcnt vmcnt(" #n ")" ::: "memory")
#define PG8_WAIT_L(n) asm volatile("s_waitcnt lgkmcnt(" #n ")" ::: "memory")
#define PG8_BAR __builtin_amdgcn_s_barrier()
#define PG8_SCHED __builtin_amdgcn_sched_barrier(0)
    Unit cur, nxt; int ui = 0;
    if (!S.next(0, cur)) return;
    f32x4 acc[2][2][4][2];
#pragma unroll
    for (int a = 0; a < 2; ++a)
#pragma unroll
        for (int b = 0; b < 2; ++b)
#pragma unroll
            for (int m = 0; m < 4; ++m)
#pragma unroll
                for (int n = 0; n < 2; ++n) acc[a][b][m][n] = (f32x4){0.f, 0.f, 0.f, 0.f};
    bf16x8 At[4][2], B0[2][2], B1[2][2];
    const char* cA = (const char*)g.A + (size_t)cur.pm * tstep; const char* cB = (const char*)g.Bt + (size_t)cur.pn * tstep;
    S.a_ready(cur);
    if constexpr (SP2) {
        PG8_STAGE(PG8_SB(0, 0), cB, voffB); PG8_STAGE(PG8_SB(0, 1), cB + hstep, voffB); PG8_STAGE(PG8_SA(0, 0), cA, voffA); PG8_STAGE(PG8_SA(0, 1), cA + hstep, voffA);
        if (wr == 1) PG8_BAR;
        PG8_WAIT_V(2); PG8_BAR;
        PG8_STAGE(PG8_SB(1, 0), cB + kstep, voffB); PG8_STAGE(PG8_SA(1, 0), cA + kstep, voffA); PG8_STAGE(PG8_SB(1, 1), cB + hstep + kstep, voffB);
        PG8_WAIT_V(6); PG8_BAR;
    } else {
        PG8_STAGE(PG8_SB(0, 0), cB, voffB); PG8_STAGE(PG8_SA(0, 0), cA, voffA); PG8_STAGE(PG8_SB(0, 1), cB + hstep, voffB); PG8_STAGE(PG8_SA(0, 1), cA + hstep, voffA);
        if (wr == 1) PG8_BAR;
        PG8_WAIT_V(4); PG8_BAR;
        PG8_STAGE(PG8_SB(1, 0), cB + kstep, voffB); PG8_STAGE(PG8_SA(1, 0), cA + kstep, voffA); PG8_STAGE(PG8_SB(1, 1), cB + hstep + kstep, voffB);
        PG8_WAIT_V(6); PG8_BAR;
    }
    for (;;) {
        const bool has_next = S.next(ui + 1, nxt);
        const char* nA = has_next ? (const char*)g.A + (size_t)nxt.pm * tstep : cA; const char* nB = has_next ? (const char*)g.Bt + (size_t)nxt.pn * tstep : cB;
        for (int t = 0; t < nt; t += 2) {
            const bool last = (t == nt - 2);
            const char* a1 = cA + (size_t)(t + 1) * kstep;
            const char* a2 = last ? nA : cA + (size_t)(t + 2) * kstep; const char* b2 = last ? nB : cB + (size_t)(t + 2) * kstep;
            const char* a3 = a2 + kstep; const char* b3 = b2 + kstep;
            if (last && has_next) S.a_ready(nxt);
            if constexpr (SP2) {
            PG8_LDB(B0, 0, 0); PG8_LDB(B1, 0, 1); PG8_SCHED; PG8_LDA(At, 0, 0); PG8_STAGE(PG8_SA(1, 1), a1 + hstep, voffA);
            PG8_WAIT_V(8); PG8_WAIT_L(0); PG8_BAR; PG8_MMA(0, 0, At, B0); PG8_MMA(0, 1, At, B1); PG8_BAR; PG8_SCHED;
            PG8_LDA(At, 0, 1); PG8_STAGE(PG8_SB(0, 0), b2, voffB); PG8_STAGE(PG8_SB(0, 1), b2 + hstep, voffB); PG8_STAGE(PG8_SA(0, 0), a2, voffA);
            PG8_WAIT_V(8); PG8_WAIT_L(0); PG8_BAR; PG8_MMA(1, 0, At, B0); PG8_MMA(1, 1, At, B1); PG8_BAR; PG8_SCHED;
            PG8_LDB(B0, 1, 0); PG8_LDB(B1, 1, 1); PG8_SCHED; PG8_LDA(At, 1, 0); PG8_STAGE(PG8_SA(0, 1), a2 + hstep, voffA);
            PG8_WAIT_V(8); PG8_WAIT_L(0); PG8_BAR; PG8_MMA(0, 0, At, B0); PG8_MMA(0, 1, At, B1); PG8_BAR; PG8_SCHED;
            PG8_LDA(At, 1, 1); PG8_STAGE(PG8_SB(1, 0), b3, voffB); PG8_STAGE(PG8_SB(1, 1), b3 + hstep, voffB); PG8_STAGE(PG8_SA(1, 0), a3, voffA);
            PG8_WAIT_V(8); PG8_WAIT_L(0); PG8_BAR; PG8_MMA(1, 0, At, B0); PG8_MMA(1, 1, At, B1); PG8_BAR; PG8_SCHED;
            } else {
            PG8_LDB(B0, 0, 0); PG8_SCHED; PG8_LDA(At, 0, 0); PG8_STAGE(PG8_SA(1, 1), a1 + hstep, voffA);
            PG8_WAIT_L(8); PG8_BAR; PG8_WAIT_L(0); PG8_MMA(0, 0, At, B0); PG8_BAR; PG8_SCHED;
            PG8_LDB(B1, 0, 1); PG8_STAGE(PG8_SB(0, 0), b2, voffB);
            PG8_BAR; PG8_WAIT_L(0); PG8_MMA(0, 1, At, B1); PG8_BAR;
            PG8_LDA(At, 0, 1); PG8_STAGE(PG8_SA(0, 0), a2, voffA);
            PG8_BAR; PG8_WAIT_L(0); PG8_MMA(1, 0, At, B0); PG8_BAR; PG8_SCHED;
            PG8_STAGE(PG8_SB(0, 1), b2 + hstep, voffB);
            PG8_WAIT_V(6); PG8_BAR; PG8_MMA(1, 1, At, B1); PG8_BAR;
            PG8_LDB(B0, 1, 0); PG8_SCHED; PG8_LDA(At, 1, 0); PG8_STAGE(PG8_SA(0, 1), a2 + hstep, voffA);
            PG8_WAIT_L(8); PG8_BAR; PG8_WAIT_L(0); PG8_MMA(0, 0, At, B0); PG8_BAR; PG8_SCHED;
            PG8_LDB(B1, 1, 1); PG8_STAGE(PG8_SB(1, 0), b3, voffB);
            PG8_BAR; PG8_WAIT_L(0); PG8_MMA(0, 1, At, B1); PG8_BAR;
            PG8_LDA(At, 1, 1); PG8_STAGE(PG8_SA(1, 0), a3, voffA);
            PG8_BAR; PG8_WAIT_L(0); PG8_MMA(1, 0, At, B0); PG8_BAR; PG8_SCHED;
            PG8_STAGE(PG8_SB(1, 1), b3 + hstep, voffB);
            PG8_WAIT_V(6); PG8_BAR; PG8_MMA(1, 1, At, B1); PG8_BAR;
            }
        }
        if constexpr (ALIGN_EPI) { if (wr == 0) PG8_BAR; }
        if constexpr (!Epi::AFTER_DRAIN) { E(acc, cur, wr, wc, fr, fq); S.done(cur); }
        if (!has_next) break;
#pragma unroll
        for (int a = 0; a < 2; ++a)
#pragma unroll
            for (int b = 0; b < 2; ++b)
#pragma unroll
                for (int m = 0; m < 4; ++m)
#pragma unroll
                    for (int n = 0; n < 2; ++n) acc[a][b][m][n] = (f32x4){0.f, 0.f, 0.f, 0.f};
        cur = nxt; cA = nA; cB = nB; ++ui;
        if constexpr (ALIGN_EPI) { if (wr == 1) PG8_BAR; }
    }
    PG8_WAIT_V(0);
    if constexpr (!ALIGN_EPI) { if (wr == 0) PG8_BAR; }
    PG8_BAR;
#undef PG8_SA
#undef PG8_SB
#undef PG8_STAGE
#undef PG8_LDA
#undef PG8_LDB
#undef PG8_MMA
#undef PG8_WAIT_V
#undef PG8_WAIT_L
#undef PG8_BAR
#undef PG8_SCHED
}
}

constexpr int DM = 2048, NBATCH = 8, SEQ = 2048, DEPTH = 4, NH = 16, HD = 128, FF = 5632;
constexpr int M = NBATCH * SEQ;
constexpr int NGU = 2 * FF, NQKV = 3 * DM;
constexpr float RMS_EPS = 1e-6f;
constexpr int NWAVES = 8;

constexpr size_t MiB = 1u << 20;
constexpr size_t WS_CTL = 0, CTL_ZERO_BYTES = 1 * MiB;
constexpr size_t WS_LF = 1 * MiB;
constexpr size_t WS_PART = 2 * MiB;
constexpr size_t WS_WF = 4 * MiB;
constexpr size_t WS_WGU = 5 * MiB;
constexpr size_t SZ_WGU = (size_t)NGU * DM * 2;
constexpr size_t WS_WD = WS_WGU + 8 * SZ_WGU;
constexpr size_t SZ_WD = (size_t)DM * FF * 2;
constexpr size_t WS_WQKV = WS_WD + 8 * SZ_WD;
constexpr size_t SZ_WQKV = (size_t)NQKV * DM * 2;
constexpr size_t WS_WO = WS_WQKV + 4 * SZ_WQKV;
constexpr size_t SZ_WO = (size_t)DM * DM * 2;
constexpr size_t WS_H = WS_WO + 4 * SZ_WO;
constexpr size_t WS_AO = WS_H + (size_t)M * DM * 2;
constexpr size_t WS_ACT = WS_AO + (size_t)M * DM * 2;
constexpr size_t WS_END = WS_ACT + (size_t)M * NQKV * 2;
static_assert(WS_WGU % 256 == 0 && WS_WD % 256 == 0 && WS_WQKV % 256 == 0 && WS_WO % 256 == 0 && WS_H % 256 == 0 && WS_ACT % 256 == 0, "alignment");

constexpr int CW_TMO = 0;
constexpr int CW_BAR = 4096;

constexpr int RING_OFF = 0, RING_BYTES = 131072;
constexpr int LDS_BYTES = 147456;
constexpr int RST_OFF = RING_BYTES;
constexpr int MISC_OFF = LDS_BYTES - 256;

#define GAS __attribute__((address_space(1)))
#define LAS __attribute__((address_space(3)))
typedef unsigned short bf16;
typedef unsigned v4u __attribute__((ext_vector_type(4)));
typedef unsigned v2u __attribute__((ext_vector_type(2)));
typedef float f32x4 __attribute__((ext_vector_type(4)));
typedef float f32x16 __attribute__((ext_vector_type(16)));
typedef short bf16x8 __attribute__((ext_vector_type(8)));
typedef short s16x4 __attribute__((ext_vector_type(4)));
typedef GAS unsigned gu32;
#define RLX_AGENT __ATOMIC_RELAXED, __HIP_MEMORY_SCOPE_AGENT
#define LDS_WAIT() asm volatile("s_waitcnt lgkmcnt(0)" ::: "memory")
#define VM_WAIT() asm volatile("s_waitcnt vmcnt(0)" ::: "memory")
__device__ __forceinline__ unsigned cvtpk(float lo, float hi) { unsigned r; asm volatile("v_cvt_pk_bf16_f32 %0, %1, %2" : "=v"(r) : "v"(lo), "v"(hi)); return r; }

#define XB_TMO      128
#define XB_XCNT(j)  (256  + 64 * (j))
#define XB_XSUB(j)  (1280 + 64 * (j))
#define XB_XGEN(j)  (2304 + 64 * (j))
#define XB_TOP      3328
#define XB_TOPGEN   3392
#define XCD_BAR_WORDS 3456
#define XB_SPIN_CAP (1u << 18)
__device__ __forceinline__ unsigned xb_ld(unsigned* p)              { return __hip_atomic_load(p, __ATOMIC_RELAXED, __HIP_MEMORY_SCOPE_AGENT); }
__device__ __forceinline__ unsigned xb_add(unsigned* p, unsigned v) { return __hip_atomic_fetch_add(p, v, __ATOMIC_RELAXED, __HIP_MEMORY_SCOPE_AGENT); }
__device__ __forceinline__ unsigned xb_xcc_id() { return (unsigned)__builtin_amdgcn_s_getreg((3 << 11) | 20) & 0xFu; }
#define XB_SPIN(cond, bar) do { unsigned _sp = 0; while (cond) { __builtin_amdgcn_s_sleep(1); \
    if ((++_sp & 255u) == 0u) { if (xb_ld(&(bar)[XB_TMO])) break; if (_sp > XB_SPIN_CAP) { atomicAdd(&(bar)[XB_TMO], 1u); break; } } } } while (0)
struct XcdBarrier { unsigned* bar; unsigned x; volatile LAS unsigned* st; };
__device__ __forceinline__ XcdBarrier xcd_barrier_post(unsigned* bar, volatile LAS unsigned* st) {
    XcdBarrier b; b.bar = bar; b.x = xb_xcc_id(); b.st = st;
    if (threadIdx.x == 0) (void)xb_add(&bar[XB_XCNT(b.x)], 1u);
    return b;
}
__device__ __forceinline__ void xcd_barrier_complete(unsigned* bar, unsigned x, unsigned& nloc, unsigned& nx) {
    const unsigned G = gridDim.x * gridDim.y * gridDim.z;
    unsigned sum, cnt, mine, sp = 0u;
    for (;;) {
        sum = 0u; cnt = 0u; mine = 0u;
#pragma unroll
        for (unsigned j = 0; j < 16; ++j) { const unsigned c = xb_ld(&bar[XB_XCNT(j)]); sum += c; cnt += (c > 0u) ? 1u : 0u; mine = (j == x) ? c : mine; }
        if (sum == G) break;
        __builtin_amdgcn_s_sleep(1);
        if ((++sp & 255u) == 0u) { if (xb_ld(&bar[XB_TMO])) break; if (sp > XB_SPIN_CAP) { atomicAdd(&bar[XB_TMO], 1u); break; } }
    }
    nloc = mine > 0u ? mine : 1u; nx = cnt > 0u ? cnt : 1u;
}
__device__ __forceinline__ void xcd_barrier(const XcdBarrier& b) {
    asm volatile("s_waitcnt vmcnt(0)" ::: "memory");
    __syncthreads();
    if (threadIdx.x == 0) {
        unsigned* bar = b.bar;
        __builtin_amdgcn_s_waitcnt(0);
        unsigned nloc = b.st[0], nx = b.st[1];
        if (nloc == 0u) { xcd_barrier_complete(bar, b.x, nloc, nx); b.st[0] = nloc; b.st[1] = nx; }
        const unsigned old = xb_add(&bar[XB_XSUB(b.x)], 1u);
        const unsigned gen = old / nloc;
        if (old + 1u == (gen + 1u) * nloc) {
            __builtin_amdgcn_fence(__ATOMIC_RELEASE, "agent");
            asm volatile("s_waitcnt vmcnt(0)" ::: "memory");
            const unsigned og = xb_add(&bar[XB_TOP], 1u);
            const unsigned tg = og / nx;
            if (og + 1u == (tg + 1u) * nx) xb_add(&bar[XB_TOPGEN], 1u);
            else XB_SPIN(xb_ld(&bar[XB_TOPGEN]) == tg, bar);
            __builtin_amdgcn_fence(__ATOMIC_ACQUIRE, "agent");
            xb_add(&bar[XB_XGEN(b.x)], 1u);
            asm volatile("s_waitcnt vmcnt(0)" ::: "memory");
        } else {
            XB_SPIN(xb_ld(&bar[XB_XGEN(b.x)]) == gen, bar);
            __builtin_amdgcn_fence(__ATOMIC_ACQUIRE, "agent");
            asm volatile("s_waitcnt vmcnt(0)" ::: "memory");
        }
    }
    __syncthreads();
}

__device__ __forceinline__ int opaque_tid() { int t = threadIdx.x; asm volatile("" : "+v"(t)); return t; }
__device__ __forceinline__ float wave_sum(float v) {
#pragma unroll
    for (int o = 1; o < 64; o <<= 1) v += __shfl_xor(v, o);
    return v;
}

__device__ __forceinline__ void transpose_item(const float* __restrict__ W, int ldw, int Kdim, bf16* __restrict__ WT, int k0, int n0, int drow0, const float* __restrict__ gk, LAS float* scr, int lane) {
    const int nl = (lane & 15) * 4, kl = lane >> 4;
    f32x4 v[16];
#pragma unroll
    for (int i = 0; i < 16; ++i) v[i] = *(const GAS f32x4*)(W + (size_t)(k0 + 4 * i + kl) * ldw + n0 + nl);
#pragma unroll
    for (int i = 0; i < 16; ++i) { const float gg = gk ? gk[k0 + 4 * i + kl] : 1.0f; LAS float* s = scr + (4 * i + kl) * 65 + nl; s[0] = v[i].x * gg; s[1] = v[i].y * gg; s[2] = v[i].z * gg; s[3] = v[i].w * gg; }
    LDS_WAIT(); asm volatile("" ::: "memory");
    const int c = lane & 7;
#pragma unroll
    for (int j = 0; j < 8; ++j) { const int n = (lane >> 3) + 8 * j; const LAS float* s = scr + (8 * c) * 65 + n;
        v4u o; o.x = cvtpk(s[0 * 65], s[1 * 65]); o.y = cvtpk(s[2 * 65], s[3 * 65]); o.z = cvtpk(s[4 * 65], s[5 * 65]); o.w = cvtpk(s[6 * 65], s[7 * 65]);
        *(GAS v4u*)(WT + (size_t)(drow0 + n) * Kdim + k0 + 8 * c) = o; }
    LDS_WAIT(); asm volatile("" ::: "memory");
}

namespace att {
constexpr int D = 128, NW = 8, QBLK = 32, KVBLK = 64, QB = 256;
constexpr int SHM_K = KVBLK * D * 2, SHM_V = KVBLK * D * 2;
constexpr int L_V = 0, L_K = 2 * SHM_V, L_WS = L_K + 2 * SHM_K, L_TAB = L_WS + NW * 64 * 4, L_SCAN = L_TAB + 2304 * 4, L_FLAG = L_SCAN + 64, L_END = L_FLAG + 64;
constexpr int TAB_N = 2304;
constexpr int QPITCH = NQKV, OPITCH = DM;
constexpr float SCALE = 0.08838834764831845f;
constexpr float C2 = 1.4426950408889634f * SCALE;
constexpr float THR = 8.f;

#define KSWZ(row, colB) ((row) * 256 + ((colB) ^ (((row) & 7) << 4)))
#define SBAR() __builtin_amdgcn_sched_barrier(0)
__device__ __forceinline__ int v_st(int k, int c) { const int kk = (k & ~0xC) | ((k & 4) << 1) | ((k & 8) >> 1); return ((kk >> 3) * 4 + (c >> 5)) * 512 + ((kk & 7) * 32 + (c & 31)) * 2; }
__device__ __forceinline__ int v_rd_base(int lane) { return ((lane & 3) << 3) | (((lane >> 2) & 3) << 6) | (((lane >> 4) & 1) << 5) | (((lane >> 5) & 1) << 8); }
constexpr int v_rd_off(int d0, int ks, int half) { return d0 * 512 + ks * 4096 + half * 2048; }
__device__ __forceinline__ int crow(int r, int hi) { return (r & 3) + 8 * (r >> 2) + 4 * hi; }

template <bool STRICT>
__device__ __forceinline__ void mask_tile(f32x16& p0, f32x16& p1, int dq) {
    const float NEG = -__builtin_inff();
    const int lim = STRICT ? 1 : 0;
#pragma unroll
    for (int r = 0; r < 16; ++r) {
        const int c = (r & 3) + 8 * (r >> 2);
        if (dq - c < lim) p0[r] = NEG;
        if (dq - c - 32 < lim) p1[r] = NEG;
    }
}
__device__ __forceinline__ void partialSM(f32x16& p0, f32x16& p1, float& m_reg, float& mn, float& alpha) {
    float pmax = p0[0];
#pragma unroll
    for (int r = 1; r < 16; ++r) pmax = fmaxf(pmax, p0[r]);
#pragma unroll
    for (int r = 0; r < 16; ++r) pmax = fmaxf(pmax, p1[r]);
    { auto rr = __builtin_amdgcn_permlane32_swap(__float_as_uint(pmax), __float_as_uint(pmax), false, false);
      pmax = fmaxf(__uint_as_float(rr[0]), __uint_as_float(rr[1])); }
    if (__builtin_expect(__all((pmax - m_reg) * SCALE <= THR), 1)) { mn = m_reg; alpha = 1.f; }
    else { mn = fmaxf(m_reg, pmax); alpha = __builtin_amdgcn_exp2f((m_reg - mn) * C2); m_reg = mn; }
    const float mnL = -mn * C2;
#pragma unroll
    for (int r = 0; r < 16; ++r) p0[r] = fmaf(p0[r], C2, mnL);
#pragma unroll
    for (int r = 0; r < 16; ++r) p1[r] = fmaf(p1[r], C2, mnL);
#pragma unroll
    for (int r = 0; r < 16; ++r) p0[r] = __builtin_amdgcn_exp2f(p0[r]);
}
#define PK4(P, B_, OUT) do { unsigned a0 = cvtpk(P[B_+0], P[B_+1]), a1 = cvtpk(P[B_+2], P[B_+3]);                          \
        unsigned b0 = cvtpk(P[B_+4], P[B_+5]), b1 = cvtpk(P[B_+6], P[B_+7]);                                             \
        auto r0 = __builtin_amdgcn_permlane32_swap(a0, b0, false, false); auto r1 = __builtin_amdgcn_permlane32_swap(a1, b1, false, false); \
        v4u w = {r0[0], r1[0], r0[1], r1[1]}; OUT = __builtin_bit_cast(bf16x8, w); } while (0)
__device__ __forceinline__ void finishSM(f32x16& p0, f32x16& p1, float alpha, float& l_reg, bf16x8& pa0, bf16x8& pa1, bf16x8& pa2, bf16x8& pa3) {
#pragma unroll
    for (int r = 0; r < 16; ++r) p1[r] = __builtin_amdgcn_exp2f(p1[r]);
    float ps = 0;
#pragma unroll
    for (int r = 0; r < 16; ++r) ps += p0[r];
#pragma unroll
    for (int r = 0; r < 16; ++r) ps += p1[r];
    { auto rr = __builtin_amdgcn_permlane32_swap(__float_as_uint(ps), __float_as_uint(ps), false, false);
      ps = __uint_as_float(rr[0]) + __uint_as_float(rr[1]); }
    l_reg = l_reg * alpha + ps;
    PK4(p0, 0, pa0); PK4(p0, 8, pa1); PK4(p1, 0, pa2); PK4(p1, 8, pa3);
}
template <int KB>
__device__ __forceinline__ void qkt(f32x16& p0, f32x16& p1, const LAS char* K_lds, int r32, int hi, const bf16x8* qr) {
    const LAS char* kb[4];
#pragma unroll
    for (int dd = 0; dd < 4; ++dd) kb[dd] = K_lds + KB * SHM_K + KSWZ(r32, (dd * 16 + hi * 8) * 2);
#pragma unroll
    for (int d0 = 0; d0 < 8; ++d0) { const LAS char* a = kb[d0 & 3] + (d0 >> 2) * 128;
        bf16x8 b0 = *reinterpret_cast<const LAS bf16x8*>(a);
        bf16x8 b1 = *reinterpret_cast<const LAS bf16x8*>(a + 32 * 256);
        p0 = __builtin_amdgcn_mfma_f32_32x32x16_bf16(b0, qr[d0], p0, 0, 0, 0);
        p1 = __builtin_amdgcn_mfma_f32_32x32x16_bf16(b1, qr[d0], p1, 0, 0, 0); }
}
template <int VB>
__device__ __forceinline__ void pv_tile(f32x16* o, int vb0, bf16x8 pa0, bf16x8 pa1, bf16x8 pa2, bf16x8 pa3) {
#define TRRD(dst, off) asm volatile("ds_read_b64_tr_b16 %0, %1 offset:%2" : "=&v"(dst) : "v"(vb0), "i"(off) : "memory")
#define PV_D0(d0) do { s16x4 l0, l1, l2, l3, h0, h1, h2, h3; constexpr int b_ = VB * SHM_V + v_rd_off(d0, 0, 0); \
        TRRD(l0, b_); TRRD(h0, b_ + 2048); TRRD(l1, b_ + 4096); TRRD(h1, b_ + 6144); TRRD(l2, b_ + 8192); TRRD(h2, b_ + 10240); TRRD(l3, b_ + 12288); TRRD(h3, b_ + 14336); \
        asm volatile("s_waitcnt lgkmcnt(0)" ::: "memory"); SBAR();   \
        o[d0] = __builtin_amdgcn_mfma_f32_32x32x16_bf16(pa0, (bf16x8){l0[0], l0[1], l0[2], l0[3], h0[0], h0[1], h0[2], h0[3]}, o[d0], 0, 0, 0);   \
        o[d0] = __builtin_amdgcn_mfma_f32_32x32x16_bf16(pa1, (bf16x8){l1[0], l1[1], l1[2], l1[3], h1[0], h1[1], h1[2], h1[3]}, o[d0], 0, 0, 0);   \
        o[d0] = __builtin_amdgcn_mfma_f32_32x32x16_bf16(pa2, (bf16x8){l2[0], l2[1], l2[2], l2[3], h2[0], h2[1], h2[2], h2[3]}, o[d0], 0, 0, 0);   \
        o[d0] = __builtin_amdgcn_mfma_f32_32x32x16_bf16(pa3, (bf16x8){l3[0], l3[1], l3[2], l3[3], h3[0], h3[1], h3[2], h3[3]}, o[d0], 0, 0, 0); } while (0)
    PV_D0(0); PV_D0(1); PV_D0(2); PV_D0(3);
#undef PV_D0
#undef TRRD
}
__device__ __forceinline__ float suffix32(const f32x16& x, f32x16& aft, float base, int hi) {
    float c0[4], c1[4];
#pragma unroll
    for (int g = 0; g < 4; ++g) { const float c = (x[4 * g] + x[4 * g + 1]) + (x[4 * g + 2] + x[4 * g + 3]);
        auto rr = __builtin_amdgcn_permlane32_swap(__float_as_uint(c), __float_as_uint(c), false, false);
        c0[g] = __uint_as_float(rr[0]); c1[g] = __uint_as_float(rr[1]); }
    float s = base;
#pragma unroll
    for (int g = 3; g >= 0; --g) { const float sx1 = s; s += c1[g]; const float sx0 = s; s += c0[g];
        const float sx = hi ? sx1 : sx0;
        aft[4 * g + 3] = sx; aft[4 * g + 2] = aft[4 * g + 3] + x[4 * g + 3]; aft[4 * g + 1] = aft[4 * g + 2] + x[4 * g + 2]; aft[4 * g] = aft[4 * g + 1] + x[4 * g + 1]; }
    return s;
}

template <int MODE, int KVB>
__device__ __forceinline__ void attn_tile(f32x16* o, float& m_reg, float& l_reg, float& R, const bf16x8* qr, const LAS char* K_lds, int vb0, const LAS float* tab, LAS float* al_l,
                                          int kb, int qlo, int qm, int tl, int r32, int hi) {
    f32x16 p0, p1; bf16x8 pa0, pa1, pa2, pa3;
    if (MODE == 0) {
        const LAS float* tp = tab + (tl + kb);
#pragma unroll
        for (int r = 0; r < 16; ++r) { const int c = (r & 3) + 8 * (r >> 2); p0[r] = tp[c]; p1[r] = tp[c + 32]; }
    } else {
#pragma unroll
        for (int r = 0; r < 16; ++r) { p0[r] = 0.f; p1[r] = 0.f; }
    }
    qkt<KVB>(p0, p1, K_lds, r32, hi, qr);
    if (MODE == 0) {
        if (kb + KVBLK - 1 > qlo) mask_tile<false>(p0, p1, qm - kb);
        float mn, alpha;
        partialSM(p0, p1, m_reg, mn, alpha);
        if (__any(alpha < 1.f)) { if (hi == 0) al_l[r32] = alpha; LDS_WAIT();
#pragma unroll
            for (int d_ = 0; d_ < 4; ++d_)
#pragma unroll
                for (int r = 0; r < 16; ++r) o[d_][r] *= al_l[crow(r, hi)]; }
        finishSM(p0, p1, alpha, l_reg, pa0, pa1, pa2, pa3);
    } else {
        f32x16 x0, x1;
#pragma unroll
        for (int r = 0; r < 16; ++r) { const float y = p0[r] * C2; const float L = __builtin_amdgcn_logf(1.0f + __builtin_amdgcn_exp2f(-fabsf(y))); const float lb = fminf(y, 0.f) - L; p0[r] = lb; x0[r] = lb - y; }
#pragma unroll
        for (int r = 0; r < 16; ++r) { const float y = p1[r] * C2; const float L = __builtin_amdgcn_logf(1.0f + __builtin_amdgcn_exp2f(-fabsf(y))); const float lb = fminf(y, 0.f) - L; p1[r] = lb; x1[r] = lb - y; }
        if (kb + KVBLK - 1 >= qlo) {
            const int dq = qm - kb; const float NEG = -__builtin_inff();
#pragma unroll
            for (int r = 0; r < 16; ++r) { const int c = (r & 3) + 8 * (r >> 2);
                if (dq - c < 1) { p0[r] = NEG; x0[r] = 0.f; }
                if (dq - c - 32 < 1) { p1[r] = NEG; x1[r] = 0.f; } }
        }
        f32x16 a0, a1;
        const float s1 = suffix32(x1, a1, R, hi);
        const float s0 = suffix32(x0, a0, s1, hi);
        R = s0;
#pragma unroll
        for (int r = 0; r < 16; ++r) { p0[r] = __builtin_amdgcn_exp2f(p0[r] + a0[r]); p1[r] = __builtin_amdgcn_exp2f(p1[r] + a1[r]); }
        PK4(p0, 0, pa0); PK4(p0, 8, pa1); PK4(p1, 0, pa2); PK4(p1, 8, pa3);
    }
    SBAR();
    pv_tile<KVB>(o, vb0, pa0, pa1, pa2, pa3);
}
template <int MODE>
__device__ __forceinline__ void attn_block(const bf16* __restrict__ Qb, const bf16* __restrict__ Kh, const bf16* __restrict__ Vh, bf16* __restrict__ Ob, int P0, LAS char* lds, int toff_mul, int toff_add) {
    int tid = threadIdx.x; asm volatile("" : "+v"(tid));
    const int wid = __builtin_amdgcn_readfirstlane(tid >> 6), lane = tid & 63, r32 = lane & 31, hi = lane >> 5;
    LAS char* V_lds = lds + L_V; LAS char* K_lds = lds + L_K;
    LAS float* wsf = (LAS float*)(lds + L_WS) + wid * 64; LAS float* li_l = wsf; LAS float* al_l = wsf + 32;
    const LAS float* tab = (const LAS float*)(lds + L_TAB);
    volatile LAS unsigned* flags = (volatile LAS unsigned*)(lds + L_FLAG);
    bf16x8 qr[8];
    { const bf16* qrow = Qb + (size_t)(wid * QBLK + r32) * QPITCH + hi * 8;
#pragma unroll
      for (int d0 = 0; d0 < 8; ++d0) qr[d0] = *(const GAS bf16x8*)(qrow + d0 * 16); }
    const int qlo = P0 + wid * QBLK, qpos = qlo + r32, qm = qpos - 4 * hi;
    const int NT = P0 / KVBLK + 4;
    const int sr = tid >> 4, sc = (tid & 15) * 8;
    const int kws = KSWZ(sr, sc * 2), vst0 = v_st(sr, sc), vst1 = v_st(32 + sr, sc);
    const int vb0 = (int)(unsigned)(uintptr_t)V_lds + v_rd_base(lane);
    const int tl = toff_mul * qpos + toff_add + 4 * hi;
    float m_reg = -1e30f, l_reg = 0.f, R = 0.f;
    f32x16 o[4];
#pragma unroll
    for (int d = 0; d < 4; ++d)
#pragma unroll
        for (int r = 0; r < 16; ++r) o[d][r] = 0.f;
    bf16x8 sk0, sk1, sv0, sv1;
#define KB_OF(it_) (((MODE == 1) ? NT - 1 - (it_) : (it_)) * KVBLK)
#define ST_LOAD(kb_) do { const bf16* kp = Kh + (size_t)((kb_) + sr) * QPITCH + sc; const bf16* vp = Vh + (size_t)((kb_) + sr) * QPITCH + sc; \
        sk0 = *(const GAS bf16x8*)kp; sk1 = *(const GAS bf16x8*)(kp + (size_t)32 * QPITCH); sv0 = *(const GAS bf16x8*)vp; sv1 = *(const GAS bf16x8*)(vp + (size_t)32 * QPITCH); } while (0)
#define ST_WRITE(bf_) do { *(LAS bf16x8*)(K_lds + (bf_) * SHM_K + kws) = sk0; *(LAS bf16x8*)(K_lds + (bf_) * SHM_K + kws + 32 * 256) = sk1; \
        *(LAS bf16x8*)(V_lds + (bf_) * SHM_V + vst0) = sv0; *(LAS bf16x8*)(V_lds + (bf_) * SHM_V + vst1) = sv1; } while (0)
    __syncthreads();
    ST_LOAD(KB_OF(0)); ST_WRITE(0);
    if (MODE == 1 && tid < 16) flags[tid] = 0u;
    __syncthreads();
    bool stop = false, wdone = false;
#define STEP(it_, B_, NB_) { const int kb = KB_OF(it_); const bool more = (it_) + 1 < NT; \
        if (more) ST_LOAD(KB_OF((it_) + 1)); \
        if (kb <= qlo + QBLK - 1 && !wdone) attn_tile<MODE, B_>(o, m_reg, l_reg, R, qr, K_lds, vb0, tab, al_l, kb, qlo, qm, tl, r32, hi); \
        if (more) ST_WRITE(NB_); \
        if (MODE == 1) { wdone = (kb <= qlo + QBLK - 1) && __all(R <= -160.f); if (lane == 0) flags[((it_) & 1) * 8 + wid] = wdone ? 1u : 0u; } \
        __syncthreads(); \
        if (MODE == 1) { unsigned a_ = 1u; _Pragma("unroll") for (int w_ = 0; w_ < 8; ++w_) a_ &= flags[((it_) & 1) * 8 + w_]; stop = (a_ != 0u); } }
    for (int it = 0; it < NT; it += 2) {
        STEP(it, 0, 1)
        if (stop) break;
        STEP(it + 1, 1, 0)
        if (stop) break;
    }
#undef STEP
#undef ST_LOAD
#undef ST_WRITE
#undef KB_OF
    float rli[16];
    if (MODE == 0) {
        if (hi == 0) li_l[r32] = l_reg; LDS_WAIT();
#pragma unroll
        for (int r = 0; r < 16; ++r) rli[r] = __builtin_amdgcn_rcpf(li_l[crow(r, hi)]);
    } else {
#pragma unroll
        for (int r = 0; r < 16; ++r) rli[r] = 1.f;
    }
    bf16* Ow = Ob + (size_t)(wid * QBLK) * OPITCH;
#pragma unroll
    for (int r = 0; r < 16; ++r) { const int orow = crow(r, hi);
#pragma unroll
        for (int d0 = 0; d0 < 4; ++d0) { const float v = o[d0][r] * rli[r];
            const float vn = __shfl_xor(v, 1);
            if ((r32 & 1) == 0) *(GAS unsigned*)(Ow + (size_t)orow * OPITCH + d0 * 32 + r32) = cvtpk(v, vn); } }
}
#undef PK4
}

__device__ __forceinline__ int t5_bucket(int d) {
    if (d < 16) return d;
    int b = 16;
    b += (d >= 22); b += (d >= 30); b += (d >= 40); b += (d >= 54); b += (d >= 73); b += (d >= 99); b += (d >= 134); b += (d >= 182);
    b += (d >= 246); b += (d >= 332); b += (d >= 450); b += (d >= 609); b += (d >= 825); b += (d >= 1117); b += (d >= 1513);
    return b;
}

struct Args {
    const float* x; const float* norm_g; const float* w_gate; const float* w_up; const float* w_down;
    const float* w_in[4]; const float* b_f0; const float* b_f3; const float* w_out; const float* rel_bias; const float* final_g;
    float* out; unsigned char* ws; int ph_lo, ph_hi;
};
static_assert(sizeof(Args) == 16 * 8 + 8, "Args has no padding");

__global__ void __launch_bounds__(NWAVES * 64, 2) mk_fwd(Args a) {
    extern __shared__ __attribute__((aligned(16))) unsigned char lds_raw[];
    LAS unsigned char* lds = (LAS unsigned char*)lds_raw;
    volatile LAS unsigned* MISC = (volatile LAS unsigned*)(lds + MISC_OFF);
    const int G = gridDim.x; const int bx = blockIdx.x; const int vcu = (G % 8 == 0) ? (bx % 8) * (G / 8) + bx / 8 : bx;
    unsigned char* ws = a.ws;
    gu32* ctl = (gu32*)(ws + WS_CTL);
    if (threadIdx.x < 64) MISC[threadIdx.x] = 0u;
    __syncthreads();
    const int lo = a.ph_lo, hi = a.ph_hi;
    XcdBarrier bar; bar.bar = (unsigned*)(ctl + CW_BAR); bar.x = 0; bar.st = nullptr;
    if (hi - lo > 1) bar = xcd_barrier_post((unsigned*)(ctl + CW_BAR), MISC + 8);
#define RUN(k) (lo <= (k) && (k) < hi)
#define SEAM(k) do { if (RUN(k) && RUN((k) + 1)) { xcd_barrier(bar); if (PROBE_DUP == 9) xcd_barrier(bar); } } while (0)

    bf16* const Hb = (bf16*)(ws + WS_H); bf16* const AO = (bf16*)(ws + WS_AO); bf16* const ACT = (bf16*)(ws + WS_ACT); bf16* const QKV = (bf16*)(ws + WS_ACT);
    float* const LF = (float*)(ws + WS_LF);
    const int NGW = G * NWAVES;
    int ph = 0;
#define LANE_IDS() const int tid = opaque_tid(), lane = tid & 63, wave = __builtin_amdgcn_readfirstlane(tid >> 6), gw = vcu * NWAVES + wave; (void)lane; (void)gw

    if (RUN(ph)) REP(1) {
        LANE_IDS();
        LAS float* scr = (LAS float*)(lds + wave * 16640);
        constexpr int I_G = (DM / 64) * (FF / 64), I_D = (FF / 64) * (DM / 64), I_Q = (DM / 64) * (NQKV / 64), I_O = (DM / 64) * (DM / 64);
        constexpr int PER_LAYER = 6 * I_G + I_Q + I_O;
        static_assert(I_G == I_D, "items");
        for (int it = gw; it < DEPTH * PER_LAYER; it += NGW) {
            const int l = it / PER_LAYER; int r = it - l * PER_LAYER;
            if (r < 6 * I_G) {
                const int mm = r / I_G, idx = r - mm * I_G, kind = mm >> 1, f = mm & 1;
                if (kind < 2) {
                    const float* W = (kind == 0 ? a.w_gate : a.w_up) + (size_t)(l * 2 + f) * DM * FF;
                    const int nblk = FF / 64, kb = idx / nblk, nb = idx - kb * nblk, n0 = nb * 64;
                    transpose_item(W, FF, DM, (bf16*)(ws + WS_WGU + (size_t)(l * 2 + f) * SZ_WGU), kb * 64, n0, (n0 >> 7) * 256 + (n0 & 127) + kind * 128, a.norm_g + (size_t)(l * 3 + 2 * f) * DM, scr, lane);
                } else {
                    const float* W = a.w_down + (size_t)(l * 2 + f) * FF * DM;
                    const int nblk = DM / 64, kb = idx / nblk, nb = idx - kb * nblk;
                    transpose_item(W, DM, FF, (bf16*)(ws + WS_WD + (size_t)(l * 2 + f) * SZ_WD), kb * 64, nb * 64, nb * 64, nullptr, scr, lane);
                }
            } else { r -= 6 * I_G;
                if (r < I_Q) {
                    const float* W = a.w_in[l]; const int ldw = (l == 0 || l == 3) ? NQKV + NH : NQKV;
                    const int nblk = NQKV / 64, kb = r / nblk, nb = r - kb * nblk;
                    transpose_item(W, ldw, DM, (bf16*)(ws + WS_WQKV + (size_t)l * SZ_WQKV), kb * 64, nb * 64, nb * 64, a.norm_g + (size_t)(l * 3 + 1) * DM, scr, lane);
                } else { r -= I_Q;
                    const float* W = a.w_out + (size_t)l * DM * DM;
                    const int nblk = DM / 64, kb = r / nblk, nb = r - kb * nblk;
                    transpose_item(W, DM, DM, (bf16*)(ws + WS_WO + (size_t)l * SZ_WO), kb * 64, nb * 64, nb * 64, nullptr, scr, lane);
                }
            }
        }
    }
    if (RUN(ph)) REP(1) {
        LANE_IDS();
        for (int idx = bx * (NWAVES * 64) + tid; idx < 2 * 16 * DM; idx += G * NWAVES * 64) {
            const int sl = idx >> 15, n = (idx >> 11) & 15, k = idx & (DM - 1), l = sl ? 3 : 0;
            const float w = a.w_in[l][(size_t)k * (NQKV + NH) + NQKV + n] * a.norm_g[(size_t)(l * 3 + 1) * DM + k];
            ((bf16*)(ws + WS_WF))[idx] = (bf16)(cvtpk(w, 0.f) & 0xffffu);
        }
        float* const part = (float*)(ws + WS_PART);
        for (int m = gw; m < M; m += NGW) {
            const GAS f32x4* xr = (const GAS f32x4*)(a.x + (size_t)m * DM) + lane;
            f32x4 v[8]; float ss = 0.f;
#pragma unroll
            for (int j = 0; j < 8; ++j) { v[j] = xr[64 * j]; ss += (v[j].x * v[j].x + v[j].y * v[j].y) + (v[j].z * v[j].z + v[j].w * v[j].w); }
            ss = wave_sum(ss);
            GAS v2u* o8 = (GAS v2u*)(Hb + (size_t)m * DM) + lane;
#pragma unroll
            for (int j = 0; j < 8; ++j) { v2u w; w.x = cvtpk(v[j].x, v[j].y); w.y = cvtpk(v[j].z, v[j].w); o8[64 * j] = w; }
            if (lane < 32) part[(size_t)m * 32 + lane] = (lane == 0) ? ss : 0.f;
        }
    }
    SEAM(ph); ++ph;

    for (int sb = 0; sb < 3 * DEPTH; ++sb) {
        const int l = sb / 3, ty = sb - 3 * l;
        const float* xsrc = (sb == 0) ? a.x : (const float*)a.out;
        if (ty != 1) {
            const int f = ty >> 1;
            if (RUN(ph)) REP(3) {
                pg8::Gemm g{Hb, (const bf16*)(ws + WS_WGU + (size_t)(l * 2 + f) * SZ_WGU), M, NGU, DM}; pg8::StaticOrder S; S.init(M, NGU, G, bx);
                pg8::Unit u0; S.next(0, u0); pg8::build_rstd_table((LAS float*)(lds + RST_OFF), (const float*)(ws + WS_PART), u0.pm, opaque_tid());
                pg8::EpiSwiGLU E{ACT, FF, (const float*)(ws + WS_PART), (const LAS float*)(lds + RST_OFF), u0.pm};
                pg8::gemm_phase<pg8::EpiSwiGLU, pg8::StaticOrder, true, true>(lds + RING_OFF, g, S, E);
            }
            SEAM(ph); ++ph;
            if (RUN(ph)) REP(6) {
                pg8::Gemm g{ACT, (const bf16*)(ws + WS_WD + (size_t)(l * 2 + f) * SZ_WD), M, DM, FF}; pg8::StaticOrder S; S.init(M, DM, G, bx);
                pg8::EpiResid E{xsrc, (PROBE_DUP == 6 && rep_ == 0) ? (float*)(ws + WS_END) : a.out, Hb, (float*)(ws + WS_PART), DM, 0.5f};
                pg8::gemm_phase<pg8::EpiResid, pg8::StaticOrder, true, true>(lds + RING_OFF, g, S, E);
            }
            SEAM(ph); ++ph;
        } else {
            if (RUN(ph) && (l == 0 || l == 3)) {
                LANE_IDS();
                const int fr = lane & 15, fq = lane >> 4;
                const bf16* wf = (const bf16*)(ws + WS_WF) + (size_t)(l ? 1 : 0) * 16 * DM + (size_t)fr * DM + 8 * fq;
                const float* bfp = (l == 0) ? a.b_f0 : a.b_f3;
                for (int rg = gw; rg < M / 16; rg += NGW) {
                    const bf16* ap = Hb + (size_t)(rg * 16 + fr) * DM + 8 * fq;
                    f32x4 acc = {0.f, 0.f, 0.f, 0.f};
#pragma unroll 8
                    for (int k0 = 0; k0 < DM; k0 += 32) { const bf16x8 av = *(const GAS bf16x8*)(ap + k0), bv = *(const GAS bf16x8*)(wf + k0);
                        acc = __builtin_amdgcn_mfma_f32_16x16x32_bf16(bv, av, acc, 0, 0, 0); }
                    const float r = pg8::row_rstd((const float*)(ws + WS_PART), rg * 16 + fr, fq);
                    const f32x4 bb = *(const GAS f32x4*)(bfp + 4 * fq);
                    f32x4 o;
#pragma unroll
                    for (int i = 0; i < 4; ++i) { const float z = acc[i] * r + bb[i]; o[i] = fminf(z, 0.f) - __logf(1.0f + __expf(-fabsf(z))); }
                    *(GAS f32x4*)(LF + (size_t)(rg * 16 + fr) * 16 + 4 * fq) = o;
                }
            }
            if (RUN(ph)) REP(4) {
                pg8::Gemm g{Hb, (const bf16*)(ws + WS_WQKV + (size_t)l * SZ_WQKV), M, NQKV, DM}; pg8::StaticOrder S; S.init(M, NQKV, G, bx);
                pg8::Unit u0; S.next(0, u0); pg8::build_rstd_table((LAS float*)(lds + RST_OFF), (const float*)(ws + WS_PART), u0.pm, opaque_tid());
                pg8::EpiBf16 E{QKV, NQKV, (const float*)(ws + WS_PART), (const LAS float*)(lds + RST_OFF), u0.pm};
                pg8::gemm_phase<pg8::EpiBf16, pg8::StaticOrder, true, true>(lds + RING_OFF, g, S, E);
            }
            SEAM(ph); ++ph;
            if (RUN(ph)) REP(5) {
                LANE_IDS();
                const int mixer = l % 3;
                LAS char* al = (LAS char*)(lds + RING_OFF);
                LAS float* tab = (LAS float*)(al + att::L_TAB);
                LAS float* scan = (LAS float*)(al + att::L_SCAN);
                for (int L = vcu; L < NBATCH * NH * 4; L += G) {
                    const int bh = L >> 2, xq = L & 3, b = bh >> 4, h = bh & 15;
                    const bf16* Qh = QKV + (size_t)b * SEQ * NQKV + h * HD; const bf16* Kh = Qh + DM; const bf16* Vh = Qh + 2 * DM;
                    bf16* Oh = AO + (size_t)b * SEQ * DM + h * HD;
                    __syncthreads();
                    int tmul = 0, tadd = 0;
                    if (mixer == 0) {
                        const float* lf = LF + (size_t)b * SEQ * 16 + h;
                        const float v0 = lf[(size_t)(4 * tid) * 16], v1 = lf[(size_t)(4 * tid + 1) * 16], v2 = lf[(size_t)(4 * tid + 2) * 16], v3 = lf[(size_t)(4 * tid + 3) * 16];
                        const float a0 = v0, a1 = a0 + v1, a2 = a1 + v2, a3 = a2 + v3;
                        float inc = a3;
#pragma unroll
                        for (int d = 1; d < 64; d <<= 1) { const float y = __shfl_up(inc, d); if (lane >= d) inc += y; }
                        if (lane == 63) scan[wave] = inc;
                        __syncthreads();
                        float pre = inc - a3;
                        for (int w = 0; w < wave; ++w) pre += scan[w];
                        const float ns = -11.313708498984761f;
                        tab[4 * tid] = (pre + a0) * ns; tab[4 * tid + 1] = (pre + a1) * ns; tab[4 * tid + 2] = (pre + a2) * ns; tab[4 * tid + 3] = (pre + a3) * ns;
                    } else if (mixer == 1) {
                        const float* rb = a.rel_bias + h * 32;
                        for (int j = tid; j < att::TAB_N; j += NWAVES * 64) {
                            const int d = 2047 - j; float v = 0.f;
                            if (d >= 0) { const int mult = (d <= 128 ? 1 : 0) + (((d & 3) == 0 && d <= 512) ? 1 : 0) + (((d & 15) == 0) ? 1 : 0);
                                v = (mult == 0) ? -__builtin_inff() : (rb[t5_bucket(d)] + (mult == 1 ? 0.f : (mult == 2 ? 0.6931471805599453f : 1.0986122886681098f))) * 11.313708498984761f; }
                            tab[j] = v; }
                        tmul = -1; tadd = 2047;
                    }
#pragma unroll 1
                    for (int pass = 0; pass < 2; ++pass) {
                        const int qb = pass ? 7 - xq : xq, P0 = qb * att::QB;
                        if (mixer == 2) att::attn_block<1>(Qh + (size_t)P0 * NQKV, Kh, Vh, Oh + (size_t)P0 * DM, P0, al, 0, 0);
                        else att::attn_block<0>(Qh + (size_t)P0 * NQKV, Kh, Vh, Oh + (size_t)P0 * DM, P0, al, tmul, tadd);
                    }
                }
            }
            SEAM(ph); ++ph;
            if (RUN(ph)) REP(7) {
                pg8::Gemm g{AO, (const bf16*)(ws + WS_WO + (size_t)l * SZ_WO), M, DM, DM}; pg8::StaticOrder S; S.init(M, DM, G, bx);
                pg8::EpiResid E{a.out, (PROBE_DUP == 7 && rep_ == 0) ? (float*)(ws + WS_ACT) : a.out, Hb, (float*)(ws + WS_PART), DM, 1.0f};
                pg8::gemm_phase<pg8::EpiResid, pg8::StaticOrder, true, true>(lds + RING_OFF, g, S, E);
            }
            SEAM(ph); ++ph;
        }
    }
    if (RUN(ph)) {
        LANE_IDS();
        f32x4 gv[8];
#pragma unroll
        for (int j = 0; j < 8; ++j) gv[j] = *((const GAS f32x4*)a.final_g + lane + 64 * j);
        for (int m = gw; m < M; m += NGW) {
            GAS f32x4* xr = (GAS f32x4*)(a.out + (size_t)m * DM) + lane;
            f32x4 v[8]; float ss = 0.f;
#pragma unroll
            for (int j = 0; j < 8; ++j) { v[j] = xr[64 * j]; ss += (v[j].x * v[j].x + v[j].y * v[j].y) + (v[j].z * v[j].z + v[j].w * v[j].w); }
            const float rstd = 1.0f / sqrtf(wave_sum(ss) * (1.0f / DM) + RMS_EPS);
#pragma unroll
            for (int j = 0; j < 8; ++j) xr[64 * j] = v[j] * rstd * gv[j];
        }
    }
#undef RUN
#undef SEAM
}
constexpr int N_PHASES = 1 + DEPTH * 7 + 1;

extern "C" void kernel_launch(void* const* d_in, const int* in_sizes, int n_in, void* d_out, int out_size, void* d_ws, size_t ws_size, hipStream_t stream) {
    static int grid = 0;
    if (grid == 0) {
        if (n_in != 14 || in_sizes[0] != M * DM || out_size != M * DM || ws_size < WS_END + (PROBE_DUP == 6 ? (size_t)M * DM * 4 : 0)) {
            fprintf(stderr, "kernel_launch: unexpected shapes (n_in %d, in0 %d, out %d, ws %zu < %zu?); nothing launched\n", n_in, n_in > 0 ? in_sizes[0] : -1, out_size, ws_size, (size_t)WS_END); grid = -1; return; }
        int dev = 0, cus = 0;
        if (hipGetDevice(&dev) != hipSuccess || hipDeviceGetAttribute(&cus, hipDeviceAttributeMultiprocessorCount, dev) != hipSuccess) { grid = -1; return; }
        if (hipFuncSetAttribute((const void*)mk_fwd, hipFuncAttributeMaxDynamicSharedMemorySize, LDS_BYTES) != hipSuccess) { fprintf(stderr, "kernel_launch: hipFuncSetAttribute failed\n"); grid = -1; return; }
        int per_cu = 0;
        if (hipOccupancyMaxActiveBlocksPerMultiprocessor(&per_cu, (const void*)mk_fwd, NWAVES * 64, LDS_BYTES) != hipSuccess || per_cu < 1)
            fprintf(stderr, "kernel_launch: note: occupancy query reports %d workgroups per CU\n", per_cu);
        (void)hipGetLastError();
        grid = cus;
    }
    if (grid < 0) return;
    if (hipMemsetAsync((char*)d_ws + WS_CTL, 0, CTL_ZERO_BYTES, stream) != hipSuccess) return;
    Args a{};
    a.x = (const float*)d_in[0]; a.norm_g = (const float*)d_in[1]; a.w_gate = (const float*)d_in[2]; a.w_up = (const float*)d_in[3]; a.w_down = (const float*)d_in[4];
    a.w_in[0] = (const float*)d_in[5]; a.b_f0 = (const float*)d_in[6]; a.w_in[1] = (const float*)d_in[7]; a.w_in[2] = (const float*)d_in[8]; a.w_in[3] = (const float*)d_in[9];
    a.b_f3 = (const float*)d_in[10]; a.w_out = (const float*)d_in[11]; a.rel_bias = (const float*)d_in[12]; a.final_g = (const float*)d_in[13];
    a.out = (float*)d_out; a.ws = (unsigned char*)d_ws;
#if MK_ONE_LAUNCH
    a.ph_lo = 0; a.ph_hi = N_PHASES;
    hipLaunchKernelGGL(mk_fwd, dim3(grid), dim3(NWAVES * 64), LDS_BYTES, stream, a);
#else
    for (int p = 0; p < N_PHASES; ++p) { a.ph_lo = p; a.ph_hi = p + 1; hipLaunchKernelGGL(mk_fwd, dim3(grid), dim3(NWAVES * 64), LDS_BYTES, stream, a); }
#endif
    const hipError_t le = hipPeekAtLastError();
    if (le != hipSuccess) fprintf(stderr, "kernel_launch: launch failed: %s\n", hipGetErrorName(le));
}
```

```cpp
#include <hip/hip_runtime.h>
#include <cstdio>
#include <cstdint>

#ifndef PROBE_DUP
#define PROBE_DUP 0
#endif
#define REP(k) _Pragma("unroll 1") for (int rep_ = 0; rep_ < ((PROBE_DUP == (k)) ? 2 : 1); ++rep_)
#ifndef RESID_BF16
#define RESID_BF16 1
#endif
#ifndef MK_ONE_LAUNCH
#define MK_ONE_LAUNCH 1
#endif

namespace pg8 {
#define PG8_LAS __attribute__((address_space(3)))
typedef unsigned short bf16_t;
typedef short bf16x8 __attribute__((ext_vector_type(8)));
typedef float f32x4 __attribute__((ext_vector_type(4)));
typedef unsigned u32x4 __attribute__((ext_vector_type(4)));
constexpr int BM = 256, BK = 64, HALF = 128, HTB = HALF * BK * 2, STAGE_BYTES = 8 * HTB, NXCD = 8, WGM = 8;

__host__ __device__ __forceinline__ int lds_byte(int r, int c) { const int st = (r >> 4) * 2 + (c >> 5), rr = r & 15, cc = c & 31, ob = rr * 64 + cc * 2; return st * 1024 + (ob ^ (((ob >> 9) & 1) << 5)); }
__host__ __device__ __forceinline__ void stage_rc(int b, int& R, int& C) { const int st = b / 1024, sb = b % 1024, swz = sb ^ (((sb >> 9) & 1) << 5); R = (st >> 1) * 16 + swz / 64; C = (st & 1) * 32 + (swz % 64) / 2; }
__host__ __device__ __forceinline__ int perm32(int rho) { const int n = rho >> 4, i = rho & 15; return 8 * (i >> 2) + 4 * n + (i & 3); }

struct Unit { int pm, pn; };
struct Gemm { const bf16_t* A; const bf16_t* Bt; int M, N, K; };

struct StaticOrder {
    int nM, nN, nwg, G, c;
    __host__ __device__ void init(int M, int N, int G_, int c_) { nM = M / BM; nN = N / BM; nwg = nM * nN; G = G_; c = c_; }
    __host__ __device__ bool next(int i, Unit& u) const {
        const long L = (long)i * G + c; if (L >= nwg) return false;
        int wgid = (int)L; { const int q = nwg / NXCD, r = nwg % NXCD, xcd = wgid % NXCD, off = wgid / NXCD; wgid = (xcd < r ? xcd * (q + 1) : r * (q + 1) + (xcd - r) * q) + off; }
        const int nig = WGM * nN, gid = wgid / nig, fm = gid * WGM, gsz = (nM - fm) < WGM ? (nM - fm) : WGM;
        u.pm = fm + ((wgid % nig) % gsz); u.pn = (wgid % nig) / gsz; return true;
    }
    __device__ __forceinline__ void a_ready(const Unit&) const {}
    __device__ __forceinline__ void done(const Unit&) const {}
};

__device__ __forceinline__ unsigned cvt_pk_bf16(float lo, float hi) { unsigned r; asm volatile("v_cvt_pk_bf16_f32 %0, %1, %2" : "=v"(r) : "v"(lo), "v"(hi)); return r; }

__device__ __forceinline__ float fq_sum(float s) {
    { auto rr = __builtin_amdgcn_permlane16_swap(__float_as_uint(s), __float_as_uint(s), false, false); s = __uint_as_float(rr[0]) + __uint_as_float(rr[1]); }
    { auto rr = __builtin_amdgcn_permlane32_swap(__float_as_uint(s), __float_as_uint(s), false, false); s = __uint_as_float(rr[0]) + __uint_as_float(rr[1]); }
    return s;
}
__device__ __forceinline__ float row_rstd(const float* part, int row, int fq) {
    const f32x4 a = *(const f32x4*)(part + (size_t)row * 32 + fq * 8), b = *(const f32x4*)(part + (size_t)row * 32 + fq * 8 + 4);
    const float s = fq_sum(((a[0] + a[1]) + (a[2] + a[3])) + ((b[0] + b[1]) + (b[2] + b[3])));
    return __builtin_amdgcn_rsqf(s * (1.0f / 2048.0f) + 1e-6f);
}
__device__ __forceinline__ void build_rstd_table(PG8_LAS float* rst, const float* part, int pm0, int tid) {
    if (tid < 256) { const f32x4* p = (const f32x4*)(part + (size_t)(pm0 * BM + tid) * 32); float s = 0.f;
#pragma unroll
        for (int j = 0; j < 8; ++j) { const f32x4 v = p[j]; s += (v[0] + v[1]) + (v[2] + v[3]); }
        rst[tid] = __builtin_amdgcn_rsqf(s * (1.0f / 2048.0f) + 1e-6f); }
    __syncthreads();
}
struct EpiBf16 {
    static constexpr bool PERM = true, AFTER_DRAIN = false;
    bf16_t* O; int ldc; const float* part; const PG8_LAS float* rst; int pm0;
    __device__ __forceinline__ void operator()(const f32x4 (&acc)[2][2][4][2], const Unit& u, int wr, int wc, int fr, int fq) const {
        const int row0 = u.pm * BM + wr * 64 + fr, col0 = u.pn * BM + wc * 32 + 8 * fq;
        float rs[2][4];
        if (u.pm == pm0) {
#pragma unroll
            for (int ai = 0; ai < 2; ++ai)
#pragma unroll
                for (int m = 0; m < 4; ++m) rs[ai][m] = rst[wr * 64 + fr + ai * HALF + m * 16];
        } else {
#pragma unroll
            for (int ai = 0; ai < 2; ++ai)
#pragma unroll
                for (int m = 0; m < 4; ++m) rs[ai][m] = row_rstd(part, row0 + ai * HALF + m * 16, fq);
        }
#pragma unroll
        for (int ai = 0; ai < 2; ++ai)
#pragma unroll
            for (int m = 0; m < 4; ++m) { bf16_t* rowp = O + (size_t)(row0 + ai * HALF + m * 16) * ldc + col0; const float r = rs[ai][m];
#pragma unroll
                for (int bj = 0; bj < 2; ++bj) { const f32x4 v0 = acc[ai][bj][m][0] * r, v1 = acc[ai][bj][m][1] * r;
                    u32x4 w; w.x = cvt_pk_bf16(v0[0], v0[1]); w.y = cvt_pk_bf16(v0[2], v0[3]); w.z = cvt_pk_bf16(v1[0], v1[1]); w.w = cvt_pk_bf16(v1[2], v1[3]);
                    *(u32x4*)(rowp + bj * HALF) = w; } }
    }
};
__device__ __forceinline__ float silu_mul(float g, float u) { const float e = __builtin_amdgcn_exp2f(g * -1.4426950408889634f); return g * __builtin_amdgcn_rcpf(1.0f + e) * u; }
struct EpiSwiGLU {
    static constexpr bool PERM = true, AFTER_DRAIN = false;
    bf16_t* O; int ldc; const float* part; const PG8_LAS float* rst; int pm0;
    __device__ __forceinline__ void operator()(const f32x4 (&acc)[2][2][4][2], const Unit& u, int wr, int wc, int fr, int fq) const {
        const int row0 = u.pm * BM + wr * 64 + fr, col0 = u.pn * HALF + wc * 32 + 8 * fq;
        float rs[2][4];
        if (u.pm == pm0) {
#pragma unroll
            for (int ai = 0; ai < 2; ++ai)
#pragma unroll
                for (int m = 0; m < 4; ++m) rs[ai][m] = rst[wr * 64 + fr + ai * HALF + m * 16];
        } else {
#pragma unroll
            for (int ai = 0; ai < 2; ++ai)
#pragma unroll
                for (int m = 0; m < 4; ++m) rs[ai][m] = row_rstd(part, row0 + ai * HALF + m * 16, fq);
        }
#pragma unroll
        for (int ai = 0; ai < 2; ++ai)
#pragma unroll
            for (int m = 0; m < 4; ++m) { bf16_t* rowp = O + (size_t)(row0 + ai * HALF + m * 16) * ldc + col0; const float r = rs[ai][m];
                const f32x4 g0 = acc[ai][0][m][0] * r, g1 = acc[ai][0][m][1] * r, u0 = acc[ai][1][m][0] * r, u1 = acc[ai][1][m][1] * r;
                u32x4 w; w.x = cvt_pk_bf16(silu_mul(g0[0], u0[0]), silu_mul(g0[1], u0[1])); w.y = cvt_pk_bf16(silu_mul(g0[2], u0[2]), silu_mul(g0[3], u0[3]));
                w.z = cvt_pk_bf16(silu_mul(g1[0], u1[0]), silu_mul(g1[1], u1[1])); w.w = cvt_pk_bf16(silu_mul(g1[2], u1[2]), silu_mul(g1[3], u1[3]));
                *(u32x4*)rowp = w; }
    }
};
struct EpiResid {
    static constexpr bool PERM = true, AFTER_DRAIN = false;
    const float* base; float* out; bf16_t* xb; float* part; int ldc; float alpha;
    __device__ __forceinline__ void operator()(const f32x4 (&acc)[2][2][4][2], const Unit& u, int wr, int wc, int fr, int fq) const {
        const int row0 = u.pm * BM + wr * 64 + fr, col0 = u.pn * BM + wc * 32 + 8 * fq;
#pragma unroll
        for (int ai = 0; ai < 2; ++ai)
#pragma unroll
            for (int m = 0; m < 4; ++m) { const int row = row0 + ai * HALF + m * 16; const size_t off = (size_t)row * ldc + col0; float s = 0.f;
#pragma unroll
                for (int bj = 0; bj < 2; ++bj) { const f32x4 b0 = *(const f32x4*)(base + off + bj * HALF), b1 = *(const f32x4*)(base + off + bj * HALF + 4);
                    const f32x4 o0 = b0 + alpha * acc[ai][bj][m][0], o1 = b1 + alpha * acc[ai][bj][m][1];
                    *(f32x4*)(out + off + bj * HALF) = o0; *(f32x4*)(out + off + bj * HALF + 4) = o1;
                    u32x4 w; w.x = cvt_pk_bf16(o0[0], o0[1]); w.y = cvt_pk_bf16(o0[2], o0[3]); w.z = cvt_pk_bf16(o1[0], o1[1]); w.w = cvt_pk_bf16(o1[2], o1[3]);
                    *(u32x4*)(xb + off + bj * HALF) = w;
                    s += ((o0[0] * o0[0] + o0[1] * o0[1]) + (o0[2] * o0[2] + o0[3] * o0[3])) + ((o1[0] * o1[0] + o1[1] * o1[1]) + (o1[2] * o1[2] + o1[3] * o1[3])); }
                s = fq_sum(s);
                if (fq == 0) part[(size_t)row * 32 + u.pn * 4 + wc] = s;
                if (m & 1) asm volatile("" ::: "memory"); }
    }
};

struct EpiResidB {
    static constexpr bool PERM = true, AFTER_DRAIN = false;
    bf16_t* xb; float* part; int ldc; float alpha;
    __device__ __forceinline__ void operator()(const f32x4 (&acc)[2][2][4][2], const Unit& u, int wr, int wc, int fr, int fq) const {
        const int row0 = u.pm * BM + wr * 64 + fr, col0 = u.pn * BM + wc * 32 + 8 * fq;
#pragma unroll
        for (int ai = 0; ai < 2; ++ai)
#pragma unroll
            for (int m = 0; m < 4; ++m) { const int row = row0 + ai * HALF + m * 16; const size_t off = (size_t)row * ldc + col0; float s = 0.f;
#pragma unroll
                for (int bj = 0; bj < 2; ++bj) { const u32x4 b = *(const u32x4*)(xb + off + bj * HALF);
                    const f32x4 b0 = {__uint_as_float(b.x << 16), __uint_as_float(b.x & 0xffff0000u), __uint_as_float(b.y << 16), __uint_as_float(b.y & 0xffff0000u)};
                    const f32x4 b1 = {__uint_as_float(b.z << 16), __uint_as_float(b.z & 0xffff0000u), __uint_as_float(b.w << 16), __uint_as_float(b.w & 0xffff0000u)};
                    const f32x4 o0 = b0 + alpha * acc[ai][bj][m][0], o1 = b1 + alpha * acc[ai][bj][m][1];
                    u32x4 w; w.x = cvt_pk_bf16(o0[0], o0[1]); w.y = cvt_pk_bf16(o0[2], o0[3]); w.z = cvt_pk_bf16(o1[0], o1[1]); w.w = cvt_pk_bf16(o1[2], o1[3]);
                    *(u32x4*)(xb + off + bj * HALF) = w;
                    const f32x4 r0 = {__uint_as_float(w.x << 16), __uint_as_float(w.x & 0xffff0000u), __uint_as_float(w.y << 16), __uint_as_float(w.y & 0xffff0000u)};
                    const f32x4 r1 = {__uint_as_float(w.z << 16), __uint_as_float(w.z & 0xffff0000u), __uint_as_float(w.w << 16), __uint_as_float(w.w & 0xffff0000u)};
                    s += ((r0[0] * r0[0] + r0[1] * r0[1]) + (r0[2] * r0[2] + r0[3] * r0[3])) + ((r1[0] * r1[0] + r1[1] * r1[1]) + (r1[2] * r1[2] + r1[3] * r1[3])); }
                s = fq_sum(s);
                if (fq == 0) part[(size_t)row * 32 + u.pn * 4 + wc] = s; }
    }
};
struct EpiNull {
    static constexpr bool PERM = true, AFTER_DRAIN = false;
    float* sink;
    __device__ __forceinline__ void operator()(const f32x4 (&acc)[2][2][4][2], const Unit& u, int wr, int wc, int fr, int fq) const {
        f32x4 t = {0.f, 0.f, 0.f, 0.f};
#pragma unroll
        for (int ai = 0; ai < 2; ++ai)
#pragma unroll
            for (int bj = 0; bj < 2; ++bj)
#pragma unroll
                for (int m = 0; m < 4; ++m)
#pragma unroll
                    for (int n = 0; n < 2; ++n) t += acc[ai][bj][m][n];
        if ((t[0] + t[1]) + (t[2] + t[3]) == 1.2345678e30f) sink[0] = 1.f;
    }
};
template <class Epi, class Sched, bool ALIGN_EPI = false, bool SP2 = false>
__device__ __forceinline__ void gemm_phase(PG8_LAS unsigned char* lds, const Gemm g, const Sched& S, const Epi& E) {
    int tid = threadIdx.x; asm volatile("" : "+v"(tid));
    const int wid = __builtin_amdgcn_readfirstlane(tid >> 6), lane = tid & 63, wr = wid >> 2, wc = wid & 3, fr = lane & 15, fq = lane >> 4;
    const int K = g.K, nt = K / BK;
    unsigned voffA[2], voffB[2];
#pragma unroll
    for (int i = 0; i < 2; ++i) { int R, C; stage_rc(tid * 16 + i * 8192, R, C); const int Rb = Epi::PERM ? ((R & ~31) + perm32(R & 31)) : R;
        voffA[i] = (unsigned)(R * K + C) * 2u; voffB[i] = (unsigned)(Rb * K + C) * 2u; }
    const size_t kstep = (size_t)(BK * 2);
    const size_t hstep = (size_t)HALF * K * 2;
    const size_t tstep = 2 * hstep;
    const unsigned ldsw = (unsigned)wid * 1024u;
    const int aoff = lds_byte(wr * 64 + fr, fq * 8), boff = lds_byte(wc * 32 + fr, fq * 8);
#define PG8_SA(b, h) (((b) * 2 + (h)) * HTB)
#define PG8_SB(b, h) ((4 + (b) * 2 + (h)) * HTB)
#define PG8_STAGE(bufoff, gbase, voff) do { _Pragma("unroll") for (int _i = 0; _i < 2; ++_i) \
        __builtin_amdgcn_global_load_lds((const unsigned*)((const char*)(gbase) + (voff)[_i]), (PG8_LAS unsigned*)(lds + (bufoff) + ldsw + _i * 8192), 16, 0, 0); } while (0)
#define PG8_LDA(dst, b, h) do { _Pragma("unroll") for (int m = 0; m < 4; ++m) _Pragma("unroll") for (int k = 0; k < 2; ++k) dst[m][k] = *(const PG8_LAS bf16x8*)(lds + PG8_SA(b, h) + aoff + m * 2048 + k * 1024); } while (0)
#define PG8_LDB(dst, b, h) do { _Pragma("unroll") for (int n = 0; n < 2; ++n) _Pragma("unroll") for (int k = 0; k < 2; ++k) dst[n][k] = *(const PG8_LAS bf16x8*)(lds + PG8_SB(b, h) + boff + n * 2048 + k * 1024); } while (0)
#define PG8_MMA(ai, bj, At, Bt) do { __builtin_amdgcn_s_setprio(1); _Pragma("unroll") for (int m = 0; m < 4; ++m) _Pragma("unroll") for (int n = 0; n < 2; ++n) _Pragma("unroll") for (int k = 0; k < 2; ++k) \
        acc[ai][bj][m][n] = __builtin_amdgcn_mfma_f32_16x16x32_bf16(Bt[n][k], At[m][k], acc[ai][bj][m][n], 0, 0, 0); __builtin_amdgcn_s_setprio(0); } while (0)
#define PG8_WAIT_V(n) asm volatile("s_waitcnt vmcnt(" #n ")" ::: "memory")
#define PG8_WAIT_L(n) asm volatile("s_waitcnt lgkmcnt(" #n ")" ::: "memory")
#define PG8_BAR __builtin_amdgcn_s_barrier()
#define PG8_SCHED __builtin_amdgcn_sched_barrier(0)
    Unit cur, nxt; int ui = 0;
    if (!S.next(0, cur)) return;
    f32x4 acc[2][2][4][2];
#pragma unroll
    for (int a = 0; a < 2; ++a)
#pragma unroll
        for (int b = 0; b < 2; ++b)
#pragma unroll
            for (int m = 0; m < 4; ++m)
#pragma unroll
                for (int n = 0; n < 2; ++n) acc[a][b][m][n] = (f32x4){0.f, 0.f, 0.f, 0.f};
    bf16x8 At[4][2], B0[2][2], B1[2][2];
    const char* cA = (const char*)g.A + (size_t)cur.pm * tstep; const char* cB = (const char*)g.Bt + (size_t)cur.pn * tstep;
    S.a_ready(cur);
    if constexpr (SP2) {
        PG8_STAGE(PG8_SB(0, 0), cB, voffB); PG8_STAGE(PG8_SB(0, 1), cB + hstep, voffB); PG8_STAGE(PG8_SA(0, 0), cA, voffA); PG8_STAGE(PG8_SA(0, 1), cA + hstep, voffA);
        if (wr == 1) PG8_BAR;
        PG8_WAIT_V(2); PG8_BAR;
        PG8_STAGE(PG8_SB(1, 0), cB + kstep, voffB); PG8_STAGE(PG8_SA(1, 0), cA + kstep, voffA); PG8_STAGE(PG8_SB(1, 1), cB + hstep + kstep, voffB);
        PG8_WAIT_V(6); PG8_BAR;
    } else {
        PG8_STAGE(PG8_SB(0, 0), cB, voffB); PG8_STAGE(PG8_SA(0, 0), cA, voffA); PG8_STAGE(PG8_SB(0, 1), cB + hstep, voffB); PG8_STAGE(PG8_SA(0, 1), cA + hstep, voffA);
        if (wr == 1) PG8_BAR;
        PG8_WAIT_V(4); PG8_BAR;
        PG8_STAGE(PG8_SB(1, 0), cB + kstep, voffB); PG8_STAGE(PG8_SA(1, 0), cA + kstep, voffA); PG8_STAGE(PG8_SB(1, 1), cB + hstep + kstep, voffB);
        PG8_WAIT_V(6); PG8_BAR;
    }
    for (;;) {
        const bool has_next = S.next(ui + 1, nxt);
        const char* nA = has_next ? (const char*)g.A + (size_t)nxt.pm * tstep : cA; const char* nB = has_next ? (const char*)g.Bt + (size_t)nxt.pn * tstep : cB;
        for (int t = 0; t < nt; t += 2) {
            const bool last = (t == nt - 2);
            const char* a1 = cA + (size_t)(t + 1) * kstep;
            const char* a2 = last ? nA : cA + (size_t)(t + 2) * kstep; const char* b2 = last ? nB : cB + (size_t)(t + 2) * kstep;
            const char* a3 = a2 + kstep; const char* b3 = b2 + kstep;
            if (last && has_next) S.a_ready(nxt);
            if constexpr (SP2) {
            PG8_LDB(B0, 0, 0); PG8_LDB(B1, 0, 1); PG8_SCHED; PG8_LDA(At, 0, 0); PG8_STAGE(PG8_SA(1, 1), a1 + hstep, voffA);
            PG8_WAIT_V(8); PG8_WAIT_L(0); PG8_BAR; PG8_MMA(0, 0, At, B0); PG8_MMA(0, 1, At, B1); PG8_BAR; PG8_SCHED;
            PG8_LDA(At, 0, 1); PG8_STAGE(PG8_SB(0, 0), b2, voffB); PG8_STAGE(PG8_SB(0, 1), b2 + hstep, voffB); PG8_STAGE(PG8_SA(0, 0), a2, voffA);
            PG8_WAIT_V(8); PG8_WAIT_L(0); PG8_BAR; PG8_MMA(1, 0, At, B0); PG8_MMA(1, 1, At, B1); PG8_BAR; PG8_SCHED;
            PG8_LDB(B0, 1, 0); PG8_LDB(B1, 1, 1); PG8_SCHED; PG8_LDA(At, 1, 0); PG8_STAGE(PG8_SA(0, 1), a2 + hstep, voffA);
            PG8_WAIT_V(8); PG8_WAIT_L(0); PG8_BAR; PG8_MMA(0, 0, At, B0); PG8_MMA(0, 1, At, B1); PG8_BAR; PG8_SCHED;
            PG8_LDA(At, 1, 1); PG8_STAGE(PG8_SB(1, 0), b3, voffB); PG8_STAGE(PG8_SB(1, 1), b3 + hstep, voffB); PG8_STAGE(PG8_SA(1, 0), a3, voffA);
            PG8_WAIT_V(8); PG8_WAIT_L(0); PG8_BAR; PG8_MMA(1, 0, At, B0); PG8_MMA(1, 1, At, B1); PG8_BAR; PG8_SCHED;
            } else {
            PG8_LDB(B0, 0, 0); PG8_SCHED; PG8_LDA(At, 0, 0); PG8_STAGE(PG8_SA(1, 1), a1 + hstep, voffA);
            PG8_WAIT_L(8); PG8_BAR; PG8_WAIT_L(0); PG8_MMA(0, 0, At, B0); PG8_BAR; PG8_SCHED;
            PG8_LDB(B1, 0, 1); PG8_STAGE(PG8_SB(0, 0), b2, voffB);
            PG8_BAR; PG8_WAIT_L(0); PG8_MMA(0, 1, At, B1); PG8_BAR;
            PG8_LDA(At, 0, 1); PG8_STAGE(PG8_SA(0, 0), a2, voffA);
            PG8_BAR; PG8_WAIT_L(0); PG8_MMA(1, 0, At, B0); PG8_BAR; PG8_SCHED;
            PG8_STAGE(PG8_SB(0, 1), b2 + hstep, voffB);
            PG8_WAIT_V(6); PG8_BAR; PG8_MMA(1, 1, At, B1); PG8_BAR;
            PG8_LDB(B0, 1, 0); PG8_SCHED; PG8_LDA(At, 1, 0); PG8_STAGE(PG8_SA(0, 1), a2 + hstep, voffA);
            PG8_WAIT_L(8); PG8_BAR; PG8_WAIT_L(0); PG8_MMA(0, 0, At, B0); PG8_BAR; PG8_SCHED;
            PG8_LDB(B1, 1, 1); PG8_STAGE(PG8_SB(1, 0), b3, voffB);
            PG8_BAR; PG8_WAIT_L(0); PG8_MMA(0, 1, At, B1); PG8_BAR;
            PG8_LDA(At, 1, 1); PG8_STAGE(PG8_SA(1, 0), a3, voffA);
            PG8_BAR; PG8_WAIT_L(0); PG8_MMA(1, 0, At, B0); PG8_BAR; PG8_SCHED;
            PG8_STAGE(PG8_SB(1, 1), b3 + hstep, voffB);
            PG8_WAIT_V(6); PG8_BAR; PG8_MMA(1, 1, At, B1); PG8_BAR;
            }
        }
        if constexpr (ALIGN_EPI) { if (wr == 0) PG8_BAR; }
        if constexpr (!Epi::AFTER_DRAIN) { E(acc, cur, wr, wc, fr, fq); S.done(cur); }
        if (!has_next) break;
#pragma unroll
        for (int a = 0; a < 2; ++a)
#pragma unroll
            for (int b = 0; b < 2; ++b)
#pragma unroll
                for (int m = 0; m < 4; ++m)
#pragma unroll
                    for (int n = 0; n < 2; ++n) acc[a][b][m][n] = (f32x4){0.f, 0.f, 0.f, 0.f};
        cur = nxt; cA = nA; cB = nB; ++ui;
        if constexpr (ALIGN_EPI) { if (wr == 1) PG8_BAR; }
    }
    PG8_WAIT_V(0);
    if constexpr (!ALIGN_EPI) { if (wr == 0) PG8_BAR; }
    PG8_BAR;
#undef PG8_SA
#undef PG8_SB
#undef PG8_STAGE
#undef PG8_LDA
#undef PG8_LDB
#undef PG8_MMA
#undef PG8_WAIT_V
#undef PG8_WAIT_L
#undef PG8_BAR
#undef PG8_SCHED
}
}

constexpr int DM = 2048, NBATCH = 8, SEQ = 2048, DEPTH = 4, NH = 16, HD = 128, FF = 5632;
constexpr int M = NBATCH * SEQ;
constexpr int NGU = 2 * FF, NQKV = 3 * DM;
constexpr float RMS_EPS = 1e-6f;
constexpr int NWAVES = 8;

constexpr size_t MiB = 1u << 20;
constexpr size_t WS_CTL = 0, CTL_ZERO_BYTES = 1 * MiB;
constexpr size_t WS_LF = 1 * MiB;
constexpr size_t WS_PART = 2 * MiB;
constexpr size_t WS_WF = 4 * MiB;
constexpr size_t WS_WGU = 5 * MiB;
constexpr size_t SZ_WGU = (size_t)NGU * DM * 2;
constexpr size_t WS_WD = WS_WGU + 8 * SZ_WGU;
constexpr size_t SZ_WD = (size_t)DM * FF * 2;
constexpr size_t WS_WQKV = WS_WD + 8 * SZ_WD;
constexpr size_t SZ_WQKV = (size_t)NQKV * DM * 2;
constexpr size_t WS_WO = WS_WQKV + 4 * SZ_WQKV;
constexpr size_t SZ_WO = (size_t)DM * DM * 2;
constexpr size_t WS_H = WS_WO + 4 * SZ_WO;
constexpr size_t WS_AO = WS_H + (size_t)M * DM * 2;
constexpr size_t WS_ACT = WS_AO + (size_t)M * DM * 2;
constexpr size_t WS_END = WS_ACT + (size_t)M * NQKV * 2;
static_assert(WS_WGU % 256 == 0 && WS_WD % 256 == 0 && WS_WQKV % 256 == 0 && WS_WO % 256 == 0 && WS_H % 256 == 0 && WS_ACT % 256 == 0, "alignment");

constexpr int CW_TMO = 0;
constexpr int CW_BAR = 4096;

constexpr int RING_OFF = 0, RING_BYTES = 131072;
constexpr int LDS_BYTES = 147456;
constexpr int RST_OFF = RING_BYTES;
constexpr int MISC_OFF = LDS_BYTES - 256;

#define GAS __attribute__((address_space(1)))
#define LAS __attribute__((address_space(3)))
typedef unsigned short bf16;
typedef unsigned v4u __attribute__((ext_vector_type(4)));
typedef unsigned v2u __attribute__((ext_vector_type(2)));
typedef float f32x4 __attribute__((ext_vector_type(4)));
typedef float f32x16 __attribute__((ext_vector_type(16)));
typedef short bf16x8 __attribute__((ext_vector_type(8)));
typedef short s16x4 __attribute__((ext_vector_type(4)));
typedef GAS unsigned gu32;
#define RLX_AGENT __ATOMIC_RELAXED, __HIP_MEMORY_SCOPE_AGENT
#define LDS_WAIT() asm volatile("s_waitcnt lgkmcnt(0)" ::: "memory")
#define VM_WAIT() asm volatile("s_waitcnt vmcnt(0)" ::: "memory")
__device__ __forceinline__ unsigned cvtpk(float lo, float hi) { unsigned r; asm volatile("v_cvt_pk_bf16_f32 %0, %1, %2" : "=v"(r) : "v"(lo), "v"(hi)); return r; }

#define XB_TMO      128
#define XB_XCNT(j)  (256  + 64 * (j))
#define XB_XSUB(j)  (1280 + 64 * (j))
#define XB_XGEN(j)  (2304 + 64 * (j))
#define XB_TOP      3328
#define XB_TOPGEN   3392
#define XCD_BAR_WORDS 3456
#define XB_SPIN_CAP (1u << 18)
__device__ __forceinline__ unsigned xb_ld(unsigned* p)              { return __hip_atomic_load(p, __ATOMIC_RELAXED, __HIP_MEMORY_SCOPE_AGENT); }
__device__ __forceinline__ unsigned xb_add(unsigned* p, unsigned v) { return __hip_atomic_fetch_add(p, v, __ATOMIC_RELAXED, __HIP_MEMORY_SCOPE_AGENT); }
__device__ __forceinline__ unsigned xb_xcc_id() { return (unsigned)__builtin_amdgcn_s_getreg((3 << 11) | 20) & 0xFu; }
#define XB_SPIN(cond, bar) do { unsigned _sp = 0; while (cond) { __builtin_amdgcn_s_sleep(1); \
    if ((++_sp & 255u) == 0u) { if (xb_ld(&(bar)[XB_TMO])) break; if (_sp > XB_SPIN_CAP) { atomicAdd(&(bar)[XB_TMO], 1u); break; } } } } while (0)
struct XcdBarrier { unsigned* bar; unsigned x; volatile LAS unsigned* st; };
__device__ __forceinline__ XcdBarrier xcd_barrier_post(unsigned* bar, volatile LAS unsigned* st) {
    XcdBarrier b; b.bar = bar; b.x = xb_xcc_id(); b.st = st;
    if (threadIdx.x == 0) (void)xb_add(&bar[XB_XCNT(b.x)], 1u);
    return b;
}
__device__ __forceinline__ void xcd_barrier_complete(unsigned* bar, unsigned x, unsigned& nloc, unsigned& nx) {
    const unsigned G = gridDim.x * gridDim.y * gridDim.z;
    unsigned sum, cnt, mine, sp = 0u;
    for (;;) {
        sum = 0u; cnt = 0u; mine = 0u;
#pragma unroll
        for (unsigned j = 0; j < 16; ++j) { const unsigned c = xb_ld(&bar[XB_XCNT(j)]); sum += c; cnt += (c > 0u) ? 1u : 0u; mine = (j == x) ? c : mine; }
        if (sum == G) break;
        __builtin_amdgcn_s_sleep(1);
        if ((++sp & 255u) == 0u) { if (xb_ld(&bar[XB_TMO])) break; if (sp > XB_SPIN_CAP) { atomicAdd(&bar[XB_TMO], 1u); break; } }
    }
    nloc = mine > 0u ? mine : 1u; nx = cnt > 0u ? cnt : 1u;
}
__device__ __forceinline__ void xcd_barrier(const XcdBarrier& b) {
    asm volatile("s_waitcnt vmcnt(0)" ::: "memory");
    __syncthreads();
    if (threadIdx.x == 0) {
        unsigned* bar = b.bar;
        __builtin_amdgcn_s_waitcnt(0);
        unsigned nloc = b.st[0], nx = b.st[1];
        if (nloc == 0u) { xcd_barrier_complete(bar, b.x, nloc, nx); b.st[0] = nloc; b.st[1] = nx; }
        const unsigned old = xb_add(&bar[XB_XSUB(b.x)], 1u);
        const unsigned gen = old / nloc;
        if (old + 1u == (gen + 1u) * nloc) {
            __builtin_amdgcn_fence(__ATOMIC_RELEASE, "agent");
            asm volatile("s_waitcnt vmcnt(0)" ::: "memory");
            const unsigned og = xb_add(&bar[XB_TOP], 1u);
            const unsigned tg = og / nx;
            if (og + 1u == (tg + 1u) * nx) xb_add(&bar[XB_TOPGEN], 1u);
            else XB_SPIN(xb_ld(&bar[XB_TOPGEN]) == tg, bar);
            __builtin_amdgcn_fence(__ATOMIC_ACQUIRE, "agent");
            xb_add(&bar[XB_XGEN(b.x)], 1u);
            asm volatile("s_waitcnt vmcnt(0)" ::: "memory");
        } else {
            XB_SPIN(xb_ld(&bar[XB_XGEN(b.x)]) == gen, bar);
            __builtin_amdgcn_fence(__ATOMIC_ACQUIRE, "agent");
            asm volatile("s_waitcnt vmcnt(0)" ::: "memory");
        }
    }
    __syncthreads();
}

__device__ __forceinline__ int opaque_tid() { int t = threadIdx.x; asm volatile("" : "+v"(t)); return t; }
__device__ __forceinline__ float wave_sum(float v) {
#pragma unroll
    for (int o = 1; o < 64; o <<= 1) v += __shfl_xor(v, o);
    return v;
}

__device__ __forceinline__ void transpose_item(const float* __restrict__ W, int ldw, int Kdim, bf16* __restrict__ WT, int k0, int n0, int drow0, const float* __restrict__ gk, LAS float* scr, int lane) {
    const int nl = (lane & 15) * 4, kl = lane >> 4;
    f32x4 v[16];
#pragma unroll
    for (int i = 0; i < 16; ++i) v[i] = *(const GAS f32x4*)(W + (size_t)(k0 + 4 * i + kl) * ldw + n0 + nl);
#pragma unroll
    for (int i = 0; i < 16; ++i) { const float gg = gk ? gk[k0 + 4 * i + kl] : 1.0f; LAS float* s = scr + (4 * i + kl) * 65 + nl; s[0] = v[i].x * gg; s[1] = v[i].y * gg; s[2] = v[i].z * gg; s[3] = v[i].w * gg; }
    LDS_WAIT(); asm volatile("" ::: "memory");
    const int c = lane & 7;
#pragma unroll
    for (int j = 0; j < 8; ++j) { const int n = (lane >> 3) + 8 * j; const LAS float* s = scr + (8 * c) * 65 + n;
        v4u o; o.x = cvtpk(s[0 * 65], s[1 * 65]); o.y = cvtpk(s[2 * 65], s[3 * 65]); o.z = cvtpk(s[4 * 65], s[5 * 65]); o.w = cvtpk(s[6 * 65], s[7 * 65]);
        *(GAS v4u*)(WT + (size_t)(drow0 + n) * Kdim + k0 + 8 * c) = o; }
    LDS_WAIT(); asm volatile("" ::: "memory");
}

namespace att {
constexpr int D = 128, NW = 8, QBLK = 32, KVBLK = 64, QB = 256;
constexpr int SHM_K = KVBLK * D * 2, SHM_V = KVBLK * D * 2;
constexpr int L_V = 0, L_K = 2 * SHM_V, L_WS = L_K + 2 * SHM_K, L_TAB = L_WS + NW * 64 * 4, L_SCAN = L_TAB + 2304 * 4, L_FLAG = L_SCAN + 64, L_END = L_FLAG + 64;
constexpr int TAB_N = 2304;
constexpr int QPITCH = NQKV, OPITCH = DM;
constexpr float SCALE = 0.08838834764831845f;
constexpr float C2 = 1.4426950408889634f * SCALE;
constexpr float THR = 8.f;

#define KSWZ(row, colB) ((row) * 256 + ((colB) ^ (((row) & 7) << 4)))
#define SBAR() __builtin_amdgcn_sched_barrier(0)
__device__ __forceinline__ int v_st(int k, int c) { const int kk = (k & ~0xC) | ((k & 4) << 1) | ((k & 8) >> 1); return ((kk >> 3) * 4 + (c >> 5)) * 512 + ((kk & 7) * 32 + (c & 31)) * 2; }
__device__ __forceinline__ int v_rd_base(int lane) { return ((lane & 3) << 3) | (((lane >> 2) & 3) << 6) | (((lane >> 4) & 1) << 5) | (((lane >> 5) & 1) << 8); }
constexpr int v_rd_off(int d0, int ks, int half) { return d0 * 512 + ks * 4096 + half * 2048; }
__device__ __forceinline__ int crow(int r, int hi) { return (r & 3) + 8 * (r >> 2) + 4 * hi; }

template <bool STRICT>
__device__ __forceinline__ void mask_tile(f32x16& p0, f32x16& p1, int dq) {
    const float NEG = -__builtin_inff();
    const int lim = STRICT ? 1 : 0;
#pragma unroll
    for (int r = 0; r < 16; ++r) {
        const int c = (r & 3) + 8 * (r >> 2);
        if (dq - c < lim) p0[r] = NEG;
        if (dq - c - 32 < lim) p1[r] = NEG;
    }
}
__device__ __forceinline__ void partialSM(f32x16& p0, f32x16& p1, float& m_reg, float& mn, float& alpha) {
    float pmax = p0[0];
#pragma unroll
    for (int r = 1; r < 16; ++r) pmax = fmaxf(pmax, p0[r]);
#pragma unroll
    for (int r = 0; r < 16; ++r) pmax = fmaxf(pmax, p1[r]);
    { auto rr = __builtin_amdgcn_permlane32_swap(__float_as_uint(pmax), __float_as_uint(pmax), false, false);
      pmax = fmaxf(__uint_as_float(rr[0]), __uint_as_float(rr[1])); }
    if (__builtin_expect(__all((pmax - m_reg) * SCALE <= THR), 1)) { mn = m_reg; alpha = 1.f; }
    else { mn = fmaxf(m_reg, pmax); alpha = __builtin_amdgcn_exp2f((m_reg - mn) * C2); m_reg = mn; }
    const float mnL = -mn * C2;
#pragma unroll
    for (int r = 0; r < 16; ++r) p0[r] = fmaf(p0[r], C2, mnL);
#pragma unroll
    for (int r = 0; r < 16; ++r) p1[r] = fmaf(p1[r], C2, mnL);
#pragma unroll
    for (int r = 0; r < 16; ++r) p0[r] = __builtin_amdgcn_exp2f(p0[r]);
}
#define PK4(P, B_, OUT) do { unsigned a0 = cvtpk(P[B_+0], P[B_+1]), a1 = cvtpk(P[B_+2], P[B_+3]);                          \
        unsigned b0 = cvtpk(P[B_+4], P[B_+5]), b1 = cvtpk(P[B_+6], P[B_+7]);                                             \
        auto r0 = __builtin_amdgcn_permlane32_swap(a0, b0, false, false); auto r1 = __builtin_amdgcn_permlane32_swap(a1, b1, false, false); \
        v4u w = {r0[0], r1[0], r0[1], r1[1]}; OUT = __builtin_bit_cast(bf16x8, w); } while (0)
__device__ __forceinline__ void finishSM(f32x16& p0, f32x16& p1, float alpha, float& l_reg, bf16x8& pa0, bf16x8& pa1, bf16x8& pa2, bf16x8& pa3) {
#pragma unroll
    for (int r = 0; r < 16; ++r) p1[r] = __builtin_amdgcn_exp2f(p1[r]);
    float ps = 0;
#pragma unroll
    for (int r = 0; r < 16; ++r) ps += p0[r];
#pragma unroll
    for (int r = 0; r < 16; ++r) ps += p1[r];
    { auto rr = __builtin_amdgcn_permlane32_swap(__float_as_uint(ps), __float_as_uint(ps), false, false);
      ps = __uint_as_float(rr[0]) + __uint_as_float(rr[1]); }
    l_reg = l_reg * alpha + ps;
    PK4(p0, 0, pa0); PK4(p0, 8, pa1); PK4(p1, 0, pa2); PK4(p1, 8, pa3);
}
template <int KB>
__device__ __forceinline__ void qkt(f32x16& p0, f32x16& p1, const LAS char* K_lds, int r32, int hi, const bf16x8* qr) {
    const LAS char* kb[4];
#pragma unroll
    for (int dd = 0; dd < 4; ++dd) kb[dd] = K_lds + KB * SHM_K + KSWZ(r32, (dd * 16 + hi * 8) * 2);
#pragma unroll
    for (int d0 = 0; d0 < 8; ++d0) { const LAS char* a = kb[d0 & 3] + (d0 >> 2) * 128;
        bf16x8 b0 = *reinterpret_cast<const LAS bf16x8*>(a);
        bf16x8 b1 = *reinterpret_cast<const LAS bf16x8*>(a + 32 * 256);
        p0 = __builtin_amdgcn_mfma_f32_32x32x16_bf16(b0, qr[d0], p0, 0, 0, 0);
        p1 = __builtin_amdgcn_mfma_f32_32x32x16_bf16(b1, qr[d0], p1, 0, 0, 0); }
}
template <int VB>
__device__ __forceinline__ void pv_tile(f32x16* o, int vb0, bf16x8 pa0, bf16x8 pa1, bf16x8 pa2, bf16x8 pa3) {
#define TRRD(dst, off) asm volatile("ds_read_b64_tr_b16 %0, %1 offset:%2" : "=&v"(dst) : "v"(vb0), "i"(off) : "memory")
#define PV_D0(d0) do { s16x4 l0, l1, l2, l3, h0, h1, h2, h3; constexpr int b_ = VB * SHM_V + v_rd_off(d0, 0, 0); \
        TRRD(l0, b_); TRRD(h0, b_ + 2048); TRRD(l1, b_ + 4096); TRRD(h1, b_ + 6144); TRRD(l2, b_ + 8192); TRRD(h2, b_ + 10240); TRRD(l3, b_ + 12288); TRRD(h3, b_ + 14336); \
        asm volatile("s_waitcnt lgkmcnt(0)" ::: "memory"); SBAR();   \
        o[d0] = __builtin_amdgcn_mfma_f32_32x32x16_bf16(pa0, (bf16x8){l0[0], l0[1], l0[2], l0[3], h0[0], h0[1], h0[2], h0[3]}, o[d0], 0, 0, 0);   \
        o[d0] = __builtin_amdgcn_mfma_f32_32x32x16_bf16(pa1, (bf16x8){l1[0], l1[1], l1[2], l1[3], h1[0], h1[1], h1[2], h1[3]}, o[d0], 0, 0, 0);   \
        o[d0] = __builtin_amdgcn_mfma_f32_32x32x16_bf16(pa2, (bf16x8){l2[0], l2[1], l2[2], l2[3], h2[0], h2[1], h2[2], h2[3]}, o[d0], 0, 0, 0);   \
        o[d0] = __builtin_amdgcn_mfma_f32_32x32x16_bf16(pa3, (bf16x8){l3[0], l3[1], l3[2], l3[3], h3[0], h3[1], h3[2], h3[3]}, o[d0], 0, 0, 0); } while (0)
    PV_D0(0); PV_D0(1); PV_D0(2); PV_D0(3);
#undef PV_D0
#undef TRRD
}
__device__ __forceinline__ float suffix32(const f32x16& x, f32x16& aft, float base, int hi) {
    float c0[4], c1[4];
#pragma unroll
    for (int g = 0; g < 4; ++g) { const float c = (x[4 * g] + x[4 * g + 1]) + (x[4 * g + 2] + x[4 * g + 3]);
        auto rr = __builtin_amdgcn_permlane32_swap(__float_as_uint(c), __float_as_uint(c), false, false);
        c0[g] = __uint_as_float(rr[0]); c1[g] = __uint_as_float(rr[1]); }
    float s = base;
#pragma unroll
    for (int g = 3; g >= 0; --g) { const float sx1 = s; s += c1[g]; const float sx0 = s; s += c0[g];
        const float sx = hi ? sx1 : sx0;
        aft[4 * g + 3] = sx; aft[4 * g + 2] = aft[4 * g + 3] + x[4 * g + 3]; aft[4 * g + 1] = aft[4 * g + 2] + x[4 * g + 2]; aft[4 * g] = aft[4 * g + 1] + x[4 * g + 1]; }
    return s;
}

template <int MODE, int KVB>
__device__ __forceinline__ void attn_tile(f32x16* o, float& m_reg, float& l_reg, float& R, const bf16x8* qr, const LAS char* K_lds, int vb0, const LAS float* tab, LAS float* al_l,
                                          int kb, int qlo, int qm, int tl, int r32, int hi) {
    f32x16 p0, p1; bf16x8 pa0, pa1, pa2, pa3;
    if (MODE == 0) {
        const LAS float* tp = tab + (tl + kb);
#pragma unroll
        for (int r = 0; r < 16; ++r) { const int c = (r & 3) + 8 * (r >> 2); p0[r] = tp[c]; p1[r] = tp[c + 32]; }
    } else {
#pragma unroll
        for (int r = 0; r < 16; ++r) { p0[r] = 0.f; p1[r] = 0.f; }
    }
    qkt<KVB>(p0, p1, K_lds, r32, hi, qr);
    if (MODE == 0) {
        if (kb + KVBLK - 1 > qlo) mask_tile<false>(p0, p1, qm - kb);
        float mn, alpha;
        partialSM(p0, p1, m_reg, mn, alpha);
        if (__any(alpha < 1.f)) { if (hi == 0) al_l[r32] = alpha; LDS_WAIT();
#pragma unroll
            for (int d_ = 0; d_ < 4; ++d_)
#pragma unroll
                for (int r = 0; r < 16; ++r) o[d_][r] *= al_l[crow(r, hi)]; }
        finishSM(p0, p1, alpha, l_reg, pa0, pa1, pa2, pa3);
    } else {
        f32x16 x0, x1;
#pragma unroll
        for (int r = 0; r < 16; ++r) { const float y = p0[r] * C2; const float L = __builtin_amdgcn_logf(1.0f + __builtin_amdgcn_exp2f(-fabsf(y))); const float lb = fminf(y, 0.f) - L; p0[r] = lb; x0[r] = lb - y; }
#pragma unroll
        for (int r = 0; r < 16; ++r) { const float y = p1[r] * C2; const float L = __builtin_amdgcn_logf(1.0f + __builtin_amdgcn_exp2f(-fabsf(y))); const float lb = fminf(y, 0.f) - L; p1[r] = lb; x1[r] = lb - y; }
        if (kb + KVBLK - 1 >= qlo) {
            const int dq = qm - kb; const float NEG = -__builtin_inff();
#pragma unroll
            for (int r = 0; r < 16; ++r) { const int c = (r & 3) + 8 * (r >> 2);
                if (dq - c < 1) { p0[r] = NEG; x0[r] = 0.f; }
                if (dq - c - 32 < 1) { p1[r] = NEG; x1[r] = 0.f; } }
        }
        f32x16 a0, a1;
        const float s1 = suffix32(x1, a1, R, hi);
        const float s0 = suffix32(x0, a0, s1, hi);
        R = s0;
#pragma unroll
        for (int r = 0; r < 16; ++r) { p0[r] = __builtin_amdgcn_exp2f(p0[r] + a0[r]); p1[r] = __builtin_amdgcn_exp2f(p1[r] + a1[r]); }
        PK4(p0, 0, pa0); PK4(p0, 8, pa1); PK4(p1, 0, pa2); PK4(p1, 8, pa3);
    }
    SBAR();
    pv_tile<KVB>(o, vb0, pa0, pa1, pa2, pa3);
}
template <int MODE>
__device__ __forceinline__ void attn_block(const bf16* __restrict__ Qb, const bf16* __restrict__ Kh, const bf16* __restrict__ Vh, bf16* __restrict__ Ob, int P0, LAS char* lds, int toff_mul, int toff_add) {
    int tid = threadIdx.x; asm volatile("" : "+v"(tid));
    const int wid = __builtin_amdgcn_readfirstlane(tid >> 6), lane = tid & 63, r32 = lane & 31, hi = lane >> 5;
    LAS char* V_lds = lds + L_V; LAS char* K_lds = lds + L_K;
    LAS float* wsf = (LAS float*)(lds + L_WS) + wid * 64; LAS float* li_l = wsf; LAS float* al_l = wsf + 32;
    const LAS float* tab = (const LAS float*)(lds + L_TAB);
    volatile LAS unsigned* flags = (volatile LAS unsigned*)(lds + L_FLAG);
    bf16x8 qr[8];
    { const bf16* qrow = Qb + (size_t)(wid * QBLK + r32) * QPITCH + hi * 8;
#pragma unroll
      for (int d0 = 0; d0 < 8; ++d0) qr[d0] = *(const GAS bf16x8*)(qrow + d0 * 16); }
    const int qlo = P0 + wid * QBLK, qpos = qlo + r32, qm = qpos - 4 * hi;
    const int NT = P0 / KVBLK + 4;
    const int sr = tid >> 4, sc = (tid & 15) * 8;
    const int kws = KSWZ(sr, sc * 2), vst0 = v_st(sr, sc), vst1 = v_st(32 + sr, sc);
    const int vb0 = (int)(unsigned)(uintptr_t)V_lds + v_rd_base(lane);
    const int tl = toff_mul * qpos + toff_add + 4 * hi;
    float m_reg = -1e30f, l_reg = 0.f, R = 0.f;
    f32x16 o[4];
#pragma unroll
    for (int d = 0; d < 4; ++d)
#pragma unroll
        for (int r = 0; r < 16; ++r) o[d][r] = 0.f;
    bf16x8 sk0, sk1, sv0, sv1;
#define KB_OF(it_) (((MODE == 1) ? NT - 1 - (it_) : (it_)) * KVBLK)
#define ST_LOAD(kb_) do { const bf16* kp = Kh + (size_t)((kb_) + sr) * QPITCH + sc; const bf16* vp = Vh + (size_t)((kb_) + sr) * QPITCH + sc; \
        sk0 = *(const GAS bf16x8*)kp; sk1 = *(const GAS bf16x8*)(kp + (size_t)32 * QPITCH); sv0 = *(const GAS bf16x8*)vp; sv1 = *(const GAS bf16x8*)(vp + (size_t)32 * QPITCH); } while (0)
#define ST_WRITE(bf_) do { *(LAS bf16x8*)(K_lds + (bf_) * SHM_K + kws) = sk0; *(LAS bf16x8*)(K_lds + (bf_) * SHM_K + kws + 32 * 256) = sk1; \
        *(LAS bf16x8*)(V_lds + (bf_) * SHM_V + vst0) = sv0; *(LAS bf16x8*)(V_lds + (bf_) * SHM_V + vst1) = sv1; } while (0)
    __syncthreads();
    ST_LOAD(KB_OF(0)); ST_WRITE(0);
    if (MODE == 1 && tid < 16) flags[tid] = 0u;
    __syncthreads();
    bool stop = false, wdone = false;
#define STEP(it_, B_, NB_) { const int kb = KB_OF(it_); const bool more = (it_) + 1 < NT; \
        if (more) ST_LOAD(KB_OF((it_) + 1)); \
        if (kb <= qlo + QBLK - 1 && !wdone) attn_tile<MODE, B_>(o, m_reg, l_reg, R, qr, K_lds, vb0, tab, al_l, kb, qlo, qm, tl, r32, hi); \
        if (more) ST_WRITE(NB_); \
        if (MODE == 1) { wdone = (kb <= qlo + QBLK - 1) && __all(R <= -160.f); if (lane == 0) flags[((it_) & 1) * 8 + wid] = wdone ? 1u : 0u; } \
        __syncthreads(); \
        if (MODE == 1) { unsigned a_ = 1u; _Pragma("unroll") for (int w_ = 0; w_ < 8; ++w_) a_ &= flags[((it_) & 1) * 8 + w_]; stop = (a_ != 0u); } }
    for (int it = 0; it < NT; it += 2) {
        STEP(it, 0, 1)
        if (stop) break;
        STEP(it + 1, 1, 0)
        if (stop) break;
    }
#undef STEP
#undef ST_LOAD
#undef ST_WRITE
#undef KB_OF
    float rli[16];
    if (MODE == 0) {
        if (hi == 0) li_l[r32] = l_reg; LDS_WAIT();
#pragma unroll
        for (int r = 0; r < 16; ++r) rli[r] = __builtin_amdgcn_rcpf(li_l[crow(r, hi)]);
    } else {
#pragma unroll
        for (int r = 0; r < 16; ++r) rli[r] = 1.f;
    }
    bf16* Ow = Ob + (size_t)(wid * QBLK) * OPITCH;
#pragma unroll
    for (int r = 0; r < 16; ++r) { const int orow = crow(r, hi);
#pragma unroll
        for (int d0 = 0; d0 < 4; ++d0) { const float v = o[d0][r] * rli[r];
            const float vn = __shfl_xor(v, 1);
            if ((r32 & 1) == 0) *(GAS unsigned*)(Ow + (size_t)orow * OPITCH + d0 * 32 + r32) = cvtpk(v, vn); } }
}
#undef PK4
}

__device__ __forceinline__ int t5_bucket(int d) {
    if (d < 16) return d;
    int b = 16;
    b += (d >= 22); b += (d >= 30); b += (d >= 40); b += (d >= 54); b += (d >= 73); b += (d >= 99); b += (d >= 134); b += (d >= 182);
    b += (d >= 246); b += (d >= 332); b += (d >= 450); b += (d >= 609); b += (d >= 825); b += (d >= 1117); b += (d >= 1513);
    return b;
}

struct Args {
    const float* x; const float* norm_g; const float* w_gate; const float* w_up; const float* w_down;
    const float* w_in[4]; const float* b_f0; const float* b_f3; const float* w_out; const float* rel_bias; const float* final_g;
    float* out; unsigned char* ws; int ph_lo, ph_hi;
};
static_assert(sizeof(Args) == 16 * 8 + 8, "Args has no padding");

__global__ void __launch_bounds__(NWAVES * 64, 2) mk_fwd(Args a) {
    extern __shared__ __attribute__((aligned(16))) unsigned char lds_raw[];
    LAS unsigned char* lds = (LAS unsigned char*)lds_raw;
    volatile LAS unsigned* MISC = (volatile LAS unsigned*)(lds + MISC_OFF);
    const int G = gridDim.x; const int bx = blockIdx.x; const int vcu = (G % 8 == 0) ? (bx % 8) * (G / 8) + bx / 8 : bx;
    unsigned char* ws = a.ws;
    gu32* ctl = (gu32*)(ws + WS_CTL);
    if (threadIdx.x < 64) MISC[threadIdx.x] = 0u;
    __syncthreads();
    const int lo = a.ph_lo, hi = a.ph_hi;
    XcdBarrier bar; bar.bar = (unsigned*)(ctl + CW_BAR); bar.x = 0; bar.st = nullptr;
    if (hi - lo > 1) bar = xcd_barrier_post((unsigned*)(ctl + CW_BAR), MISC + 8);
#define RUN(k) (lo <= (k) && (k) < hi)
#define SEAM(k) do { if (RUN(k) && RUN((k) + 1)) { xcd_barrier(bar); if (PROBE_DUP == 9) xcd_barrier(bar); } } while (0)

    bf16* const Hb = (bf16*)(ws + WS_H); bf16* const AO = (bf16*)(ws + WS_AO); bf16* const ACT = (bf16*)(ws + WS_ACT); bf16* const QKV = (bf16*)(ws + WS_ACT);
    float* const LF = (float*)(ws + WS_LF);
    const int NGW = G * NWAVES;
    int ph = 0;
#define LANE_IDS() const int tid = opaque_tid(), lane = tid & 63, wave = __builtin_amdgcn_readfirstlane(tid >> 6), gw = vcu * NWAVES + wave; (void)lane; (void)gw

    if (RUN(ph)) REP(1) {
        LANE_IDS();
        LAS float* scr = (LAS float*)(lds + wave * 16640);
        constexpr int I_G = (DM / 64) * (FF / 64), I_D = (FF / 64) * (DM / 64), I_Q = (DM / 64) * (NQKV / 64), I_O = (DM / 64) * (DM / 64);
        constexpr int PER_LAYER = 6 * I_G + I_Q + I_O;
        static_assert(I_G == I_D, "items");
        for (int it = gw; it < DEPTH * PER_LAYER; it += NGW) {
            const int l = it / PER_LAYER; int r = it - l * PER_LAYER;
            if (r < 6 * I_G) {
                const int mm = r / I_G, idx = r - mm * I_G, kind = mm >> 1, f = mm & 1;
                if (kind < 2) {
                    const float* W = (kind == 0 ? a.w_gate : a.w_up) + (size_t)(l * 2 + f) * DM * FF;
                    const int nblk = FF / 64, kb = idx / nblk, nb = idx - kb * nblk, n0 = nb * 64;
                    transpose_item(W, FF, DM, (bf16*)(ws + WS_WGU + (size_t)(l * 2 + f) * SZ_WGU), kb * 64, n0, (n0 >> 7) * 256 + (n0 & 127) + kind * 128, a.norm_g + (size_t)(l * 3 + 2 * f) * DM, scr, lane);
                } else {
                    const float* W = a.w_down + (size_t)(l * 2 + f) * FF * DM;
                    const int nblk = DM / 64, kb = idx / nblk, nb = idx - kb * nblk;
                    transpose_item(W, DM, FF, (bf16*)(ws + WS_WD + (size_t)(l * 2 + f) * SZ_WD), kb * 64, nb * 64, nb * 64, nullptr, scr, lane);
                }
            } else { r -= 6 * I_G;
                if (r < I_Q) {
                    const float* W = a.w_in[l]; const int ldw = (l == 0 || l == 3) ? NQKV + NH : NQKV;
                    const int nblk = NQKV / 64, kb = r / nblk, nb = r - kb * nblk;
                    transpose_item(W, ldw, DM, (bf16*)(ws + WS_WQKV + (size_t)l * SZ_WQKV), kb * 64, nb * 64, nb * 64, a.norm_g + (size_t)(l * 3 + 1) * DM, scr, lane);
                } else { r -= I_Q;
                    const float* W = a.w_out + (size_t)l * DM * DM;
                    const int nblk = DM / 64, kb = r / nblk, nb = r - kb * nblk;
                    transpose_item(W, DM, DM, (bf16*)(ws + WS_WO + (size_t)l * SZ_WO), kb * 64, nb * 64, nb * 64, nullptr, scr, lane);
                }
            }
        }
    }
    if (RUN(ph)) REP(1) {
        LANE_IDS();
        for (int idx = bx * (NWAVES * 64) + tid; idx < 2 * 16 * DM; idx += G * NWAVES * 64) {
            const int sl = idx >> 15, n = (idx >> 11) & 15, k = idx & (DM - 1), l = sl ? 3 : 0;
            const float w = a.w_in[l][(size_t)k * (NQKV + NH) + NQKV + n] * a.norm_g[(size_t)(l * 3 + 1) * DM + k];
            ((bf16*)(ws + WS_WF))[idx] = (bf16)(cvtpk(w, 0.f) & 0xffffu);
        }
        float* const part = (float*)(ws + WS_PART);
        for (int m = gw; m < M; m += NGW) {
            const GAS f32x4* xr = (const GAS f32x4*)(a.x + (size_t)m * DM) + lane;
            f32x4 v[8]; float ss = 0.f;
#pragma unroll
            for (int j = 0; j < 8; ++j) { v[j] = xr[64 * j]; ss += (v[j].x * v[j].x + v[j].y * v[j].y) + (v[j].z * v[j].z + v[j].w * v[j].w); }
            ss = wave_sum(ss);
            GAS v2u* o8 = (GAS v2u*)(Hb + (size_t)m * DM) + lane;
#pragma unroll
            for (int j = 0; j < 8; ++j) { v2u w; w.x = cvtpk(v[j].x, v[j].y); w.y = cvtpk(v[j].z, v[j].w); o8[64 * j] = w; }
            if (lane < 32) part[(size_t)m * 32 + lane] = (lane == 0) ? ss : 0.f;
        }
    }
    SEAM(ph); ++ph;

    for (int sb = 0; sb < 3 * DEPTH; ++sb) {
        const int l = sb / 3, ty = sb - 3 * l;
        const float* xsrc = (sb == 0) ? a.x : (const float*)a.out;
        if (ty != 1) {
            const int f = ty >> 1;
            if (PROBE_DUP == 8 && RUN(ph)) {
                pg8::Gemm g{Hb, (const bf16*)(ws + WS_WGU + (size_t)(l * 2 + f) * SZ_WGU), M, NGU, DM}; pg8::StaticOrder S; S.init(M, NGU, G, bx);
                pg8::EpiNull E{(float*)(ws + WS_END)};
                pg8::gemm_phase<pg8::EpiNull, pg8::StaticOrder, true, true>(lds + RING_OFF, g, S, E);
            }
            if (RUN(ph)) REP(3) {
                pg8::Gemm g{Hb, (const bf16*)(ws + WS_WGU + (size_t)(l * 2 + f) * SZ_WGU), M, NGU, DM}; pg8::StaticOrder S; S.init(M, NGU, G, bx);
                pg8::Unit u0; S.next(0, u0); pg8::build_rstd_table((LAS float*)(lds + RST_OFF), (const float*)(ws + WS_PART), u0.pm, opaque_tid());
                pg8::EpiSwiGLU E{ACT, FF, (const float*)(ws + WS_PART), (const LAS float*)(lds + RST_OFF), u0.pm};
                pg8::gemm_phase<pg8::EpiSwiGLU, pg8::StaticOrder, true, true>(lds + RING_OFF, g, S, E);
            }
            SEAM(ph); ++ph;
            if (RUN(ph)) REP(6) {
                pg8::Gemm g{ACT, (const bf16*)(ws + WS_WD + (size_t)(l * 2 + f) * SZ_WD), M, DM, FF}; pg8::StaticOrder S; S.init(M, DM, G, bx);
#if RESID_BF16
                pg8::EpiResidB E{(PROBE_DUP == 6 && rep_ == 0) ? (bf16*)(ws + WS_END) : Hb, (float*)(ws + WS_PART), DM, 0.5f};
                pg8::gemm_phase<pg8::EpiResidB, pg8::StaticOrder, true, true>(lds + RING_OFF, g, S, E);
#else
                pg8::EpiResid E{xsrc, (PROBE_DUP == 6 && rep_ == 0) ? (float*)(ws + WS_END) : a.out, Hb, (float*)(ws + WS_PART), DM, 0.5f};
                pg8::gemm_phase<pg8::EpiResid, pg8::StaticOrder, true, true>(lds + RING_OFF, g, S, E);
#endif
            }
            SEAM(ph); ++ph;
        } else {
            if (RUN(ph) && (l == 0 || l == 3)) {
                LANE_IDS();
                const int fr = lane & 15, fq = lane >> 4;
                const bf16* wf = (const bf16*)(ws + WS_WF) + (size_t)(l ? 1 : 0) * 16 * DM + (size_t)fr * DM + 8 * fq;
                const float* bfp = (l == 0) ? a.b_f0 : a.b_f3;
                for (int rg = gw; rg < M / 16; rg += NGW) {
                    const bf16* ap = Hb + (size_t)(rg * 16 + fr) * DM + 8 * fq;
                    f32x4 acc = {0.f, 0.f, 0.f, 0.f};
#pragma unroll 8
                    for (int k0 = 0; k0 < DM; k0 += 32) { const bf16x8 av = *(const GAS bf16x8*)(ap + k0), bv = *(const GAS bf16x8*)(wf + k0);
                        acc = __builtin_amdgcn_mfma_f32_16x16x32_bf16(bv, av, acc, 0, 0, 0); }
                    const float r = pg8::row_rstd((const float*)(ws + WS_PART), rg * 16 + fr, fq);
                    const f32x4 bb = *(const GAS f32x4*)(bfp + 4 * fq);
                    f32x4 o;
#pragma unroll
                    for (int i = 0; i < 4; ++i) { const float z = acc[i] * r + bb[i]; o[i] = fminf(z, 0.f) - __logf(1.0f + __expf(-fabsf(z))); }
                    *(GAS f32x4*)(LF + (size_t)(rg * 16 + fr) * 16 + 4 * fq) = o;
                }
            }
            if (RUN(ph)) REP(4) {
                pg8::Gemm g{Hb, (const bf16*)(ws + WS_WQKV + (size_t)l * SZ_WQKV), M, NQKV, DM}; pg8::StaticOrder S; S.init(M, NQKV, G, bx);
                pg8::Unit u0; S.next(0, u0); pg8::build_rstd_table((LAS float*)(lds + RST_OFF), (const float*)(ws + WS_PART), u0.pm, opaque_tid());
                pg8::EpiBf16 E{QKV, NQKV, (const float*)(ws + WS_PART), (const LAS float*)(lds + RST_OFF), u0.pm};
                pg8::gemm_phase<pg8::EpiBf16, pg8::StaticOrder, true, true>(lds + RING_OFF, g, S, E);
            }
            SEAM(ph); ++ph;
            if (RUN(ph)) REP(5) {
                LANE_IDS();
                const int mixer = l % 3;
                LAS char* al = (LAS char*)(lds + RING_OFF);
                LAS float* tab = (LAS float*)(al + att::L_TAB);
                LAS float* scan = (LAS float*)(al + att::L_SCAN);
                for (int L = vcu; L < NBATCH * NH * 4; L += G) {
                    const int bh = L >> 2, xq = L & 3, b = bh >> 4, h = bh & 15;
                    const bf16* Qh = QKV + (size_t)b * SEQ * NQKV + h * HD; const bf16* Kh = Qh + DM; const bf16* Vh = Qh + 2 * DM;
                    bf16* Oh = AO + (size_t)b * SEQ * DM + h * HD;
                    __syncthreads();
                    int tmul = 0, tadd = 0;
                    if (mixer == 0) {
                        const float* lf = LF + (size_t)b * SEQ * 16 + h;
                        const float v0 = lf[(size_t)(4 * tid) * 16], v1 = lf[(size_t)(4 * tid + 1) * 16], v2 = lf[(size_t)(4 * tid + 2) * 16], v3 = lf[(size_t)(4 * tid + 3) * 16];
                        const float a0 = v0, a1 = a0 + v1, a2 = a1 + v2, a3 = a2 + v3;
                        float inc = a3;
#pragma unroll
                        for (int d = 1; d < 64; d <<= 1) { const float y = __shfl_up(inc, d); if (lane >= d) inc += y; }
                        if (lane == 63) scan[wave] = inc;
                        __syncthreads();
                        float pre = inc - a3;
                        for (int w = 0; w < wave; ++w) pre += scan[w];
                        const float ns = -11.313708498984761f;
                        tab[4 * tid] = (pre + a0) * ns; tab[4 * tid + 1] = (pre + a1) * ns; tab[4 * tid + 2] = (pre + a2) * ns; tab[4 * tid + 3] = (pre + a3) * ns;
                    } else if (mixer == 1) {
                        const float* rb = a.rel_bias + h * 32;
                        for (int j = tid; j < att::TAB_N; j += NWAVES * 64) {
                            const int d = 2047 - j; float v = 0.f;
                            if (d >= 0) { const int mult = (d <= 128 ? 1 : 0) + (((d & 3) == 0 && d <= 512) ? 1 : 0) + (((d & 15) == 0) ? 1 : 0);
                                v = (mult == 0) ? -__builtin_inff() : (rb[t5_bucket(d)] + (mult == 1 ? 0.f : (mult == 2 ? 0.6931471805599453f : 1.0986122886681098f))) * 11.313708498984761f; }
                            tab[j] = v; }
                        tmul = -1; tadd = 2047;
                    }
#pragma unroll 1
                    for (int pass = 0; pass < 2; ++pass) {
                        const int qb = pass ? 7 - xq : xq, P0 = qb * att::QB;
                        if (mixer == 2) att::attn_block<1>(Qh + (size_t)P0 * NQKV, Kh, Vh, Oh + (size_t)P0 * DM, P0, al, 0, 0);
                        else att::attn_block<0>(Qh + (size_t)P0 * NQKV, Kh, Vh, Oh + (size_t)P0 * DM, P0, al, tmul, tadd);
                    }
                }
            }
            SEAM(ph); ++ph;
            if (RUN(ph)) REP(7) {
                pg8::Gemm g{AO, (const bf16*)(ws + WS_WO + (size_t)l * SZ_WO), M, DM, DM}; pg8::StaticOrder S; S.init(M, DM, G, bx);
#if RESID_BF16
                pg8::EpiResidB E{(PROBE_DUP == 7 && rep_ == 0) ? (bf16*)(ws + WS_ACT) : Hb, (float*)(ws + WS_PART), DM, 1.0f};
                pg8::gemm_phase<pg8::EpiResidB, pg8::StaticOrder, true, true>(lds + RING_OFF, g, S, E);
#else
                pg8::EpiResid E{a.out, (PROBE_DUP == 7 && rep_ == 0) ? (float*)(ws + WS_ACT) : a.out, Hb, (float*)(ws + WS_PART), DM, 1.0f};
                pg8::gemm_phase<pg8::EpiResid, pg8::StaticOrder, true, true>(lds + RING_OFF, g, S, E);
#endif
            }
            SEAM(ph); ++ph;
        }
    }
    if (RUN(ph)) {
        LANE_IDS();
        f32x4 gv[8];
#pragma unroll
        for (int j = 0; j < 8; ++j) gv[j] = *((const GAS f32x4*)a.final_g + lane + 64 * j);
        for (int m = gw; m < M; m += NGW) {
            GAS f32x4* xr = (GAS f32x4*)(a.out + (size_t)m * DM) + lane;
            f32x4 v[8]; float ss = 0.f;
#pragma unroll
            for (int j = 0; j < 8; ++j) {
#if RESID_BF16
                const v2u w = *((const GAS v2u*)(Hb + (size_t)m * DM) + lane + 64 * j);
                v[j] = (f32x4){__uint_as_float(w.x << 16), __uint_as_float(w.x & 0xffff0000u), __uint_as_float(w.y << 16), __uint_as_float(w.y & 0xffff0000u)};
#else
                v[j] = xr[64 * j];
#endif
                ss += (v[j].x * v[j].x + v[j].y * v[j].y) + (v[j].z * v[j].z + v[j].w * v[j].w); }
            const float rstd = 1.0f / sqrtf(wave_sum(ss) * (1.0f / DM) + RMS_EPS);
#pragma unroll
            for (int j = 0; j < 8; ++j) xr[64 * j] = v[j] * rstd * gv[j];
        }
    }
#undef RUN
#undef SEAM
}
constexpr int N_PHASES = 1 + DEPTH * 7 + 1;

extern "C" void kernel_launch(void* const* d_in, const int* in_sizes, int n_in, void* d_out, int out_size, void* d_ws, size_t ws_size, hipStream_t stream) {
    static int grid = 0;
    if (grid == 0) {
        if (n_in != 14 || in_sizes[0] != M * DM || out_size != M * DM || ws_size < WS_END + (PROBE_DUP == 6 ? (size_t)M * DM * 4 : 0) + (PROBE_DUP == 8 ? 4096 : 0)) {
            fprintf(stderr, "kernel_launch: unexpected shapes (n_in %d, in0 %d, out %d, ws %zu < %zu?); nothing launched\n", n_in, n_in > 0 ? in_sizes[0] : -1, out_size, ws_size, (size_t)WS_END); grid = -1; return; }
        int dev = 0, cus = 0;
        if (hipGetDevice(&dev) != hipSuccess || hipDeviceGetAttribute(&cus, hipDeviceAttributeMultiprocessorCount, dev) != hipSuccess) { grid = -1; return; }
        if (hipFuncSetAttribute((const void*)mk_fwd, hipFuncAttributeMaxDynamicSharedMemorySize, LDS_BYTES) != hipSuccess) { fprintf(stderr, "kernel_launch: hipFuncSetAttribute failed\n"); grid = -1; return; }
        int per_cu = 0;
        if (hipOccupancyMaxActiveBlocksPerMultiprocessor(&per_cu, (const void*)mk_fwd, NWAVES * 64, LDS_BYTES) != hipSuccess || per_cu < 1)
            fprintf(stderr, "kernel_launch: note: occupancy query reports %d workgroups per CU\n", per_cu);
        (void)hipGetLastError();
        grid = cus;
    }
    if (grid < 0) return;
    if (hipMemsetAsync((char*)d_ws + WS_CTL, 0, CTL_ZERO_BYTES, stream) != hipSuccess) return;
    Args a{};
    a.x = (const float*)d_in[0]; a.norm_g = (const float*)d_in[1]; a.w_gate = (const float*)d_in[2]; a.w_up = (const float*)d_in[3]; a.w_down = (const float*)d_in[4];
    a.w_in[0] = (const float*)d_in[5]; a.b_f0 = (const float*)d_in[6]; a.w_in[1] = (const float*)d_in[7]; a.w_in[2] = (const float*)d_in[8]; a.w_in[3] = (const float*)d_in[9];
    a.b_f3 = (const float*)d_in[10]; a.w_out = (const float*)d_in[11]; a.rel_bias = (const float*)d_in[12]; a.final_g = (const float*)d_in[13];
    a.out = (float*)d_out; a.ws = (unsigned char*)d_ws;
#if MK_ONE_LAUNCH
    a.ph_lo = 0; a.ph_hi = N_PHASES;
    hipLaunchKernelGGL(mk_fwd, dim3(grid), dim3(NWAVES * 64), LDS_BYTES, stream, a);
#else
    for (int p = 0; p < N_PHASES; ++p) { a.ph_lo = p; a.ph_hi = p + 1; hipLaunchKernelGGL(mk_fwd, dim3(grid), dim3(NWAVES * 64), LDS_BYTES, stream, a); }
#endif
    const hipError_t le = hipPeekAtLastError();
    if (le != hipSuccess) fprintf(stderr, "kernel_launch: launch failed: %s\n", hipGetErrorName(le));
}
```

```cpp
#include <hip/hip_runtime.h>
#include <cstdio>
#include <cstdint>

#ifndef PROBE_DUP
#define PROBE_DUP 0
#endif
#define REP(k) _Pragma("unroll 1") for (int rep_ = 0; rep_ < ((PROBE_DUP == (k)) ? 2 : 1); ++rep_)
#ifndef PROBE_KL
#define PROBE_KL 0
#endif
#ifndef RESID_BF16
#define RESID_BF16 1
#endif
#ifndef MK_ONE_LAUNCH
#define MK_ONE_LAUNCH 1
#endif

namespace pg8 {
#define PG8_LAS __attribute__((address_space(3)))
typedef unsigned short bf16_t;
typedef short bf16x8 __attribute__((ext_vector_type(8)));
typedef float f32x4 __attribute__((ext_vector_type(4)));
typedef unsigned u32x4 __attribute__((ext_vector_type(4)));
constexpr int BM = 256, BK = 64, HALF = 128, HTB = HALF * BK * 2, STAGE_BYTES = 8 * HTB, NXCD = 8, WGM = 8;

__host__ __device__ __forceinline__ int lds_byte(int r, int c) { const int st = (r >> 4) * 2 + (c >> 5), rr = r & 15, cc = c & 31, ob = rr * 64 + cc * 2; return st * 1024 + (ob ^ (((ob >> 9) & 1) << 5)); }
__host__ __device__ __forceinline__ void stage_rc(int b, int& R, int& C) { const int st = b / 1024, sb = b % 1024, swz = sb ^ (((sb >> 9) & 1) << 5); R = (st >> 1) * 16 + swz / 64; C = (st & 1) * 32 + (swz % 64) / 2; }
__host__ __device__ __forceinline__ int perm32(int rho) { const int n = rho >> 4, i = rho & 15; return 8 * (i >> 2) + 4 * n + (i & 3); }

struct Unit { int pm, pn; };
struct Gemm { const bf16_t* A; const bf16_t* Bt; int M, N, K; };

struct StaticOrder {
    int nM, nN, nwg, G, c;
    __host__ __device__ void init(int M, int N, int G_, int c_) { nM = M / BM; nN = N / BM; nwg = nM * nN; G = G_; c = c_; }
    __host__ __device__ bool next(int i, Unit& u) const {
        const long L = (long)i * G + c; if (L >= nwg) return false;
        int wgid = (int)L; { const int q = nwg / NXCD, r = nwg % NXCD, xcd = wgid % NXCD, off = wgid / NXCD; wgid = (xcd < r ? xcd * (q + 1) : r * (q + 1) + (xcd - r) * q) + off; }
        const int nig = WGM * nN, gid = wgid / nig, fm = gid * WGM, gsz = (nM - fm) < WGM ? (nM - fm) : WGM;
        u.pm = fm + ((wgid % nig) % gsz); u.pn = (wgid % nig) / gsz; return true;
    }
    __device__ __forceinline__ void a_ready(const Unit&) const {}
    __device__ __forceinline__ void done(const Unit&) const {}
};

__device__ __forceinline__ unsigned cvt_pk_bf16(float lo, float hi) { unsigned r; asm volatile("v_cvt_pk_bf16_f32 %0, %1, %2" : "=v"(r) : "v"(lo), "v"(hi)); return r; }

__device__ __forceinline__ float fq_sum(float s) {
    { auto rr = __builtin_amdgcn_permlane16_swap(__float_as_uint(s), __float_as_uint(s), false, false); s = __uint_as_float(rr[0]) + __uint_as_float(rr[1]); }
    { auto rr = __builtin_amdgcn_permlane32_swap(__float_as_uint(s), __float_as_uint(s), false, false); s = __uint_as_float(rr[0]) + __uint_as_float(rr[1]); }
    return s;
}
__device__ __forceinline__ float row_rstd(const float* part, int row, int fq) {
    const f32x4 a = *(const f32x4*)(part + (size_t)row * 32 + fq * 8), b = *(const f32x4*)(part + (size_t)row * 32 + fq * 8 + 4);
    const float s = fq_sum(((a[0] + a[1]) + (a[2] + a[3])) + ((b[0] + b[1]) + (b[2] + b[3])));
    return __builtin_amdgcn_rsqf(s * (1.0f / 2048.0f) + 1e-6f);
}
__device__ __forceinline__ void build_rstd_table(PG8_LAS float* rst, const float* part, int pm0, int tid) {
    if (tid < 256) { const f32x4* p = (const f32x4*)(part + (size_t)(pm0 * BM + tid) * 32); float s = 0.f;
#pragma unroll
        for (int j = 0; j < 8; ++j) { const f32x4 v = p[j]; s += (v[0] + v[1]) + (v[2] + v[3]); }
        rst[tid] = __builtin_amdgcn_rsqf(s * (1.0f / 2048.0f) + 1e-6f); }
    __syncthreads();
}
struct EpiBf16 {
    static constexpr bool PERM = true, AFTER_DRAIN = false; static constexpr int KL = 0;
    bf16_t* O; int ldc; const float* part; const PG8_LAS float* rst; int pm0; int local;
    __device__ __forceinline__ void operator()(const f32x4 (&acc)[2][2][4][2], const Unit& u, int wr, int wc, int fr, int fq) const {
        const int row0 = (local ? 0 : u.pm * BM) + wr * 64 + fr, col0 = (local ? 0 : u.pn * BM) + wc * 32 + 8 * fq;
        float rs[2][4];
        if (u.pm == pm0) {
#pragma unroll
            for (int ai = 0; ai < 2; ++ai)
#pragma unroll
                for (int m = 0; m < 4; ++m) rs[ai][m] = rst[wr * 64 + fr + ai * HALF + m * 16];
        } else {
#pragma unroll
            for (int ai = 0; ai < 2; ++ai)
#pragma unroll
                for (int m = 0; m < 4; ++m) rs[ai][m] = row_rstd(part, row0 + ai * HALF + m * 16, fq);
        }
#pragma unroll
        for (int ai = 0; ai < 2; ++ai)
#pragma unroll
            for (int m = 0; m < 4; ++m) { bf16_t* rowp = O + (size_t)(row0 + ai * HALF + m * 16) * ldc + col0; const float r = rs[ai][m];
#pragma unroll
                for (int bj = 0; bj < 2; ++bj) { const f32x4 v0 = acc[ai][bj][m][0] * r, v1 = acc[ai][bj][m][1] * r;
                    u32x4 w; w.x = cvt_pk_bf16(v0[0], v0[1]); w.y = cvt_pk_bf16(v0[2], v0[3]); w.z = cvt_pk_bf16(v1[0], v1[1]); w.w = cvt_pk_bf16(v1[2], v1[3]);
                    *(u32x4*)(rowp + bj * HALF) = w; } }
    }
};
typedef float f32x2 __attribute__((ext_vector_type(2)));
__device__ __forceinline__ f32x2 silu_mul2(f32x2 g, f32x2 u, float nrl  , float r2  ) {
    const f32x2 a = g * nrl; f32x2 e; e.x = __builtin_amdgcn_exp2f(a.x); e.y = __builtin_amdgcn_exp2f(a.y);
    const f32x2 d = e + 1.0f; f32x2 s; s.x = __builtin_amdgcn_rcpf(d.x); s.y = __builtin_amdgcn_rcpf(d.y);
    return (g * u) * (s * r2);
}
struct EpiSwiGLU {
    static constexpr bool PERM = true, AFTER_DRAIN = false; static constexpr int KL = 0;
    bf16_t* O; int ldc; const float* part; const PG8_LAS float* rst; int pm0;
    __device__ __forceinline__ void operator()(const f32x4 (&acc)[2][2][4][2], const Unit& u, int wr, int wc, int fr, int fq) const {
        const int row0 = u.pm * BM + wr * 64 + fr, col0 = u.pn * HALF + wc * 32 + 8 * fq;
        float rs[2][4];
        if (u.pm == pm0) {
#pragma unroll
            for (int ai = 0; ai < 2; ++ai)
#pragma unroll
                for (int m = 0; m < 4; ++m) rs[ai][m] = rst[wr * 64 + fr + ai * HALF + m * 16];
        } else {
#pragma unroll
            for (int ai = 0; ai < 2; ++ai)
#pragma unroll
                for (int m = 0; m < 4; ++m) rs[ai][m] = row_rstd(part, row0 + ai * HALF + m * 16, fq);
        }
#pragma unroll
        for (int ai = 0; ai < 2; ++ai)
#pragma unroll
            for (int m = 0; m < 4; ++m) { bf16_t* rowp = O + (size_t)(row0 + ai * HALF + m * 16) * ldc + col0; const float r = rs[ai][m], nrl = r * -1.4426950408889634f, r2 = r * r;
                const f32x4 g0 = acc[ai][0][m][0], g1 = acc[ai][0][m][1], u0 = acc[ai][1][m][0], u1 = acc[ai][1][m][1];
                const f32x2 a = silu_mul2((f32x2){g0[0], g0[1]}, (f32x2){u0[0], u0[1]}, nrl, r2), b = silu_mul2((f32x2){g0[2], g0[3]}, (f32x2){u0[2], u0[3]}, nrl, r2);
                const f32x2 c = silu_mul2((f32x2){g1[0], g1[1]}, (f32x2){u1[0], u1[1]}, nrl, r2), d = silu_mul2((f32x2){g1[2], g1[3]}, (f32x2){u1[2], u1[3]}, nrl, r2);
                u32x4 w; w.x = cvt_pk_bf16(a.x, a.y); w.y = cvt_pk_bf16(b.x, b.y); w.z = cvt_pk_bf16(c.x, c.y); w.w = cvt_pk_bf16(d.x, d.y);
                *(u32x4*)rowp = w; }
    }
};
struct EpiResid {
    static constexpr bool PERM = true, AFTER_DRAIN = false; static constexpr int KL = 0;
    const float* base; float* out; bf16_t* xb; float* part; int ldc; float alpha;
    __device__ __forceinline__ void operator()(const f32x4 (&acc)[2][2][4][2], const Unit& u, int wr, int wc, int fr, int fq) const {
        const int row0 = u.pm * BM + wr * 64 + fr, col0 = u.pn * BM + wc * 32 + 8 * fq;
#pragma unroll
        for (int ai = 0; ai < 2; ++ai)
#pragma unroll
            for (int m = 0; m < 4; ++m) { const int row = row0 + ai * HALF + m * 16; const size_t off = (size_t)row * ldc + col0; float s = 0.f;
#pragma unroll
                for (int bj = 0; bj < 2; ++bj) { const f32x4 b0 = *(const f32x4*)(base + off + bj * HALF), b1 = *(const f32x4*)(base + off + bj * HALF + 4);
                    const f32x4 o0 = b0 + alpha * acc[ai][bj][m][0], o1 = b1 + alpha * acc[ai][bj][m][1];
                    *(f32x4*)(out + off + bj * HALF) = o0; *(f32x4*)(out + off + bj * HALF + 4) = o1;
                    u32x4 w; w.x = cvt_pk_bf16(o0[0], o0[1]); w.y = cvt_pk_bf16(o0[2], o0[3]); w.z = cvt_pk_bf16(o1[0], o1[1]); w.w = cvt_pk_bf16(o1[2], o1[3]);
                    *(u32x4*)(xb + off + bj * HALF) = w;
                    s += ((o0[0] * o0[0] + o0[1] * o0[1]) + (o0[2] * o0[2] + o0[3] * o0[3])) + ((o1[0] * o1[0] + o1[1] * o1[1]) + (o1[2] * o1[2] + o1[3] * o1[3])); }
                s = fq_sum(s);
                if (fq == 0) part[(size_t)row * 32 + u.pn * 4 + wc] = s;
                if (m & 1) asm volatile("" ::: "memory"); }
    }
};

struct EpiResidB {
    static constexpr bool PERM = true, AFTER_DRAIN = false; static constexpr int KL = 0;
    bf16_t* xb; float* part; int ldc; float alpha;
    __device__ __forceinline__ void operator()(const f32x4 (&acc)[2][2][4][2], const Unit& u, int wr, int wc, int fr, int fq) const {
        const int row0 = u.pm * BM + wr * 64 + fr, col0 = u.pn * BM + wc * 32 + 8 * fq;
#pragma unroll
        for (int ai = 0; ai < 2; ++ai)
#pragma unroll
            for (int m = 0; m < 4; ++m) { const int row = row0 + ai * HALF + m * 16; const size_t off = (size_t)row * ldc + col0; float s = 0.f;
#pragma unroll
                for (int bj = 0; bj < 2; ++bj) { const u32x4 b = *(const u32x4*)(xb + off + bj * HALF);
                    const f32x4 b0 = {__uint_as_float(b.x << 16), __uint_as_float(b.x & 0xffff0000u), __uint_as_float(b.y << 16), __uint_as_float(b.y & 0xffff0000u)};
                    const f32x4 b1 = {__uint_as_float(b.z << 16), __uint_as_float(b.z & 0xffff0000u), __uint_as_float(b.w << 16), __uint_as_float(b.w & 0xffff0000u)};
                    const f32x4 o0 = b0 + alpha * acc[ai][bj][m][0], o1 = b1 + alpha * acc[ai][bj][m][1];
                    u32x4 w; w.x = cvt_pk_bf16(o0[0], o0[1]); w.y = cvt_pk_bf16(o0[2], o0[3]); w.z = cvt_pk_bf16(o1[0], o1[1]); w.w = cvt_pk_bf16(o1[2], o1[3]);
                    *(u32x4*)(xb + off + bj * HALF) = w;
                    const f32x4 r0 = {__uint_as_float(w.x << 16), __uint_as_float(w.x & 0xffff0000u), __uint_as_float(w.y << 16), __uint_as_float(w.y & 0xffff0000u)};
                    const f32x4 r1 = {__uint_as_float(w.z << 16), __uint_as_float(w.z & 0xffff0000u), __uint_as_float(w.w << 16), __uint_as_float(w.w & 0xffff0000u)};
                    s += ((r0[0] * r0[0] + r0[1] * r0[1]) + (r0[2] * r0[2] + r0[3] * r0[3])) + ((r1[0] * r1[0] + r1[1] * r1[1]) + (r1[2] * r1[2] + r1[3] * r1[3])); }
                s = fq_sum(s);
                if (fq == 0) part[(size_t)row * 32 + u.pn * 4 + wc] = s; }
    }
};
struct ProbeOrder : StaticOrder {
    __host__ __device__ bool next(int i, Unit& u) const { const bool r = StaticOrder::next(i, u); u.pm = c & 7; u.pn = (c >> 3) & 3; return r; }
};
struct EpiSwiGLULocal {
    static constexpr bool PERM = true, AFTER_DRAIN = false; static constexpr int KL = 0;
    EpiSwiGLU inner;
    __device__ __forceinline__ void operator()(const f32x4 (&acc)[2][2][4][2], const Unit& u, int wr, int wc, int fr, int fq) const {
        Unit v; v.pm = 0; v.pn = 0; EpiSwiGLU e = inner; e.pm0 = 0; e(acc, v, wr, wc, fr, fq);
    }
};
struct EpiNull {
    static constexpr bool PERM = true, AFTER_DRAIN = false; static constexpr int KL = PROBE_KL;
    float* sink;
    __device__ __forceinline__ void operator()(const f32x4 (&acc)[2][2][4][2], const Unit& u, int wr, int wc, int fr, int fq) const {
        f32x4 t = {0.f, 0.f, 0.f, 0.f};
#pragma unroll
        for (int ai = 0; ai < 2; ++ai)
#pragma unroll
            for (int bj = 0; bj < 2; ++bj)
#pragma unroll
                for (int m = 0; m < 4; ++m)
#pragma unroll
                    for (int n = 0; n < 2; ++n) t += acc[ai][bj][m][n];
        if ((t[0] + t[1]) + (t[2] + t[3]) == 1.2345678e30f) sink[0] = 1.f;
    }
};
template <class Epi, class Sched, bool ALIGN_EPI = false, bool SP2 = false>
__device__ __forceinline__ void gemm_phase(PG8_LAS unsigned char* lds, const Gemm g, const Sched& S, const Epi& E) {
    int tid = threadIdx.x; asm volatile("" : "+v"(tid));
    const int wid = __builtin_amdgcn_readfirstlane(tid >> 6), lane = tid & 63, wr = wid >> 2, wc = wid & 3, fr = lane & 15, fq = lane >> 4;
    constexpr int KL_ = Epi::KL;
    const int K = g.K, nt = K / BK;
    unsigned voffA[2], voffB[2];
#pragma unroll
    for (int i = 0; i < 2; ++i) { int R, C; stage_rc(tid * 16 + i * 8192, R, C); const int Rb = Epi::PERM ? ((R & ~31) + perm32(R & 31)) : R;
        voffA[i] = (unsigned)(R * K + C) * 2u; voffB[i] = (unsigned)(Rb * K + C) * 2u; }
    const size_t kstep = (size_t)(BK * 2);
    const size_t hstep = (size_t)HALF * K * 2;
    const size_t tstep = 2 * hstep;
    const unsigned ldsw = (unsigned)wid * 1024u;
    const int aoff = lds_byte(wr * 64 + fr, fq * 8), boff = lds_byte(wc * 32 + fr, fq * 8);
#define PG8_SA(b, h) (((b) * 2 + (h)) * HTB)
#define PG8_SB(b, h) ((4 + (b) * 2 + (h)) * HTB)
#define PG8_STAGE(bufoff, gbase, voff) do { _Pragma("unroll") for (int _i = 0; _i < 2; ++_i) \
        __builtin_amdgcn_global_load_lds((const unsigned*)((const char*)(gbase) + (voff)[_i]), (PG8_LAS unsigned*)(lds + (bufoff) + ldsw + _i * 8192), 16, 0, 0); } while (0)
#define PG8_LDA(dst, b, h) do { _Pragma("unroll") for (int m = 0; m < 4; ++m) _Pragma("unroll") for (int k = 0; k < 2; ++k) dst[m][k] = *(const PG8_LAS bf16x8*)(lds + PG8_SA(b, h) + aoff + m * 2048 + k * 1024); } while (0)
#define PG8_LDB(dst, b, h) do { _Pragma("unroll") for (int n = 0; n < 2; ++n) _Pragma("unroll") for (int k = 0; k < 2; ++k) dst[n][k] = *(const PG8_LAS bf16x8*)(lds + PG8_SB(b, h) + boff + n * 2048 + k * 1024); } while (0)
#define PG8_MMA(ai, bj, At, Bt) do { __builtin_amdgcn_s_setprio(1); _Pragma("unroll") for (int m = 0; m < 4; ++m) _Pragma("unroll") for (int n = 0; n < 2; ++n) _Pragma("unroll") for (int k = 0; k < 2; ++k) \
        acc[ai][bj][m][n] = __builtin_amdgcn_mfma_f32_16x16x32_bf16(Bt[n][k], At[m][k], acc[ai][bj][m][n], 0, 0, 0); __builtin_amdgcn_s_setprio(0); } while (0)
#define PG8_WAIT_V(n) asm volatile("s_waitcnt vmcnt(" #n ")" ::: "memory")
#define PG8_WAIT_L(n) asm volatile("s_waitcnt lgkmcnt(" #n ")" ::: "memory")
#define PG8_BAR __builtin_amdgcn_s_barrier()
#define PG8_SCHED __builtin_amdgcn_sched_barrier(0)
    Unit cur, nxt; int ui = 0;
    if (!S.next(0, cur)) return;
    f32x4 acc[2][2][4][2];
#pragma unroll
    for (int a = 0; a < 2; ++a)
#pragma unroll
        for (int b = 0; b < 2; ++b)
#pragma unroll
            for (int m = 0; m < 4; ++m)
#pragma unroll
                for (int n = 0; n < 2; ++n) acc[a][b][m][n] = (f32x4){0.f, 0.f, 0.f, 0.f};
    bf16x8 At[4][2], B0[2][2], B1[2][2];
    const char* cA = (const char*)g.A + (size_t)cur.pm * tstep; const char* cB = (const char*)g.Bt + (size_t)cur.pn * tstep;
    S.a_ready(cur);
    if constexpr (SP2) {
        PG8_STAGE(PG8_SB(0, 0), cB, voffB); PG8_STAGE(PG8_SB(0, 1), cB + hstep, voffB); PG8_STAGE(PG8_SA(0, 0), cA, voffA); PG8_STAGE(PG8_SA(0, 1), cA + hstep, voffA);
        if (wr == 1) PG8_BAR;
        PG8_WAIT_V(2); PG8_BAR;
        PG8_STAGE(PG8_SB(1, 0), cB + kstep, voffB); PG8_STAGE(PG8_SA(1, 0), cA + kstep, voffA); PG8_STAGE(PG8_SB(1, 1), cB + hstep + kstep, voffB);
        PG8_WAIT_V(6); PG8_BAR;
    } else {
        PG8_STAGE(PG8_SB(0, 0), cB, voffB); PG8_STAGE(PG8_SA(0, 0), cA, voffA); PG8_STAGE(PG8_SB(0, 1), cB + hstep, voffB); PG8_STAGE(PG8_SA(0, 1), cA + hstep, voffA);
        if (wr == 1) PG8_BAR;
        PG8_WAIT_V(4); PG8_BAR;
        PG8_STAGE(PG8_SB(1, 0), cB + kstep, voffB); PG8_STAGE(PG8_SA(1, 0), cA + kstep, voffA); PG8_STAGE(PG8_SB(1, 1), cB + hstep + kstep, voffB);
        PG8_WAIT_V(6); PG8_BAR;
    }
    for (;;) {
        const bool has_next = S.next(ui + 1, nxt);
        const char* nA = has_next ? (const char*)g.A + (size_t)nxt.pm * tstep : cA; const char* nB = has_next ? (const char*)g.Bt + (size_t)nxt.pn * tstep : cB;
        for (int t = 0; t < nt; t += 2) {
            const bool last = (t == nt - 2);
            const char* a1 = cA + (size_t)(t + 1) * kstep;
            const char* a2 = last ? nA : cA + (size_t)(t + 2) * kstep; const char* b2 = last ? nB : cB + (size_t)(t + 2) * kstep;
            const char* a3 = a2 + kstep; const char* b3 = b2 + kstep;
            if (last && has_next) S.a_ready(nxt);
            if constexpr (SP2) {
            PG8_LDB(B0, 0, 0); PG8_LDB(B1, 0, 1); PG8_SCHED; PG8_LDA(At, 0, 0); if (KL_ != 2) PG8_STAGE(PG8_SA(1, 1), a1 + hstep, voffA);
            PG8_WAIT_V(8); PG8_WAIT_L(0); PG8_BAR; PG8_MMA(0, 0, At, B0); PG8_MMA(0, 1, At, B1); PG8_BAR; PG8_SCHED;
            if (KL_ != 1) PG8_LDA(At, 0, 1); if (KL_ != 2) { PG8_STAGE(PG8_SB(0, 0), b2, voffB); PG8_STAGE(PG8_SB(0, 1), b2 + hstep, voffB); PG8_STAGE(PG8_SA(0, 0), a2, voffA); }
            PG8_WAIT_V(8); PG8_WAIT_L(0); PG8_BAR; PG8_MMA(1, 0, At, B0); PG8_MMA(1, 1, At, B1); PG8_BAR; PG8_SCHED;
            PG8_LDB(B0, 1, 0); PG8_LDB(B1, 1, 1); PG8_SCHED; PG8_LDA(At, 1, 0); if (KL_ != 2) PG8_STAGE(PG8_SA(0, 1), a2 + hstep, voffA);
            PG8_WAIT_V(8); PG8_WAIT_L(0); PG8_BAR; PG8_MMA(0, 0, At, B0); PG8_MMA(0, 1, At, B1); PG8_BAR; PG8_SCHED;
            if (KL_ != 1) PG8_LDA(At, 1, 1); if (KL_ != 2) { PG8_STAGE(PG8_SB(1, 0), b3, voffB); PG8_STAGE(PG8_SB(1, 1), b3 + hstep, voffB); PG8_STAGE(PG8_SA(1, 0), a3, voffA); }
            PG8_WAIT_V(8); PG8_WAIT_L(0); PG8_BAR; PG8_MMA(1, 0, At, B0); PG8_MMA(1, 1, At, B1); PG8_BAR; PG8_SCHED;
            } else {
            PG8_LDB(B0, 0, 0); PG8_SCHED; PG8_LDA(At, 0, 0); PG8_STAGE(PG8_SA(1, 1), a1 + hstep, voffA);
            PG8_WAIT_L(8); PG8_BAR; PG8_WAIT_L(0); PG8_MMA(0, 0, At, B0); PG8_BAR; PG8_SCHED;
            PG8_LDB(B1, 0, 1); PG8_STAGE(PG8_SB(0, 0), b2, voffB);
            PG8_BAR; PG8_WAIT_L(0); PG8_MMA(0, 1, At, B1); PG8_BAR;
            PG8_LDA(At, 0, 1); PG8_STAGE(PG8_SA(0, 0), a2, voffA);
            PG8_BAR; PG8_WAIT_L(0); PG8_MMA(1, 0, At, B0); PG8_BAR; PG8_SCHED;
            PG8_STAGE(PG8_SB(0, 1), b2 + hstep, voffB);
            PG8_WAIT_V(6); PG8_BAR; PG8_MMA(1, 1, At, B1); PG8_BAR;
            PG8_LDB(B0, 1, 0); PG8_SCHED; PG8_LDA(At, 1, 0); PG8_STAGE(PG8_SA(0, 1), a2 + hstep, voffA);
            PG8_WAIT_L(8); PG8_BAR; PG8_WAIT_L(0); PG8_MMA(0, 0, At, B0); PG8_BAR; PG8_SCHED;
            PG8_LDB(B1, 1, 1); PG8_STAGE(PG8_SB(1, 0), b3, voffB);
            PG8_BAR; PG8_WAIT_L(0); PG8_MMA(0, 1, At, B1); PG8_BAR;
            PG8_LDA(At, 1, 1); PG8_STAGE(PG8_SA(1, 0), a3, voffA);
            PG8_BAR; PG8_WAIT_L(0); PG8_MMA(1, 0, At, B0); PG8_BAR; PG8_SCHED;
            PG8_STAGE(PG8_SB(1, 1), b3 + hstep, voffB);
            PG8_WAIT_V(6); PG8_BAR; PG8_MMA(1, 1, At, B1); PG8_BAR;
            }
        }
        if constexpr (ALIGN_EPI) { if (wr == 0) PG8_BAR; }
        if constexpr (!Epi::AFTER_DRAIN) { E(acc, cur, wr, wc, fr, fq); S.done(cur); }
        if (!has_next) break;
#pragma unroll
        for (int a = 0; a < 2; ++a)
#pragma unroll
            for (int b = 0; b < 2; ++b)
#pragma unroll
                for (int m = 0; m < 4; ++m)
#pragma unroll
                    for (int n = 0; n < 2; ++n) acc[a][b][m][n] = (f32x4){0.f, 0.f, 0.f, 0.f};
        cur = nxt; cA = nA; cB = nB; ++ui;
        if constexpr (ALIGN_EPI) { if (wr == 1) PG8_BAR; }
    }
    PG8_WAIT_V(0);
    if constexpr (!ALIGN_EPI) { if (wr == 0) PG8_BAR; }
    PG8_BAR;
#undef PG8_SA
#undef PG8_SB
#undef PG8_STAGE
#undef PG8_LDA
#undef PG8_LDB
#undef PG8_MMA
#undef PG8_WAIT_V
#undef PG8_WAIT_L
#undef PG8_BAR
#undef PG8_SCHED
}
}

constexpr int DM = 2048, NBATCH = 8, SEQ = 2048, DEPTH = 4, NH = 16, HD = 128, FF = 5632;
constexpr int M = NBATCH * SEQ;
constexpr int NGU = 2 * FF, NQKV = 3 * DM;
constexpr float RMS_EPS = 1e-6f;
constexpr int NWAVES = 8;

constexpr size_t MiB = 1u << 20;
constexpr size_t WS_CTL = 0, CTL_ZERO_BYTES = 1 * MiB;
constexpr size_t WS_LF = 1 * MiB;
constexpr size_t WS_PART = 2 * MiB;
constexpr size_t WS_WF = 4 * MiB;
constexpr size_t WS_WGU = 5 * MiB;
constexpr size_t SZ_WGU = (size_t)NGU * DM * 2;
constexpr size_t WS_WD = WS_WGU + 8 * SZ_WGU;
constexpr size_t SZ_WD = (size_t)DM * FF * 2;
constexpr size_t WS_WQKV = WS_WD + 8 * SZ_WD;
constexpr size_t SZ_WQKV = (size_t)NQKV * DM * 2;
constexpr size_t WS_WO = WS_WQKV + 4 * SZ_WQKV;
constexpr size_t SZ_WO = (size_t)DM * DM * 2;
constexpr size_t WS_H = WS_WO + 4 * SZ_WO;
constexpr size_t WS_AO = WS_H + (size_t)M * DM * 2;
constexpr size_t WS_ACT = WS_AO + (size_t)M * DM * 2;
constexpr size_t WS_END = WS_ACT + (size_t)M * NQKV * 2;
static_assert(WS_WGU % 256 == 0 && WS_WD % 256 == 0 && WS_WQKV % 256 == 0 && WS_WO % 256 == 0 && WS_H % 256 == 0 && WS_ACT % 256 == 0, "alignment");

constexpr int CW_TMO = 0;
constexpr int CW_BAR = 4096;

constexpr int RING_OFF = 0, RING_BYTES = 131072;
constexpr int LDS_BYTES = 147456;
constexpr int RST_OFF = RING_BYTES;
constexpr int MISC_OFF = LDS_BYTES - 256;

#define GAS __attribute__((address_space(1)))
#define LAS __attribute__((address_space(3)))
typedef unsigned short bf16;
typedef unsigned v4u __attribute__((ext_vector_type(4)));
typedef unsigned v2u __attribute__((ext_vector_type(2)));
typedef float f32x4 __attribute__((ext_vector_type(4)));
typedef float f32x16 __attribute__((ext_vector_type(16)));
typedef short bf16x8 __attribute__((ext_vector_type(8)));
typedef short s16x4 __attribute__((ext_vector_type(4)));
typedef GAS unsigned gu32;
#define RLX_AGENT __ATOMIC_RELAXED, __HIP_MEMORY_SCOPE_AGENT
#define LDS_WAIT() asm volatile("s_waitcnt lgkmcnt(0)" ::: "memory")
#define VM_WAIT() asm volatile("s_waitcnt vmcnt(0)" ::: "memory")
__device__ __forceinline__ unsigned cvtpk(float lo, float hi) { unsigned r; asm volatile("v_cvt_pk_bf16_f32 %0, %1, %2" : "=v"(r) : "v"(lo), "v"(hi)); return r; }

#define XB_TMO      128
#define XB_XCNT(j)  (256  + 64 * (j))
#define XB_XSUB(j)  (1280 + 64 * (j))
#define XB_XGEN(j)  (2304 + 64 * (j))
#define XB_TOP      3328
#define XB_TOPGEN   3392
#define XCD_BAR_WORDS 3456
#define XB_SPIN_CAP (1u << 18)
__device__ __forceinline__ unsigned xb_ld(unsigned* p)              { return __hip_atomic_load(p, __ATOMIC_RELAXED, __HIP_MEMORY_SCOPE_AGENT); }
__device__ __forceinline__ unsigned xb_add(unsigned* p, unsigned v) { return __hip_atomic_fetch_add(p, v, __ATOMIC_RELAXED, __HIP_MEMORY_SCOPE_AGENT); }
__device__ __forceinline__ unsigned xb_xcc_id() { return (unsigned)__builtin_amdgcn_s_getreg((3 << 11) | 20) & 0xFu; }
#define XB_SPIN(cond, bar) do { unsigned _sp = 0; while (cond) { __builtin_amdgcn_s_sleep(1); \
    if ((++_sp & 255u) == 0u) { if (xb_ld(&(bar)[XB_TMO])) break; if (_sp > XB_SPIN_CAP) { atomicAdd(&(bar)[XB_TMO], 1u); break; } } } } while (0)
struct XcdBarrier { unsigned* bar; unsigned x; volatile LAS unsigned* st; unsigned gsize; };
__device__ __forceinline__ XcdBarrier xcd_barrier_post(unsigned* bar, volatile LAS unsigned* st, unsigned gsize) {
    XcdBarrier b; b.bar = bar; b.x = xb_xcc_id(); b.st = st; b.gsize = gsize;
    if (threadIdx.x == 0) (void)xb_add(&bar[XB_XCNT(b.x)], 1u);
    return b;
}
__device__ __forceinline__ void xcd_barrier_complete(unsigned* bar, unsigned x, unsigned G, unsigned& nloc, unsigned& nx) {
    unsigned sum, cnt, mine, sp = 0u;
    for (;;) {
        sum = 0u; cnt = 0u; mine = 0u;
#pragma unroll
        for (unsigned j = 0; j < 16; ++j) { const unsigned c = xb_ld(&bar[XB_XCNT(j)]); sum += c; cnt += (c > 0u) ? 1u : 0u; mine = (j == x) ? c : mine; }
        if (sum == G) break;
        __builtin_amdgcn_s_sleep(1);
        if ((++sp & 255u) == 0u) { if (xb_ld(&bar[XB_TMO])) break; if (sp > XB_SPIN_CAP) { atomicAdd(&bar[XB_TMO], 1u); break; } }
    }
    nloc = mine > 0u ? mine : 1u; nx = cnt > 0u ? cnt : 1u;
}
__device__ __forceinline__ void xcd_barrier(const XcdBarrier& b) {
    asm volatile("s_waitcnt vmcnt(0)" ::: "memory");
    __syncthreads();
    if (threadIdx.x == 0) {
        unsigned* bar = b.bar;
        __builtin_amdgcn_s_waitcnt(0);
        unsigned nloc = b.st[0], nx = b.st[1];
        if (nloc == 0u) { xcd_barrier_complete(bar, b.x, b.gsize, nloc, nx); b.st[0] = nloc; b.st[1] = nx; }
        const unsigned old = xb_add(&bar[XB_XSUB(b.x)], 1u);
        const unsigned gen = old / nloc;
        if (old + 1u == (gen + 1u) * nloc) {
            __builtin_amdgcn_fence(__ATOMIC_RELEASE, "agent");
            asm volatile("s_waitcnt vmcnt(0)" ::: "memory");
            const unsigned og = xb_add(&bar[XB_TOP], 1u);
            const unsigned tg = og / nx;
            if (og + 1u == (tg + 1u) * nx) xb_add(&bar[XB_TOPGEN], 1u);
            else XB_SPIN(xb_ld(&bar[XB_TOPGEN]) == tg, bar);
            __builtin_amdgcn_fence(__ATOMIC_ACQUIRE, "agent");
            xb_add(&bar[XB_XGEN(b.x)], 1u);
            asm volatile("s_waitcnt vmcnt(0)" ::: "memory");
        } else {
            XB_SPIN(xb_ld(&bar[XB_XGEN(b.x)]) == gen, bar);
            __builtin_amdgcn_fence(__ATOMIC_ACQUIRE, "agent");
            asm volatile("s_waitcnt vmcnt(0)" ::: "memory");
        }
    }
    __syncthreads();
}

__device__ __forceinline__ int opaque_tid() { int t = threadIdx.x; asm volatile("" : "+v"(t)); return t; }
__device__ __forceinline__ float wave_sum(float v) {
#pragma unroll
    for (int o = 1; o < 64; o <<= 1) v += __shfl_xor(v, o);
    return v;
}

__device__ __forceinline__ void transpose_item(const float* __restrict__ W, int ldw, int Kdim, bf16* __restrict__ WT, int k0, int n0, int drow0, const float* __restrict__ gk, LAS float* scr, int lane) {
    const int nl = (lane & 15) * 4, kl = lane >> 4;
    f32x4 v[16];
#pragma unroll
    for (int i = 0; i < 16; ++i) v[i] = *(const GAS f32x4*)(W + (size_t)(k0 + 4 * i + kl) * ldw + n0 + nl);
#pragma unroll
    for (int i = 0; i < 16; ++i) { const float gg = gk ? gk[k0 + 4 * i + kl] : 1.0f; LAS float* s = scr + (4 * i + kl) * 65 + nl; s[0] = v[i].x * gg; s[1] = v[i].y * gg; s[2] = v[i].z * gg; s[3] = v[i].w * gg; }
    LDS_WAIT(); asm volatile("" ::: "memory");
    const int c = lane & 7;
#pragma unroll
    for (int j = 0; j < 8; ++j) { const int n = (lane >> 3) + 8 * j; const LAS float* s = scr + (8 * c) * 65 + n;
        v4u o; o.x = cvtpk(s[0 * 65], s[1 * 65]); o.y = cvtpk(s[2 * 65], s[3 * 65]); o.z = cvtpk(s[4 * 65], s[5 * 65]); o.w = cvtpk(s[6 * 65], s[7 * 65]);
        *(GAS v4u*)(WT + (size_t)(drow0 + n) * Kdim + k0 + 8 * c) = o; }
    LDS_WAIT(); asm volatile("" ::: "memory");
}

namespace att {
constexpr int D = 128, NW = 8, QBLK = 32, KVBLK = 64, QB = 256;
constexpr int SHM_K = KVBLK * D * 2, SHM_V = KVBLK * D * 2;
constexpr int L_V = 0, L_K = 2 * SHM_V, L_WS = L_K + 2 * SHM_K, L_TAB = L_WS + NW * 64 * 4, L_SCAN = L_TAB + 2304 * 4, L_FLAG = L_SCAN + 64, L_END = L_FLAG + 64;
constexpr int TAB_N = 2304;
constexpr int QPITCH = NQKV, OPITCH = DM;
constexpr float SCALE = 0.08838834764831845f;
constexpr float C2 = 1.4426950408889634f * SCALE;
constexpr float THR = 8.f;

#define KSWZ(row, colB) ((row) * 256 + ((colB) ^ (((row) & 7) << 4)))
#define SBAR() __builtin_amdgcn_sched_barrier(0)
__device__ __forceinline__ int v_st(int k, int c) { const int kk = (k & ~0xC) | ((k & 4) << 1) | ((k & 8) >> 1); return ((kk >> 3) * 4 + (c >> 5)) * 512 + ((kk & 7) * 32 + (c & 31)) * 2; }
__device__ __forceinline__ int v_rd_base(int lane) { return ((lane & 3) << 3) | (((lane >> 2) & 3) << 6) | (((lane >> 4) & 1) << 5) | (((lane >> 5) & 1) << 8); }
constexpr int v_rd_off(int d0, int ks, int half) { return d0 * 512 + ks * 4096 + half * 2048; }
__device__ __forceinline__ int crow(int r, int hi) { return (r & 3) + 8 * (r >> 2) + 4 * hi; }

template <bool STRICT>
__device__ __forceinline__ void mask_tile(f32x16& p0, f32x16& p1, int dq) {
    const float NEG = -__builtin_inff();
    const int lim = STRICT ? 1 : 0;
#pragma unroll
    for (int r = 0; r < 16; ++r) {
        const int c = (r & 3) + 8 * (r >> 2);
        if (dq - c < lim) p0[r] = NEG;
        if (dq - c - 32 < lim) p1[r] = NEG;
    }
}
__device__ __forceinline__ void partialSM(f32x16& p0, f32x16& p1, float& m_reg, float& mn, float& alpha) {
    float pmax = p0[0];
#pragma unroll
    for (int r = 1; r < 16; ++r) pmax = fmaxf(pmax, p0[r]);
#pragma unroll
    for (int r = 0; r < 16; ++r) pmax = fmaxf(pmax, p1[r]);
    { auto rr = __builtin_amdgcn_permlane32_swap(__float_as_uint(pmax), __float_as_uint(pmax), false, false);
      pmax = fmaxf(__uint_as_float(rr[0]), __uint_as_float(rr[1])); }
    if (__builtin_expect(__all((pmax - m_reg) * SCALE <= THR), 1)) { mn = m_reg; alpha = 1.f; }
    else { mn = fmaxf(m_reg, pmax); alpha = __builtin_amdgcn_exp2f((m_reg - mn) * C2); m_reg = mn; }
    const float mnL = -mn * C2;
#pragma unroll
    for (int r = 0; r < 16; ++r) p0[r] = fmaf(p0[r], C2, mnL);
#pragma unroll
    for (int r = 0; r < 16; ++r) p1[r] = fmaf(p1[r], C2, mnL);
#pragma unroll
    for (int r = 0; r < 16; ++r) p0[r] = __builtin_amdgcn_exp2f(p0[r]);
}
#define PK4(P, B_, OUT) do { unsigned a0 = cvtpk(P[B_+0], P[B_+1]), a1 = cvtpk(P[B_+2], P[B_+3]);                          \
        unsigned b0 = cvtpk(P[B_+4], P[B_+5]), b1 = cvtpk(P[B_+6], P[B_+7]);                                             \
        auto r0 = __builtin_amdgcn_permlane32_swap(a0, b0, false, false); auto r1 = __builtin_amdgcn_permlane32_swap(a1, b1, false, false); \
        v4u w = {r0[0], r1[0], r0[1], r1[1]}; OUT = __builtin_bit_cast(bf16x8, w); } while (0)
__device__ __forceinline__ void finishSM(f32x16& p0, f32x16& p1, float alpha, float& l_reg, bf16x8& pa0, bf16x8& pa1, bf16x8& pa2, bf16x8& pa3) {
#pragma unroll
    for (int r = 0; r < 16; ++r) p1[r] = __builtin_amdgcn_exp2f(p1[r]);
    float ps = 0;
#pragma unroll
    for (int r = 0; r < 16; ++r) ps += p0[r];
#pragma unroll
    for (int r = 0; r < 16; ++r) ps += p1[r];
    { auto rr = __builtin_amdgcn_permlane32_swap(__float_as_uint(ps), __float_as_uint(ps), false, false);
      ps = __uint_as_float(rr[0]) + __uint_as_float(rr[1]); }
    l_reg = l_reg * alpha + ps;
    PK4(p0, 0, pa0); PK4(p0, 8, pa1); PK4(p1, 0, pa2); PK4(p1, 8, pa3);
}
template <int KB>
__device__ __forceinline__ void qkt(f32x16& p0, f32x16& p1, const LAS char* K_lds, int r32, int hi, const bf16x8* qr) {
    const LAS char* kb[4];
#pragma unroll
    for (int dd = 0; dd < 4; ++dd) kb[dd] = K_lds + KB * SHM_K + KSWZ(r32, (dd * 16 + hi * 8) * 2);
#pragma unroll
    for (int d0 = 0; d0 < 8; ++d0) { const LAS char* a = kb[d0 & 3] + (d0 >> 2) * 128;
        bf16x8 b0 = *reinterpret_cast<const LAS bf16x8*>(a);
        bf16x8 b1 = *reinterpret_cast<const LAS bf16x8*>(a + 32 * 256);
        p0 = __builtin_amdgcn_mfma_f32_32x32x16_bf16(b0, qr[d0], p0, 0, 0, 0);
        p1 = __builtin_amdgcn_mfma_f32_32x32x16_bf16(b1, qr[d0], p1, 0, 0, 0); }
}
template <int VB>
__device__ __forceinline__ void pv_tile(f32x16* o, int vb0, bf16x8 pa0, bf16x8 pa1, bf16x8 pa2, bf16x8 pa3) {
#define TRRD(dst, off) asm volatile("ds_read_b64_tr_b16 %0, %1 offset:%2" : "=&v"(dst) : "v"(vb0), "i"(off) : "memory")
#define PV_D0(d0) do { s16x4 l0, l1, l2, l3, h0, h1, h2, h3; constexpr int b_ = VB * SHM_V + v_rd_off(d0, 0, 0); \
        TRRD(l0, b_); TRRD(h0, b_ + 2048); TRRD(l1, b_ + 4096); TRRD(h1, b_ + 6144); TRRD(l2, b_ + 8192); TRRD(h2, b_ + 10240); TRRD(l3, b_ + 12288); TRRD(h3, b_ + 14336); \
        asm volatile("s_waitcnt lgkmcnt(0)" ::: "memory"); SBAR();   \
        o[d0] = __builtin_amdgcn_mfma_f32_32x32x16_bf16(pa0, (bf16x8){l0[0], l0[1], l0[2], l0[3], h0[0], h0[1], h0[2], h0[3]}, o[d0], 0, 0, 0);   \
        o[d0] = __builtin_amdgcn_mfma_f32_32x32x16_bf16(pa1, (bf16x8){l1[0], l1[1], l1[2], l1[3], h1[0], h1[1], h1[2], h1[3]}, o[d0], 0, 0, 0);   \
        o[d0] = __builtin_amdgcn_mfma_f32_32x32x16_bf16(pa2, (bf16x8){l2[0], l2[1], l2[2], l2[3], h2[0], h2[1], h2[2], h2[3]}, o[d0], 0, 0, 0);   \
        o[d0] = __builtin_amdgcn_mfma_f32_32x32x16_bf16(pa3, (bf16x8){l3[0], l3[1], l3[2], l3[3], h3[0], h3[1], h3[2], h3[3]}, o[d0], 0, 0, 0); } while (0)
    PV_D0(0); PV_D0(1); PV_D0(2); PV_D0(3);
#undef PV_D0
#undef TRRD
}
__device__ __forceinline__ float suffix32(const f32x16& x, f32x16& aft, float base, int hi) {
    float c0[4], c1[4];
#pragma unroll
    for (int g = 0; g < 4; ++g) { const float c = (x[4 * g] + x[4 * g + 1]) + (x[4 * g + 2] + x[4 * g + 3]);
        auto rr = __builtin_amdgcn_permlane32_swap(__float_as_uint(c), __float_as_uint(c), false, false);
        c0[g] = __uint_as_float(rr[0]); c1[g] = __uint_as_float(rr[1]); }
    float s = base;
#pragma unroll
    for (int g = 3; g >= 0; --g) { const float sx1 = s; s += c1[g]; const float sx0 = s; s += c0[g];
        const float sx = hi ? sx1 : sx0;
        aft[4 * g + 3] = sx; aft[4 * g + 2] = aft[4 * g + 3] + x[4 * g + 3]; aft[4 * g + 1] = aft[4 * g + 2] + x[4 * g + 2]; aft[4 * g] = aft[4 * g + 1] + x[4 * g + 1]; }
    return s;
}

template <int MODE, int KVB>
__device__ __forceinline__ void attn_tile(f32x16* o, float& m_reg, float& l_reg, float& R, const bf16x8* qr, const LAS char* K_lds, int vb0, const LAS float* tab, LAS float* al_l,
                                          int kb, int qlo, int qm, int tl, int r32, int hi) {
    f32x16 p0, p1; bf16x8 pa0, pa1, pa2, pa3;
    if (MODE == 0) {
        const LAS float* tp = tab + (tl + kb);
#pragma unroll
        for (int r = 0; r < 16; ++r) { const int c = (r & 3) + 8 * (r >> 2); p0[r] = tp[c]; p1[r] = tp[c + 32]; }
    } else {
#pragma unroll
        for (int r = 0; r < 16; ++r) { p0[r] = 0.f; p1[r] = 0.f; }
    }
    qkt<KVB>(p0, p1, K_lds, r32, hi, qr);
    if (MODE == 0) {
        if (kb + KVBLK - 1 > qlo) mask_tile<false>(p0, p1, qm - kb);
        float mn, alpha;
        partialSM(p0, p1, m_reg, mn, alpha);
        if (__any(alpha < 1.f)) { if (hi == 0) al_l[r32] = alpha; LDS_WAIT();
#pragma unroll
            for (int d_ = 0; d_ < 4; ++d_)
#pragma unroll
                for (int r = 0; r < 16; ++r) o[d_][r] *= al_l[crow(r, hi)]; }
        finishSM(p0, p1, alpha, l_reg, pa0, pa1, pa2, pa3);
    } else {
        f32x16 x0, x1;
#pragma unroll
        for (int r = 0; r < 16; ++r) { const float y = p0[r] * C2; const float L = __builtin_amdgcn_logf(1.0f + __builtin_amdgcn_exp2f(-fabsf(y))); const float lb = fminf(y, 0.f) - L; p0[r] = lb; x0[r] = lb - y; }
#pragma unroll
        for (int r = 0; r < 16; ++r) { const float y = p1[r] * C2; const float L = __builtin_amdgcn_logf(1.0f + __builtin_amdgcn_exp2f(-fabsf(y))); const float lb = fminf(y, 0.f) - L; p1[r] = lb; x1[r] = lb - y; }
        if (kb + KVBLK - 1 >= qlo) {
            const int dq = qm - kb; const float NEG = -__builtin_inff();
#pragma unroll
            for (int r = 0; r < 16; ++r) { const int c = (r & 3) + 8 * (r >> 2);
                if (dq - c < 1) { p0[r] = NEG; x0[r] = 0.f; }
                if (dq - c - 32 < 1) { p1[r] = NEG; x1[r] = 0.f; } }
        }
        f32x16 a0, a1;
        const float s1 = suffix32(x1, a1, R, hi);
        const float s0 = suffix32(x0, a0, s1, hi);
        R = s0;
#pragma unroll
        for (int r = 0; r < 16; ++r) { p0[r] = __builtin_amdgcn_exp2f(p0[r] + a0[r]); p1[r] = __builtin_amdgcn_exp2f(p1[r] + a1[r]); }
        PK4(p0, 0, pa0); PK4(p0, 8, pa1); PK4(p1, 0, pa2); PK4(p1, 8, pa3);
    }
    SBAR();
    pv_tile<KVB>(o, vb0, pa0, pa1, pa2, pa3);
}
template <int MODE>
__device__ __forceinline__ void attn_block(const bf16* __restrict__ Qb, const bf16* __restrict__ Kh, const bf16* __restrict__ Vh, bf16* __restrict__ Ob, int P0, LAS char* lds, int toff_mul, int toff_add) {
    int tid = threadIdx.x; asm volatile("" : "+v"(tid));
    const int wid = __builtin_amdgcn_readfirstlane(tid >> 6), lane = tid & 63, r32 = lane & 31, hi = lane >> 5;
    LAS char* V_lds = lds + L_V; LAS char* K_lds = lds + L_K;
    LAS float* wsf = (LAS float*)(lds + L_WS) + wid * 64; LAS float* li_l = wsf; LAS float* al_l = wsf + 32;
    const LAS float* tab = (const LAS float*)(lds + L_TAB);
    volatile LAS unsigned* flags = (volatile LAS unsigned*)(lds + L_FLAG);
    bf16x8 qr[8];
    { const bf16* qrow = Qb + (size_t)(wid * QBLK + r32) * QPITCH + hi * 8;
#pragma unroll
      for (int d0 = 0; d0 < 8; ++d0) qr[d0] = *(const GAS bf16x8*)(qrow + d0 * 16); }
    const int qlo = P0 + wid * QBLK, qpos = qlo + r32, qm = qpos - 4 * hi;
    const int NT = P0 / KVBLK + 4;
    const int sr = tid >> 4, sc = (tid & 15) * 8;
    const int kws = KSWZ(sr, sc * 2), vst0 = v_st(sr, sc), vst1 = v_st(32 + sr, sc);
    const int vb0 = (int)(unsigned)(uintptr_t)V_lds + v_rd_base(lane);
    const int tl = toff_mul * qpos + toff_add + 4 * hi;
    float m_reg = -1e30f, l_reg = 0.f, R = 0.f;
    f32x16 o[4];
#pragma unroll
    for (int d = 0; d < 4; ++d)
#pragma unroll
        for (int r = 0; r < 16; ++r) o[d][r] = 0.f;
    bf16x8 sk0, sk1, sv0, sv1;
#define KB_OF(it_) (((MODE == 1) ? NT - 1 - (it_) : (it_)) * KVBLK)
#define ST_LOAD(kb_) do { const bf16* kp = Kh + (size_t)((kb_) + sr) * QPITCH + sc; const bf16* vp = Vh + (size_t)((kb_) + sr) * QPITCH + sc; \
        sk0 = *(const GAS bf16x8*)kp; sk1 = *(const GAS bf16x8*)(kp + (size_t)32 * QPITCH); sv0 = *(const GAS bf16x8*)vp; sv1 = *(const GAS bf16x8*)(vp + (size_t)32 * QPITCH); } while (0)
#define ST_WRITE(bf_) do { *(LAS bf16x8*)(K_lds + (bf_) * SHM_K + kws) = sk0; *(LAS bf16x8*)(K_lds + (bf_) * SHM_K + kws + 32 * 256) = sk1; \
        *(LAS bf16x8*)(V_lds + (bf_) * SHM_V + vst0) = sv0; *(LAS bf16x8*)(V_lds + (bf_) * SHM_V + vst1) = sv1; } while (0)
    __syncthreads();
    ST_LOAD(KB_OF(0)); ST_WRITE(0);
    if (MODE == 1 && tid < 16) flags[tid] = 0u;
    __syncthreads();
    bool stop = false, wdone = false;
#define STEP(it_, B_, NB_) { const int kb = KB_OF(it_); const bool more = (it_) + 1 < NT; \
        if (more) ST_LOAD(KB_OF((it_) + 1)); \
        if (kb <= qlo + QBLK - 1 && !wdone) attn_tile<MODE, B_>(o, m_reg, l_reg, R, qr, K_lds, vb0, tab, al_l, kb, qlo, qm, tl, r32, hi); \
        if (more) ST_WRITE(NB_); \
        if (MODE == 1) { wdone = (kb <= qlo + QBLK - 1) && __all(R <= -160.f); if (lane == 0) flags[((it_) & 1) * 8 + wid] = wdone ? 1u : 0u; } \
        __syncthreads(); \
        if (MODE == 1) { unsigned a_ = 1u; _Pragma("unroll") for (int w_ = 0; w_ < 8; ++w_) a_ &= flags[((it_) & 1) * 8 + w_]; stop = (a_ != 0u); } }
    for (int it = 0; it < NT; it += 2) {
        STEP(it, 0, 1)
        if (stop) break;
        STEP(it + 1, 1, 0)
        if (stop) break;
    }
#undef STEP
#undef ST_LOAD
#undef ST_WRITE
#undef KB_OF
    float rli[16];
    if (MODE == 0) {
        if (hi == 0) li_l[r32] = l_reg; LDS_WAIT();
#pragma unroll
        for (int r = 0; r < 16; ++r) rli[r] = __builtin_amdgcn_rcpf(li_l[crow(r, hi)]);
    } else {
#pragma unroll
        for (int r = 0; r < 16; ++r) rli[r] = 1.f;
    }
    bf16* Ow = Ob + (size_t)(wid * QBLK) * OPITCH;
#pragma unroll
    for (int r = 0; r < 16; ++r) { const int orow = crow(r, hi);
#pragma unroll
        for (int d0 = 0; d0 < 4; ++d0) { const float v = o[d0][r] * rli[r];
            const float vn = __shfl_xor(v, 1);
            if ((r32 & 1) == 0) *(GAS unsigned*)(Ow + (size_t)orow * OPITCH + d0 * 32 + r32) = cvtpk(v, vn); } }
}
#undef PK4
}

__device__ __forceinline__ int t5_bucket(int d) {
    if (d < 16) return d;
    int b = 16;
    b += (d >= 22); b += (d >= 30); b += (d >= 40); b += (d >= 54); b += (d >= 73); b += (d >= 99); b += (d >= 134); b += (d >= 182);
    b += (d >= 246); b += (d >= 332); b += (d >= 450); b += (d >= 609); b += (d >= 825); b += (d >= 1117); b += (d >= 1513);
    return b;
}

struct Args {
    const float* x; const float* norm_g; const float* w_gate; const float* w_up; const float* w_down;
    const float* w_in[4]; const float* b_f0; const float* b_f3; const float* w_out; const float* rel_bias; const float* final_g;
    float* out; unsigned char* ws; int ph_lo, ph_hi;
};
static_assert(sizeof(Args) == 16 * 8 + 8, "Args has no padding");

__global__ void __launch_bounds__(NWAVES * 64, 2) mk_fwd(Args a) {
    extern __shared__ __attribute__((aligned(16))) unsigned char lds_raw[];
    LAS unsigned char* lds = (LAS unsigned char*)lds_raw;
    volatile LAS unsigned* MISC = (volatile LAS unsigned*)(lds + MISC_OFF);
    const int G = gridDim.x; const int bx = blockIdx.x; const int vcu = (G % 8 == 0) ? (bx % 8) * (G / 8) + bx / 8 : bx;
    unsigned char* ws = a.ws;
    gu32* ctl = (gu32*)(ws + WS_CTL);
    if (threadIdx.x < 64) MISC[threadIdx.x] = 0u;
    __syncthreads();
    const int lo = a.ph_lo, hi = a.ph_hi;
    const int grp = bx & 7, gidx = bx >> 3;
    XcdBarrier bar, barL; bar.bar = (unsigned*)(ctl + CW_BAR); bar.x = 0; bar.st = nullptr; bar.gsize = 0; barL = bar;
    if (hi - lo > 1) { bar = xcd_barrier_post((unsigned*)(ctl + CW_BAR), MISC + 8, (unsigned)G); barL = xcd_barrier_post((unsigned*)(ctl + CW_BAR) + (1 + grp) * XCD_BAR_WORDS, MISC + 10, (unsigned)(G / 8)); }
#define RUN(k) (lo <= (k) && (k) < hi)
#define SEAM(k) do { if (RUN(k) && RUN((k) + 1)) { if ((k) == 0) xcd_barrier(bar); else xcd_barrier(barL); if (PROBE_DUP == 9) xcd_barrier(barL); } } while (0)

    bf16* const Hb = (bf16*)(ws + WS_H); bf16* const AO = (bf16*)(ws + WS_AO);
    bf16* const ACT = (bf16*)(ws + WS_ACT + (size_t)(bx & 7) * ((size_t)SEQ * (NQKV - FF) * 2)); bf16* const QKV = (bf16*)(ws + WS_ACT);
    float* const LF = (float*)(ws + WS_LF);
    const int NGW = G * NWAVES;
    int ph = 0;
#define LANE_IDS() const int tid = opaque_tid(), lane = tid & 63, wave = __builtin_amdgcn_readfirstlane(tid >> 6), gw = vcu * NWAVES + wave; (void)lane; (void)gw

    if (RUN(ph)) REP(1) {
        LANE_IDS();
        LAS float* scr = (LAS float*)(lds + wave * 16640);
        constexpr int I_G = (DM / 64) * (FF / 64), I_D = (FF / 64) * (DM / 64), I_Q = (DM / 64) * (NQKV / 64), I_O = (DM / 64) * (DM / 64);
        constexpr int PER_LAYER = 6 * I_G + I_Q + I_O;
        static_assert(I_G == I_D, "items");
        for (int it = gw; it < DEPTH * PER_LAYER; it += NGW) {
            const int l = it / PER_LAYER; int r = it - l * PER_LAYER;
            if (r < 6 * I_G) {
                const int mm = r / I_G, idx = r - mm * I_G, kind = mm >> 1, f = mm & 1;
                if (kind < 2) {
                    const float* W = (kind == 0 ? a.w_gate : a.w_up) + (size_t)(l * 2 + f) * DM * FF;
                    const int nblk = FF / 64, kb = idx / nblk, nb = idx - kb * nblk, n0 = nb * 64;
                    transpose_item(W, FF, DM, (bf16*)(ws + WS_WGU + (size_t)(l * 2 + f) * SZ_WGU), kb * 64, n0, (n0 >> 7) * 256 + (n0 & 127) + kind * 128, a.norm_g + (size_t)(l * 3 + 2 * f) * DM, scr, lane);
                } else {
                    const float* W = a.w_down + (size_t)(l * 2 + f) * FF * DM;
                    const int nblk = DM / 64, kb = idx / nblk, nb = idx - kb * nblk;
                    transpose_item(W, DM, FF, (bf16*)(ws + WS_WD + (size_t)(l * 2 + f) * SZ_WD), kb * 64, nb * 64, nb * 64, nullptr, scr, lane);
                }
            } else { r -= 6 * I_G;
                if (r < I_Q) {
                    const float* W = a.w_in[l]; const int ldw = (l == 0 || l == 3) ? NQKV + NH : NQKV;
                    const int nblk = NQKV / 64, kb = r / nblk, nb = r - kb * nblk;
                    transpose_item(W, ldw, DM, (bf16*)(ws + WS_WQKV + (size_t)l * SZ_WQKV), kb * 64, nb * 64, nb * 64, a.norm_g + (size_t)(l * 3 + 1) * DM, scr, lane);
                } else { r -= I_Q;
                    const float* W = a.w_out + (size_t)l * DM * DM;
                    const int nblk = DM / 64, kb = r / nblk, nb = r - kb * nblk;
                    transpose_item(W, DM, DM, (bf16*)(ws + WS_WO + (size_t)l * SZ_WO), kb * 64, nb * 64, nb * 64, nullptr, scr, lane);
                }
            }
        }
    }
    if (RUN(ph)) REP(1) {
        LANE_IDS();
        for (int idx = bx * (NWAVES * 64) + tid; idx < 2 * 16 * DM; idx += G * NWAVES * 64) {
            const int sl = idx >> 15, n = (idx >> 11) & 15, k = idx & (DM - 1), l = sl ? 3 : 0;
            const float w = a.w_in[l][(size_t)k * (NQKV + NH) + NQKV + n] * a.norm_g[(size_t)(l * 3 + 1) * DM + k];
            ((bf16*)(ws + WS_WF))[idx] = (bf16)(cvtpk(w, 0.f) & 0xffffu);
        }
        float* const part = (float*)(ws + WS_PART);
        for (int m = gw; m < M; m += NGW) {
            const GAS f32x4* xr = (const GAS f32x4*)(a.x + (size_t)m * DM) + lane;
            f32x4 v[8]; float ss = 0.f;
#pragma unroll
            for (int j = 0; j < 8; ++j) { v[j] = xr[64 * j]; ss += (v[j].x * v[j].x + v[j].y * v[j].y) + (v[j].z * v[j].z + v[j].w * v[j].w); }
            ss = wave_sum(ss);
            GAS v2u* o8 = (GAS v2u*)(Hb + (size_t)m * DM) + lane;
#pragma unroll
            for (int j = 0; j < 8; ++j) { v2u w; w.x = cvtpk(v[j].x, v[j].y); w.y = cvtpk(v[j].z, v[j].w); o8[64 * j] = w; }
            if (lane < 32) part[(size_t)m * 32 + lane] = (lane == 0) ? ss : 0.f;
        }
    }
    SEAM(ph); ++ph;

    for (int sb = 0; sb < 3 * DEPTH; ++sb) {
        const int l = sb / 3, ty = sb - 3 * l;
        const float* xsrc = (sb == 0) ? a.x : (const float*)a.out;
        if (ty != 1) {
            const int f = ty >> 1;
            if (PROBE_DUP == 10 && RUN(ph)) {
                pg8::Gemm g{Hb, (const bf16*)(ws + WS_WGU + (size_t)(l * 2 + f) * SZ_WGU), M, NGU, DM}; pg8::StaticOrder S; S.init(M, NGU, G, bx);
                pg8::Unit u0; S.next(0, u0); pg8::build_rstd_table((LAS float*)(lds + RST_OFF), (const float*)(ws + WS_PART), u0.pm, opaque_tid());
                pg8::EpiSwiGLULocal E{pg8::EpiSwiGLU{(bf16*)(ws + WS_END) + (size_t)bx * 256 * 128, 128, (const float*)(ws + WS_PART), (const LAS float*)(lds + RST_OFF), 0}};
                pg8::gemm_phase<pg8::EpiSwiGLULocal, pg8::StaticOrder, true, true>(lds + RING_OFF, g, S, E);
            }
            if (PROBE_DUP == 8 && RUN(ph)) {
                pg8::Gemm g{Hb, (const bf16*)(ws + WS_WGU + (size_t)(l * 2 + f) * SZ_WGU), M, NGU, DM};
#if PROBE_KL == 3
                pg8::ProbeOrder S; S.init(M, NGU, G, bx);
                pg8::EpiNull E{(float*)(ws + WS_END)};
                pg8::gemm_phase<pg8::EpiNull, pg8::ProbeOrder, true, true>(lds + RING_OFF, g, S, E);
#else
                pg8::StaticOrder S; S.init(M, NGU, G, bx);
                pg8::EpiNull E{(float*)(ws + WS_END)};
                pg8::gemm_phase<pg8::EpiNull, pg8::StaticOrder, true, true>(lds + RING_OFF, g, S, E);
#endif
            }
            if (RUN(ph)) REP(3) {
                pg8::Gemm g{Hb, (const bf16*)(ws + WS_WGU + (size_t)(l * 2 + f) * SZ_WGU), M, NGU, DM}; pg8::StaticOrder S; S.init(M, NGU, G, bx);
                pg8::Unit u0; S.next(0, u0); pg8::build_rstd_table((LAS float*)(lds + RST_OFF), (const float*)(ws + WS_PART), u0.pm, opaque_tid());
                pg8::EpiSwiGLU E{ACT, FF, (const float*)(ws + WS_PART), (const LAS float*)(lds + RST_OFF), u0.pm};
                pg8::gemm_phase<pg8::EpiSwiGLU, pg8::StaticOrder, true, true>(lds + RING_OFF, g, S, E);
            }
            SEAM(ph); ++ph;
            if (RUN(ph)) REP(6) {
                pg8::Gemm g{ACT, (const bf16*)(ws + WS_WD + (size_t)(l * 2 + f) * SZ_WD), M, DM, FF}; pg8::StaticOrder S; S.init(M, DM, G, bx);
#if RESID_BF16
                pg8::EpiResidB E{(PROBE_DUP == 6 && rep_ == 0) ? (bf16*)(ws + WS_END) : Hb, (float*)(ws + WS_PART), DM, 0.5f};
                pg8::gemm_phase<pg8::EpiResidB, pg8::StaticOrder, true, true>(lds + RING_OFF, g, S, E);
#else
                pg8::EpiResid E{xsrc, (PROBE_DUP == 6 && rep_ == 0) ? (float*)(ws + WS_END) : a.out, Hb, (float*)(ws + WS_PART), DM, 0.5f};
                pg8::gemm_phase<pg8::EpiResid, pg8::StaticOrder, true, true>(lds + RING_OFF, g, S, E);
#endif
            }
            SEAM(ph); ++ph;
        } else {
            if (RUN(ph) && (l == 0 || l == 3)) {
                LANE_IDS();
                const int fr = lane & 15, fq = lane >> 4;
                const bf16* wf = (const bf16*)(ws + WS_WF) + (size_t)(l ? 1 : 0) * 16 * DM + (size_t)fr * DM + 8 * fq;
                const float* bfp = (l == 0) ? a.b_f0 : a.b_f3;
                for (int rgl = gidx * NWAVES + wave; rgl < SEQ / 16; rgl += (G / 8) * NWAVES) { const int rg = grp * (SEQ / 16) + rgl;
                    const bf16* ap = Hb + (size_t)(rg * 16 + fr) * DM + 8 * fq;
                    f32x4 acc = {0.f, 0.f, 0.f, 0.f};
#pragma unroll 8
                    for (int k0 = 0; k0 < DM; k0 += 32) { const bf16x8 av = *(const GAS bf16x8*)(ap + k0), bv = *(const GAS bf16x8*)(wf + k0);
                        acc = __builtin_amdgcn_mfma_f32_16x16x32_bf16(bv, av, acc, 0, 0, 0); }
                    const float r = pg8::row_rstd((const float*)(ws + WS_PART), rg * 16 + fr, fq);
                    const f32x4 bb = *(const GAS f32x4*)(bfp + 4 * fq);
                    f32x4 o;
#pragma unroll
                    for (int i = 0; i < 4; ++i) { const float z = acc[i] * r + bb[i]; o[i] = fminf(z, 0.f) - __logf(1.0f + __expf(-fabsf(z))); }
                    *(GAS f32x4*)(LF + (size_t)(rg * 16 + fr) * 16 + 4 * fq) = o;
                }
            }
            if ((PROBE_DUP == 11 || PROBE_DUP == 12) && RUN(ph)) {
                pg8::Gemm g{Hb, (const bf16*)(ws + WS_WQKV + (size_t)l * SZ_WQKV), M, NQKV, DM}; pg8::StaticOrder S; S.init(M, NQKV, G, bx);
                pg8::Unit u0; S.next(0, u0); pg8::build_rstd_table((LAS float*)(lds + RST_OFF), (const float*)(ws + WS_PART), u0.pm, opaque_tid());
#if PROBE_DUP == 11
                pg8::EpiBf16 E{(bf16*)(ws + WS_END) + (size_t)bx * 256 * 256, 256, (const float*)(ws + WS_PART), (const LAS float*)(lds + RST_OFF), u0.pm, 1};
                pg8::gemm_phase<pg8::EpiBf16, pg8::StaticOrder, true, true>(lds + RING_OFF, g, S, E);
#else
                pg8::EpiNull E{(float*)(ws + WS_END)};
                pg8::gemm_phase<pg8::EpiNull, pg8::StaticOrder, true, true>(lds + RING_OFF, g, S, E);
#endif
            }
            if (RUN(ph)) REP(4) {
                pg8::Gemm g{Hb, (const bf16*)(ws + WS_WQKV + (size_t)l * SZ_WQKV), M, NQKV, DM}; pg8::StaticOrder S; S.init(M, NQKV, G, bx);
                pg8::Unit u0; S.next(0, u0); pg8::build_rstd_table((LAS float*)(lds + RST_OFF), (const float*)(ws + WS_PART), u0.pm, opaque_tid());
                pg8::EpiBf16 E{QKV, NQKV, (const float*)(ws + WS_PART), (const LAS float*)(lds + RST_OFF), u0.pm, 0};
                pg8::gemm_phase<pg8::EpiBf16, pg8::StaticOrder, true, true>(lds + RING_OFF, g, S, E);
            }
            SEAM(ph); ++ph;
            if (RUN(ph)) REP(5) {
                LANE_IDS();
                const int mixer = l % 3;
                LAS char* al = (LAS char*)(lds + RING_OFF);
                LAS float* tab = (LAS float*)(al + att::L_TAB);
                LAS float* scan = (LAS float*)(al + att::L_SCAN);
                for (int j = gidx; j < NH * 4; j += G / 8) {
                    const int b = grp, h = j >> 2, xq = j & 3;
                    const bf16* Qh = QKV + (size_t)b * SEQ * NQKV + h * HD; const bf16* Kh = Qh + DM; const bf16* Vh = Qh + 2 * DM;
                    bf16* Oh = AO + (size_t)b * SEQ * DM + h * HD;
                    __syncthreads();
                    int tmul = 0, tadd = 0;
                    if (mixer == 0) {
                        const float* lf = LF + (size_t)b * SEQ * 16 + h;
                        const float v0 = lf[(size_t)(4 * tid) * 16], v1 = lf[(size_t)(4 * tid + 1) * 16], v2 = lf[(size_t)(4 * tid + 2) * 16], v3 = lf[(size_t)(4 * tid + 3) * 16];
                        const float a0 = v0, a1 = a0 + v1, a2 = a1 + v2, a3 = a2 + v3;
                        float inc = a3;
#pragma unroll
                        for (int d = 1; d < 64; d <<= 1) { const float y = __shfl_up(inc, d); if (lane >= d) inc += y; }
                        if (lane == 63) scan[wave] = inc;
                        __syncthreads();
                        float pre = inc - a3;
                        for (int w = 0; w < wave; ++w) pre += scan[w];
                        const float ns = -11.313708498984761f;
                        tab[4 * tid] = (pre + a0) * ns; tab[4 * tid + 1] = (pre + a1) * ns; tab[4 * tid + 2] = (pre + a2) * ns; tab[4 * tid + 3] = (pre + a3) * ns;
                    } else if (mixer == 1) {
                        const float* rb = a.rel_bias + h * 32;
                        for (int j = tid; j < att::TAB_N; j += NWAVES * 64) {
                            const int d = 2047 - j; float v = 0.f;
                            if (d >= 0) { const int mult = (d <= 128 ? 1 : 0) + (((d & 3) == 0 && d <= 512) ? 1 : 0) + (((d & 15) == 0) ? 1 : 0);
                                v = (mult == 0) ? -__builtin_inff() : (rb[t5_bucket(d)] + (mult == 1 ? 0.f : (mult == 2 ? 0.6931471805599453f : 1.0986122886681098f))) * 11.313708498984761f; }
                            tab[j] = v; }
                        tmul = -1; tadd = 2047;
                    }
#pragma unroll 1
                    for (int pass = 0; pass < 2; ++pass) {
                        const int qb = pass ? 7 - xq : xq, P0 = qb * att::QB;
                        if (mixer == 2) att::attn_block<1>(Qh + (size_t)P0 * NQKV, Kh, Vh, Oh + (size_t)P0 * DM, P0, al, 0, 0);
                        else att::attn_block<0>(Qh + (size_t)P0 * NQKV, Kh, Vh, Oh + (size_t)P0 * DM, P0, al, tmul, tadd);
                    }
                }
            }
            SEAM(ph); ++ph;
            if (RUN(ph)) REP(7) {
                pg8::Gemm g{AO, (const bf16*)(ws + WS_WO + (size_t)l * SZ_WO), M, DM, DM}; pg8::StaticOrder S; S.init(M, DM, G, bx);
#if RESID_BF16
                pg8::EpiResidB E{(PROBE_DUP == 7 && rep_ == 0) ? (bf16*)(ws + WS_ACT) : Hb, (float*)(ws + WS_PART), DM, 1.0f};
                pg8::gemm_phase<pg8::EpiResidB, pg8::StaticOrder, true, true>(lds + RING_OFF, g, S, E);
#else
                pg8::EpiResid E{a.out, (PROBE_DUP == 7 && rep_ == 0) ? (float*)(ws + WS_ACT) : a.out, Hb, (float*)(ws + WS_PART), DM, 1.0f};
                pg8::gemm_phase<pg8::EpiResid, pg8::StaticOrder, true, true>(lds + RING_OFF, g, S, E);
#endif
            }
            SEAM(ph); ++ph;
        }
    }
    if (RUN(ph)) {
        LANE_IDS();
        f32x4 gv[8];
#pragma unroll
        for (int j = 0; j < 8; ++j) gv[j] = *((const GAS f32x4*)a.final_g + lane + 64 * j);
        for (int ml = gidx * NWAVES + wave; ml < SEQ; ml += (G / 8) * NWAVES) { const int m = grp * SEQ + ml;
            GAS f32x4* xr = (GAS f32x4*)(a.out + (size_t)m * DM) + lane;
            f32x4 v[8]; float ss = 0.f;
#pragma unroll
            for (int j = 0; j < 8; ++j) {
#if RESID_BF16
                const v2u w = *((const GAS v2u*)(Hb + (size_t)m * DM) + lane + 64 * j);
                v[j] = (f32x4){__uint_as_float(w.x << 16), __uint_as_float(w.x & 0xffff0000u), __uint_as_float(w.y << 16), __uint_as_float(w.y & 0xffff0000u)};
#else
                v[j] = xr[64 * j];
#endif
                ss += (v[j].x * v[j].x + v[j].y * v[j].y) + (v[j].z * v[j].z + v[j].w * v[j].w); }
            const float rstd = 1.0f / sqrtf(wave_sum(ss) * (1.0f / DM) + RMS_EPS);
#pragma unroll
            for (int j = 0; j < 8; ++j) xr[64 * j] = v[j] * rstd * gv[j];
        }
    }
#undef RUN
#undef SEAM
}
constexpr int N_PHASES = 1 + DEPTH * 7 + 1;

extern "C" void kernel_launch(void* const* d_in, const int* in_sizes, int n_in, void* d_out, int out_size, void* d_ws, size_t ws_size, hipStream_t stream) {
    static int grid = 0;
    if (grid == 0) {
        if (n_in != 14 || in_sizes[0] != M * DM || out_size != M * DM || ws_size < WS_END + (PROBE_DUP == 6 ? (size_t)M * DM * 4 : 0) + (PROBE_DUP == 8 ? 4096 : 0) + (PROBE_DUP == 10 ? (size_t)256 * 65536 : 0) + ((PROBE_DUP == 11 || PROBE_DUP == 12) ? (size_t)256 * 131072 : 0)) {
            fprintf(stderr, "kernel_launch: unexpected shapes (n_in %d, in0 %d, out %d, ws %zu < %zu?); nothing launched\n", n_in, n_in > 0 ? in_sizes[0] : -1, out_size, ws_size, (size_t)WS_END); grid = -1; return; }
        int dev = 0, cus = 0;
        if (hipGetDevice(&dev) != hipSuccess || hipDeviceGetAttribute(&cus, hipDeviceAttributeMultiprocessorCount, dev) != hipSuccess) { grid = -1; return; }
        if (hipFuncSetAttribute((const void*)mk_fwd, hipFuncAttributeMaxDynamicSharedMemorySize, LDS_BYTES) != hipSuccess) { fprintf(stderr, "kernel_launch: hipFuncSetAttribute failed\n"); grid = -1; return; }
        int per_cu = 0;
        if (hipOccupancyMaxActiveBlocksPerMultiprocessor(&per_cu, (const void*)mk_fwd, NWAVES * 64, LDS_BYTES) != hipSuccess || per_cu < 1)
            fprintf(stderr, "kernel_launch: note: occupancy query reports %d workgroups per CU\n", per_cu);
        (void)hipGetLastError();
        grid = cus;
        if (grid != 256) { fprintf(stderr, "kernel_launch: built for a 256-CU device (8 groups of 32 workgroups own the 8 batch elements); found %d CUs; nothing launched\n", grid); grid = -1; return; }
    }
    if (grid < 0) return;
    if (hipMemsetAsync((char*)d_ws + WS_CTL, 0, CTL_ZERO_BYTES, stream) != hipSuccess) return;
    Args a{};
    a.x = (const float*)d_in[0]; a.norm_g = (const float*)d_in[1]; a.w_gate = (const float*)d_in[2]; a.w_up = (const float*)d_in[3]; a.w_down = (const float*)d_in[4];
    a.w_in[0] = (const float*)d_in[5]; a.b_f0 = (const float*)d_in[6]; a.w_in[1] = (const float*)d_in[7]; a.w_in[2] = (const float*)d_in[8]; a.w_in[3] = (const float*)d_in[9];
    a.b_f3 = (const float*)d_in[10]; a.w_out = (const float*)d_in[11]; a.rel_bias = (const float*)d_in[12]; a.final_g = (const float*)d_in[13];
    a.out = (float*)d_out; a.ws = (unsigned char*)d_ws;
#if MK_ONE_LAUNCH
    a.ph_lo = 0; a.ph_hi = N_PHASES;
    hipLaunchKernelGGL(mk_fwd, dim3(grid), dim3(NWAVES * 64), LDS_BYTES, stream, a);
#else
    for (int p = 0; p < N_PHASES; ++p) { a.ph_lo = p; a.ph_hi = p + 1; hipLaunchKernelGGL(mk_fwd, dim3(grid), dim3(NWAVES * 64), LDS_BYTES, stream, a); }
#endif
    const hipError_t le = hipPeekAtLastError();
    if (le != hipSuccess) fprintf(stderr, "kernel_launch: launch failed: %s\n", hipGetErrorName(le));
}
```

```cpp
#include <hip/hip_runtime.h>
#include <cstdio>
#include <cstdint>

#ifndef PROBE_DUP
#define PROBE_DUP 0
#endif
#define REP(k) _Pragma("unroll 1") for (int rep_ = 0; rep_ < ((PROBE_DUP == (k)) ? 2 : 1); ++rep_)
#ifndef PROBE_KL
#define PROBE_KL 0
#endif
#ifndef EPI_RELAX
#define EPI_RELAX 0
#endif
#ifndef RESID_BF16
#define RESID_BF16 1
#endif
#ifndef MK_ONE_LAUNCH
#define MK_ONE_LAUNCH 1
#endif

namespace pg8 {
#define PG8_LAS __attribute__((address_space(3)))
typedef unsigned short bf16_t;
typedef short bf16x8 __attribute__((ext_vector_type(8)));
typedef float f32x4 __attribute__((ext_vector_type(4)));
typedef unsigned u32x4 __attribute__((ext_vector_type(4)));
constexpr int BM = 256, BK = 64, HALF = 128, HTB = HALF * BK * 2, STAGE_BYTES = 8 * HTB, NXCD = 8, WGM = 8;

__host__ __device__ __forceinline__ int lds_byte(int r, int c) { const int st = (r >> 4) * 2 + (c >> 5), rr = r & 15, cc = c & 31, ob = rr * 64 + cc * 2; return st * 1024 + (ob ^ (((ob >> 9) & 1) << 5)); }
__host__ __device__ __forceinline__ void stage_rc(int b, int& R, int& C) { const int st = b / 1024, sb = b % 1024, swz = sb ^ (((sb >> 9) & 1) << 5); R = (st >> 1) * 16 + swz / 64; C = (st & 1) * 32 + (swz % 64) / 2; }
__host__ __device__ __forceinline__ int perm32(int rho) { const int n = rho >> 4, i = rho & 15; return 8 * (i >> 2) + 4 * n + (i & 3); }

typedef __bf16 bf16x2e __attribute__((ext_vector_type(2)));
struct Unit { int pm, pn; };
struct Gemm { const bf16_t* A; const bf16_t* Bt; int M, N, K; };

struct StaticOrder {
    int nM, nN, nwg, G, c;
    __host__ __device__ void init(int M, int N, int G_, int c_) { nM = M / BM; nN = N / BM; nwg = nM * nN; G = G_; c = c_; }
    __host__ __device__ __forceinline__ bool next(int i, Unit& u) const {
        const long L = (long)i * G + c; if (L >= nwg) return false;
        int wgid = (int)L; { const int q = nwg / NXCD, r = nwg % NXCD, xcd = wgid % NXCD, off = wgid / NXCD; wgid = (xcd < r ? xcd * (q + 1) : r * (q + 1) + (xcd - r) * q) + off; }
        const int nig = WGM * nN, gid = wgid / nig, fm = gid * WGM, gsz = (nM - fm) < WGM ? (nM - fm) : WGM;
        u.pm = fm + ((wgid % nig) % gsz); u.pn = (wgid % nig) / gsz; return true;
    }
    __device__ __forceinline__ void a_ready(const Unit&) const {}
    __device__ __forceinline__ void done(const Unit&) const {}
};

__device__ __forceinline__ unsigned cvt_pk_bf16(float lo, float hi) { unsigned r; asm volatile("v_cvt_pk_bf16_f32 %0, %1, %2" : "=v"(r) : "v"(lo), "v"(hi)); return r; }

__device__ __forceinline__ float fq_sum(float s) {
    { auto rr = __builtin_amdgcn_permlane16_swap(__float_as_uint(s), __float_as_uint(s), false, false); s = __uint_as_float(rr[0]) + __uint_as_float(rr[1]); }
    { auto rr = __builtin_amdgcn_permlane32_swap(__float_as_uint(s), __float_as_uint(s), false, false); s = __uint_as_float(rr[0]) + __uint_as_float(rr[1]); }
    return s;
}
__device__ __forceinline__ float row_rstd(const float* part, int row, int fq) {
    const f32x4 a = *(const f32x4*)(part + (size_t)row * 32 + fq * 8), b = *(const f32x4*)(part + (size_t)row * 32 + fq * 8 + 4);
    const float s = fq_sum(((a[0] + a[1]) + (a[2] + a[3])) + ((b[0] + b[1]) + (b[2] + b[3])));
    return __builtin_amdgcn_rsqf(s * (1.0f / 2048.0f) + 1e-6f);
}
__device__ __forceinline__ void build_rstd_table(PG8_LAS float* rst, const float* part, int pm0, int tid) {
    if (tid < 256) { const f32x4* p = (const f32x4*)(part + (size_t)(pm0 * BM + tid) * 32); float s = 0.f;
#pragma unroll
        for (int j = 0; j < 8; ++j) { const f32x4 v = p[j]; s += (v[0] + v[1]) + (v[2] + v[3]); }
        rst[tid] = __builtin_amdgcn_rsqf(s * (1.0f / 2048.0f) + 1e-6f); }
    __syncthreads();
}
struct EpiBf16 {
    static constexpr bool PERM = true, AFTER_DRAIN = false; static constexpr int KL = 0; static constexpr int NVM = 16;
    bf16_t* O; int ldc; const float* part; const PG8_LAS float* rst; int pm0; int local;
    unsigned* kmaxp;
    __device__ __forceinline__ void operator()(const f32x4 (&acc)[2][2][4][2], const Unit& u, int wr, int wc, int fr, int fq) const {
        const int row0 = (local ? 0 : u.pm * BM) + wr * 64 + fr, col0 = (local ? 0 : u.pn * BM) + wc * 32 + 8 * fq;
        const bool kn = (kmaxp != nullptr) && u.pn >= 8 && u.pn < 16;
        float km0 = 0.f, km1 = 0.f;
        float rs[2][4];
        if (u.pm == pm0) {
#pragma unroll
            for (int ai = 0; ai < 2; ++ai)
#pragma unroll
                for (int m = 0; m < 4; ++m) rs[ai][m] = rst[wr * 64 + fr + ai * HALF + m * 16];
        } else {
#pragma unroll
            for (int ai = 0; ai < 2; ++ai)
#pragma unroll
                for (int m = 0; m < 4; ++m) rs[ai][m] = row_rstd(part, row0 + ai * HALF + m * 16, fq);
        }
#pragma unroll
        for (int ai = 0; ai < 2; ++ai)
#pragma unroll
            for (int m = 0; m < 4; ++m) { bf16_t* rowp = O + (size_t)(row0 + ai * HALF + m * 16) * ldc + col0; const float r = rs[ai][m];
#pragma unroll
                for (int bj = 0; bj < 2; ++bj) { const f32x4 v0 = acc[ai][bj][m][0] * r, v1 = acc[ai][bj][m][1] * r;
                    u32x4 w; w.x = cvt_pk_bf16(v0[0], v0[1]); w.y = cvt_pk_bf16(v0[2], v0[3]); w.z = cvt_pk_bf16(v1[0], v1[1]); w.w = cvt_pk_bf16(v1[2], v1[3]);
                    *(u32x4*)(rowp + bj * HALF) = w;
                    if (kn) { float q = __builtin_amdgcn_fdot2_f32_bf16(__builtin_bit_cast(bf16x2e, w.x), __builtin_bit_cast(bf16x2e, w.x), 0.f, false);
                        q = __builtin_amdgcn_fdot2_f32_bf16(__builtin_bit_cast(bf16x2e, w.y), __builtin_bit_cast(bf16x2e, w.y), q, false);
                        q = __builtin_amdgcn_fdot2_f32_bf16(__builtin_bit_cast(bf16x2e, w.z), __builtin_bit_cast(bf16x2e, w.z), q, false);
                        q = __builtin_amdgcn_fdot2_f32_bf16(__builtin_bit_cast(bf16x2e, w.w), __builtin_bit_cast(bf16x2e, w.w), q, false);
                        q = fq_sum(q); if (bj == 0) km0 = fmaxf(km0, q); else km1 = fmaxf(km1, q); } } }
        if (kn) {
#pragma unroll
            for (int d = 1; d < 16; d <<= 1) { km0 = fmaxf(km0, __shfl_xor(km0, d)); km1 = fmaxf(km1, __shfl_xor(km1, d)); }
            if ((fr | fq) == 0) { unsigned* kp = kmaxp + (((u.pm >> 3) * 16 + 2 * (u.pn - 8)) * 4 + wc);
                (void)__hip_atomic_fetch_max(kp, __float_as_uint(km0), __ATOMIC_RELAXED, __HIP_MEMORY_SCOPE_AGENT);
                (void)__hip_atomic_fetch_max(kp + 4, __float_as_uint(km1), __ATOMIC_RELAXED, __HIP_MEMORY_SCOPE_AGENT); }
        }
    }
};
typedef float f32x2 __attribute__((ext_vector_type(2)));
__device__ __forceinline__ f32x2 silu_mul2(f32x2 g, f32x2 u, float nrl  , float r2  ) {
    const f32x2 a = g * nrl; f32x2 e; e.x = __builtin_amdgcn_exp2f(a.x); e.y = __builtin_amdgcn_exp2f(a.y);
    const f32x2 d = e + 1.0f; f32x2 s; s.x = __builtin_amdgcn_rcpf(d.x); s.y = __builtin_amdgcn_rcpf(d.y);
    return (g * u) * (s * r2);
}
struct EpiSwiGLU {
    static constexpr bool PERM = true, AFTER_DRAIN = false; static constexpr int KL = 0; static constexpr int NVM = 8;
    bf16_t* O; int ldc; const float* part; const PG8_LAS float* rst; int pm0;
    __device__ __forceinline__ void operator()(const f32x4 (&acc)[2][2][4][2], const Unit& u, int wr, int wc, int fr, int fq) const {
        const int row0 = u.pm * BM + wr * 64 + fr, col0 = u.pn * HALF + wc * 32 + 8 * fq;
        float rs[2][4];
        if (u.pm == pm0) {
#pragma unroll
            for (int ai = 0; ai < 2; ++ai)
#pragma unroll
                for (int m = 0; m < 4; ++m) rs[ai][m] = rst[wr * 64 + fr + ai * HALF + m * 16];
        } else {
#pragma unroll
            for (int ai = 0; ai < 2; ++ai)
#pragma unroll
                for (int m = 0; m < 4; ++m) rs[ai][m] = row_rstd(part, row0 + ai * HALF + m * 16, fq);
        }
#pragma unroll
        for (int ai = 0; ai < 2; ++ai)
#pragma unroll
            for (int m = 0; m < 4; ++m) { bf16_t* rowp = O + (size_t)(row0 + ai * HALF + m * 16) * ldc + col0; const float r = rs[ai][m], nrl = r * -1.4426950408889634f, r2 = r * r;
                const f32x4 g0 = acc[ai][0][m][0], g1 = acc[ai][0][m][1], u0 = acc[ai][1][m][0], u1 = acc[ai][1][m][1];
                const f32x2 a = silu_mul2((f32x2){g0[0], g0[1]}, (f32x2){u0[0], u0[1]}, nrl, r2), b = silu_mul2((f32x2){g0[2], g0[3]}, (f32x2){u0[2], u0[3]}, nrl, r2);
                const f32x2 c = silu_mul2((f32x2){g1[0], g1[1]}, (f32x2){u1[0], u1[1]}, nrl, r2), d = silu_mul2((f32x2){g1[2], g1[3]}, (f32x2){u1[2], u1[3]}, nrl, r2);
                u32x4 w; w.x = cvt_pk_bf16(a.x, a.y); w.y = cvt_pk_bf16(b.x, b.y); w.z = cvt_pk_bf16(c.x, c.y); w.w = cvt_pk_bf16(d.x, d.y);
                *(u32x4*)rowp = w; }
    }
};
struct EpiResid {
    static constexpr bool PERM = true, AFTER_DRAIN = false; static constexpr int KL = 0; static constexpr int NVM = 32;
    const float* base; float* out; bf16_t* xb; float* part; int ldc; float alpha;
    __device__ __forceinline__ void operator()(const f32x4 (&acc)[2][2][4][2], const Unit& u, int wr, int wc, int fr, int fq) const {
        const int row0 = u.pm * BM + wr * 64 + fr, col0 = u.pn * BM + wc * 32 + 8 * fq;
#pragma unroll
        for (int ai = 0; ai < 2; ++ai)
#pragma unroll
            for (int m = 0; m < 4; ++m) { const int row = row0 + ai * HALF + m * 16; const size_t off = (size_t)row * ldc + col0; float s = 0.f;
#pragma unroll
                for (int bj = 0; bj < 2; ++bj) { const f32x4 b0 = *(const f32x4*)(base + off + bj * HALF), b1 = *(const f32x4*)(base + off + bj * HALF + 4);
                    const f32x4 o0 = b0 + alpha * acc[ai][bj][m][0], o1 = b1 + alpha * acc[ai][bj][m][1];
                    *(f32x4*)(out + off + bj * HALF) = o0; *(f32x4*)(out + off + bj * HALF + 4) = o1;
                    u32x4 w; w.x = cvt_pk_bf16(o0[0], o0[1]); w.y = cvt_pk_bf16(o0[2], o0[3]); w.z = cvt_pk_bf16(o1[0], o1[1]); w.w = cvt_pk_bf16(o1[2], o1[3]);
                    *(u32x4*)(xb + off + bj * HALF) = w;
                    s += ((o0[0] * o0[0] + o0[1] * o0[1]) + (o0[2] * o0[2] + o0[3] * o0[3])) + ((o1[0] * o1[0] + o1[1] * o1[1]) + (o1[2] * o1[2] + o1[3] * o1[3])); }
                s = fq_sum(s);
                if (fq == 0) part[(size_t)row * 32 + u.pn * 4 + wc] = s;
                if (m & 1) asm volatile("" ::: "memory"); }
    }
};

struct EpiResidB {
    static constexpr bool PERM = true, AFTER_DRAIN = false; static constexpr int KL = 0; static constexpr int NVM = 32;
    bf16_t* xb; float* part; int ldc; float alpha;
    __device__ __forceinline__ void operator()(const f32x4 (&acc)[2][2][4][2], const Unit& u, int wr, int wc, int fr, int fq) const {
        const int row0 = u.pm * BM + wr * 64 + fr, col0 = u.pn * BM + wc * 32 + 8 * fq;
#pragma unroll
        for (int ai = 0; ai < 2; ++ai)
#pragma unroll
            for (int m = 0; m < 4; ++m) { const int row = row0 + ai * HALF + m * 16; const size_t off = (size_t)row * ldc + col0; float s = 0.f;
#pragma unroll
                for (int bj = 0; bj < 2; ++bj) { const u32x4 b = *(const u32x4*)(xb + off + bj * HALF);
                    const f32x4 b0 = {__uint_as_float(b.x << 16), __uint_as_float(b.x & 0xffff0000u), __uint_as_float(b.y << 16), __uint_as_float(b.y & 0xffff0000u)};
                    const f32x4 b1 = {__uint_as_float(b.z << 16), __uint_as_float(b.z & 0xffff0000u), __uint_as_float(b.w << 16), __uint_as_float(b.w & 0xffff0000u)};
                    const f32x4 o0 = b0 + alpha * acc[ai][bj][m][0], o1 = b1 + alpha * acc[ai][bj][m][1];
                    u32x4 w; w.x = cvt_pk_bf16(o0[0], o0[1]); w.y = cvt_pk_bf16(o0[2], o0[3]); w.z = cvt_pk_bf16(o1[0], o1[1]); w.w = cvt_pk_bf16(o1[2], o1[3]);
                    *(u32x4*)(xb + off + bj * HALF) = w;
                    const f32x4 r0 = {__uint_as_float(w.x << 16), __uint_as_float(w.x & 0xffff0000u), __uint_as_float(w.y << 16), __uint_as_float(w.y & 0xffff0000u)};
                    const f32x4 r1 = {__uint_as_float(w.z << 16), __uint_as_float(w.z & 0xffff0000u), __uint_as_float(w.w << 16), __uint_as_float(w.w & 0xffff0000u)};
                    s += ((r0[0] * r0[0] + r0[1] * r0[1]) + (r0[2] * r0[2] + r0[3] * r0[3])) + ((r1[0] * r1[0] + r1[1] * r1[1]) + (r1[2] * r1[2] + r1[3] * r1[3])); }
                s = fq_sum(s);
                if (fq == 0) part[(size_t)row * 32 + u.pn * 4 + wc] = s; }
    }
};
struct ProbeOrder : StaticOrder {
    __host__ __device__ bool next(int i, Unit& u) const { const bool r = StaticOrder::next(i, u); u.pm = c & 7; u.pn = (c >> 3) & 3; return r; }
};
struct EpiSwiGLULocal {
    static constexpr bool PERM = true, AFTER_DRAIN = false; static constexpr int KL = 0; static constexpr int NVM = 8;
    EpiSwiGLU inner;
    __device__ __forceinline__ void operator()(const f32x4 (&acc)[2][2][4][2], const Unit& u, int wr, int wc, int fr, int fq) const {
        Unit v; v.pm = 0; v.pn = 0; EpiSwiGLU e = inner; e.pm0 = 0; e(acc, v, wr, wc, fr, fq);
    }
};
struct EpiNull {
    static constexpr bool PERM = true, AFTER_DRAIN = false; static constexpr int KL = PROBE_KL; static constexpr int NVM = 0;
    float* sink;
    __device__ __forceinline__ void operator()(const f32x4 (&acc)[2][2][4][2], const Unit& u, int wr, int wc, int fr, int fq) const {
        f32x4 t = {0.f, 0.f, 0.f, 0.f};
#pragma unroll
        for (int ai = 0; ai < 2; ++ai)
#pragma unroll
            for (int bj = 0; bj < 2; ++bj)
#pragma unroll
                for (int m = 0; m < 4; ++m)
#pragma unroll
                    for (int n = 0; n < 2; ++n) t += acc[ai][bj][m][n];
        if ((t[0] + t[1]) + (t[2] + t[3]) == 1.2345678e30f) sink[0] = 1.f;
    }
};
template <class Epi, class Sched, bool ALIGN_EPI = false, bool SP2 = false>
__device__ __forceinline__ void gemm_phase(PG8_LAS unsigned char* lds, const Gemm g, const Sched& S, const Epi& E) {
    int tid = threadIdx.x; asm volatile("" : "+v"(tid));
    const int wid = __builtin_amdgcn_readfirstlane(tid >> 6), lane = tid & 63, wr = wid >> 2, wc = wid & 3, fr = lane & 15, fq = lane >> 4;
    constexpr int KL_ = Epi::KL;
    const int K = g.K, nt = K / BK;
    unsigned voffA[2], voffB[2];
#pragma unroll
    for (int i = 0; i < 2; ++i) { int R, C; stage_rc(tid * 16 + i * 8192, R, C); const int Rb = Epi::PERM ? ((R & ~31) + perm32(R & 31)) : R;
        voffA[i] = (unsigned)(R * K + C) * 2u; voffB[i] = (unsigned)(Rb * K + C) * 2u; }
    const size_t kstep = (size_t)(BK * 2);
    const size_t hstep = (size_t)HALF * K * 2;
    const size_t tstep = 2 * hstep;
    const unsigned ldsw = (unsigned)wid * 1024u;
    const int aoff = lds_byte(wr * 64 + fr, fq * 8), boff = lds_byte(wc * 32 + fr, fq * 8);
#define PG8_SA(b, h) (((b) * 2 + (h)) * HTB)
#define PG8_SB(b, h) ((4 + (b) * 2 + (h)) * HTB)
#define PG8_STAGE(bufoff, gbase, voff) do { _Pragma("unroll") for (int _i = 0; _i < 2; ++_i) \
        __builtin_amdgcn_global_load_lds((const unsigned*)((const char*)(gbase) + (voff)[_i]), (PG8_LAS unsigned*)(lds + (bufoff) + ldsw + _i * 8192), 16, 0, 0); } while (0)
#define PG8_LDA(dst, b, h) do { _Pragma("unroll") for (int m = 0; m < 4; ++m) _Pragma("unroll") for (int k = 0; k < 2; ++k) dst[m][k] = *(const PG8_LAS bf16x8*)(lds + PG8_SA(b, h) + aoff + m * 2048 + k * 1024); } while (0)
#define PG8_LDB(dst, b, h) do { _Pragma("unroll") for (int n = 0; n < 2; ++n) _Pragma("unroll") for (int k = 0; k < 2; ++k) dst[n][k] = *(const PG8_LAS bf16x8*)(lds + PG8_SB(b, h) + boff + n * 2048 + k * 1024); } while (0)
#define PG8_MMA(ai, bj, At, Bt) do { __builtin_amdgcn_s_setprio(1); _Pragma("unroll") for (int m = 0; m < 4; ++m) _Pragma("unroll") for (int n = 0; n < 2; ++n) _Pragma("unroll") for (int k = 0; k < 2; ++k) \
        acc[ai][bj][m][n] = __builtin_amdgcn_mfma_f32_16x16x32_bf16(Bt[n][k], At[m][k], acc[ai][bj][m][n], 0, 0, 0); __builtin_amdgcn_s_setprio(0); } while (0)
#define PG8_WAIT_V(n) asm volatile("s_waitcnt vmcnt(" #n ")" ::: "memory")
#define PG8_WAIT_L(n) asm volatile("s_waitcnt lgkmcnt(" #n ")" ::: "memory")
#define PG8_BAR __builtin_amdgcn_s_barrier()
#define PG8_SCHED __builtin_amdgcn_sched_barrier(0)
    Unit cur, nxt; int ui = 0;
    if (!S.next(0, cur)) return;
    f32x4 acc[2][2][4][2];
#pragma unroll
    for (int a = 0; a < 2; ++a)
#pragma unroll
        for (int b = 0; b < 2; ++b)
#pragma unroll
            for (int m = 0; m < 4; ++m)
#pragma unroll
                for (int n = 0; n < 2; ++n) acc[a][b][m][n] = (f32x4){0.f, 0.f, 0.f, 0.f};
    bf16x8 At[4][2], B0[2][2], B1[2][2];
    const char* cA = (const char*)g.A + (size_t)cur.pm * tstep; const char* cB = (const char*)g.Bt + (size_t)cur.pn * tstep;
    S.a_ready(cur);
    if constexpr (SP2) {
        PG8_STAGE(PG8_SB(0, 0), cB, voffB); PG8_STAGE(PG8_SB(0, 1), cB + hstep, voffB); PG8_STAGE(PG8_SA(0, 0), cA, voffA); PG8_STAGE(PG8_SA(0, 1), cA + hstep, voffA);
        if (wr == 1) PG8_BAR;
        PG8_WAIT_V(2); PG8_BAR;
        PG8_STAGE(PG8_SB(1, 0), cB + kstep, voffB); PG8_STAGE(PG8_SA(1, 0), cA + kstep, voffA); PG8_STAGE(PG8_SB(1, 1), cB + hstep + kstep, voffB);
        PG8_WAIT_V(6); PG8_BAR;
    } else {
        PG8_STAGE(PG8_SB(0, 0), cB, voffB); PG8_STAGE(PG8_SA(0, 0), cA, voffA); PG8_STAGE(PG8_SB(0, 1), cB + hstep, voffB); PG8_STAGE(PG8_SA(0, 1), cA + hstep, voffA);
        if (wr == 1) PG8_BAR;
        PG8_WAIT_V(4); PG8_BAR;
        PG8_STAGE(PG8_SB(1, 0), cB + kstep, voffB); PG8_STAGE(PG8_SA(1, 0), cA + kstep, voffA); PG8_STAGE(PG8_SB(1, 1), cB + hstep + kstep, voffB);
        PG8_WAIT_V(6); PG8_BAR;
    }
    for (;;) {
        const bool has_next = S.next(ui + 1, nxt);
        const char* nA = has_next ? (const char*)g.A + (size_t)nxt.pm * tstep : cA; const char* nB = has_next ? (const char*)g.Bt + (size_t)nxt.pn * tstep : cB;
        for (int t = 0; t < nt; t += 2) {
            const bool last = (t == nt - 2);
            const char* a1 = cA + (size_t)(t + 1) * kstep;
            const char* a2 = last ? nA : cA + (size_t)(t + 2) * kstep; const char* b2 = last ? nB : cB + (size_t)(t + 2) * kstep;
            const char* a3 = a2 + kstep; const char* b3 = b2 + kstep;
            if (last && has_next) S.a_ready(nxt);
            if constexpr (SP2) {
#define PG8_KT_PAIR(W1_, W2_) do { \
            if (KL_ != 4) { PG8_LDB(B0, 0, 0); PG8_LDB(B1, 0, 1); } PG8_SCHED; PG8_LDA(At, 0, 0); if (KL_ != 2) PG8_STAGE(PG8_SA(1, 1), a1 + hstep, voffA); \
            W1_; PG8_WAIT_L(0); PG8_BAR; PG8_MMA(0, 0, At, B0); PG8_MMA(0, 1, At, B1); PG8_BAR; PG8_SCHED; \
            if (KL_ != 1) PG8_LDA(At, 0, 1); if (KL_ != 2) { PG8_STAGE(PG8_SB(0, 0), b2, voffB); PG8_STAGE(PG8_SB(0, 1), b2 + hstep, voffB); PG8_STAGE(PG8_SA(0, 0), a2, voffA); } \
            W2_; PG8_WAIT_L(0); PG8_BAR; PG8_MMA(1, 0, At, B0); PG8_MMA(1, 1, At, B1); PG8_BAR; PG8_SCHED; \
            if (KL_ != 4) { PG8_LDB(B0, 1, 0); PG8_LDB(B1, 1, 1); } PG8_SCHED; PG8_LDA(At, 1, 0); if (KL_ != 2) PG8_STAGE(PG8_SA(0, 1), a2 + hstep, voffA); \
            PG8_WAIT_V(8); PG8_WAIT_L(0); PG8_BAR; PG8_MMA(0, 0, At, B0); PG8_MMA(0, 1, At, B1); PG8_BAR; PG8_SCHED; \
            if (KL_ != 1) PG8_LDA(At, 1, 1); if (KL_ != 2) { PG8_STAGE(PG8_SB(1, 0), b3, voffB); PG8_STAGE(PG8_SB(1, 1), b3 + hstep, voffB); PG8_STAGE(PG8_SA(1, 0), a3, voffA); } \
            PG8_WAIT_V(8); PG8_WAIT_L(0); PG8_BAR; PG8_MMA(1, 0, At, B0); PG8_MMA(1, 1, At, B1); PG8_BAR; PG8_SCHED; } while (0)
#define PG8_WAIT_VN(n_) asm volatile("s_waitcnt vmcnt(%0)" :: "n"(n_) : "memory")
            const int relax = (EPI_RELAX && t == 0 && ui > 0) ? 1 : 0;
#define PG8_WAIT_SEL() asm volatile("s_cmp_eq_u32 %0, 0\n\ts_cbranch_scc1 .Lw8_%=\n\ts_waitcnt vmcnt(%1)\n\ts_branch .Lwd_%=\n.Lw8_%=:\n\ts_waitcnt vmcnt(8)\n.Lwd_%=:" :: "s"(__builtin_amdgcn_readfirstlane(relax)), "n"(8 + Epi::NVM) : "scc", "memory")
            PG8_KT_PAIR(PG8_WAIT_SEL(), PG8_WAIT_SEL());
#undef PG8_WAIT_SEL
#undef PG8_KT_PAIR
#undef PG8_WAIT_VN
            } else {
            PG8_LDB(B0, 0, 0); PG8_SCHED; PG8_LDA(At, 0, 0); PG8_STAGE(PG8_SA(1, 1), a1 + hstep, voffA);
            PG8_WAIT_L(8); PG8_BAR; PG8_WAIT_L(0); PG8_MMA(0, 0, At, B0); PG8_BAR; PG8_SCHED;
            PG8_LDB(B1, 0, 1); PG8_STAGE(PG8_SB(0, 0), b2, voffB);
            PG8_BAR; PG8_WAIT_L(0); PG8_MMA(0, 1, At, B1); PG8_BAR;
            PG8_LDA(At, 0, 1); PG8_STAGE(PG8_SA(0, 0), a2, voffA);
            PG8_BAR; PG8_WAIT_L(0); PG8_MMA(1, 0, At, B0); PG8_BAR; PG8_SCHED;
            PG8_STAGE(PG8_SB(0, 1), b2 + hstep, voffB);
            PG8_WAIT_V(6); PG8_BAR; PG8_MMA(1, 1, At, B1); PG8_BAR;
            PG8_LDB(B0, 1, 0); PG8_SCHED; PG8_LDA(At, 1, 0); PG8_STAGE(PG8_SA(0, 1), a2 + hstep, voffA);
            PG8_WAIT_L(8); PG8_BAR; PG8_WAIT_L(0); PG8_MMA(0, 0, At, B0); PG8_BAR; PG8_SCHED;
            PG8_LDB(B1, 1, 1); PG8_STAGE(PG8_SB(1, 0), b3, voffB);
            PG8_BAR; PG8_WAIT_L(0); PG8_MMA(0, 1, At, B1); PG8_BAR;
            PG8_LDA(At, 1, 1); PG8_STAGE(PG8_SA(1, 0), a3, voffA);
            PG8_BAR; PG8_WAIT_L(0); PG8_MMA(1, 0, At, B0); PG8_BAR; PG8_SCHED;
            PG8_STAGE(PG8_SB(1, 1), b3 + hstep, voffB);
            PG8_WAIT_V(6); PG8_BAR; PG8_MMA(1, 1, At, B1); PG8_BAR;
            }
        }
        if constexpr (ALIGN_EPI) { if (wr == 0) PG8_BAR; }
        if constexpr (!Epi::AFTER_DRAIN) { E(acc, cur, wr, wc, fr, fq); S.done(cur); }
        if (!has_next) break;
#pragma unroll
        for (int a = 0; a < 2; ++a)
#pragma unroll
            for (int b = 0; b < 2; ++b)
#pragma unroll
                for (int m = 0; m < 4; ++m)
#pragma unroll
                    for (int n = 0; n < 2; ++n) acc[a][b][m][n] = (f32x4){0.f, 0.f, 0.f, 0.f};
        cur = nxt; cA = nA; cB = nB; ++ui;
        if constexpr (ALIGN_EPI) { if (wr == 1) PG8_BAR; }
    }
    PG8_WAIT_V(0);
    if constexpr (!ALIGN_EPI) { if (wr == 0) PG8_BAR; }
    PG8_BAR;
#undef PG8_SA
#undef PG8_SB
#undef PG8_STAGE
#undef PG8_LDA
#undef PG8_LDB
#undef PG8_MMA
#undef PG8_WAIT_V
#undef PG8_WAIT_L
#undef PG8_BAR
#undef PG8_SCHED
}
}

constexpr int DM = 2048, NBATCH = 8, SEQ = 2048, DEPTH = 4, NH = 16, HD = 128, FF = 5632;
constexpr int M = NBATCH * SEQ;
constexpr int NGU = 2 * FF, NQKV = 3 * DM;
constexpr float RMS_EPS = 1e-6f;
constexpr int NWAVES = 8;

constexpr size_t MiB = 1u << 20;
constexpr size_t WS_CTL = 0, CTL_ZERO_BYTES = 1 * MiB;
constexpr size_t WS_LF = 1 * MiB;
constexpr size_t WS_PART = 2 * MiB;
constexpr size_t WS_WF = 4 * MiB;
constexpr size_t WS_WGU = 5 * MiB;
constexpr size_t SZ_WGU = (size_t)NGU * DM * 2;
constexpr size_t WS_WD = WS_WGU + 8 * SZ_WGU;
constexpr size_t SZ_WD = (size_t)DM * FF * 2;
constexpr size_t WS_WQKV = WS_WD + 8 * SZ_WD;
constexpr size_t SZ_WQKV = (size_t)NQKV * DM * 2;
constexpr size_t WS_WO = WS_WQKV + 4 * SZ_WQKV;
constexpr size_t SZ_WO = (size_t)DM * DM * 2;
constexpr size_t WS_H = WS_WO + 4 * SZ_WO;
constexpr size_t WS_AO = WS_H + (size_t)M * DM * 2;
constexpr size_t WS_ACT = WS_AO + (size_t)M * DM * 2;
constexpr size_t WS_END = WS_ACT + (size_t)M * NQKV * 2;
static_assert(WS_WGU % 256 == 0 && WS_WD % 256 == 0 && WS_WQKV % 256 == 0 && WS_WO % 256 == 0 && WS_H % 256 == 0 && WS_ACT % 256 == 0, "alignment");

constexpr int CW_TMO = 0;
constexpr int CW_BAR = 4096;
constexpr int CW_Q = 200000;
constexpr int CW_KMAX = 65536;

constexpr int RING_OFF = 0, RING_BYTES = 131072;
constexpr int LDS_BYTES = 147456;
constexpr int RST_OFF = RING_BYTES;
constexpr int MISC_OFF = LDS_BYTES - 256;

#define GAS __attribute__((address_space(1)))
#define LAS __attribute__((address_space(3)))
typedef unsigned short bf16;
typedef unsigned v4u __attribute__((ext_vector_type(4)));
typedef unsigned v2u __attribute__((ext_vector_type(2)));
typedef float f32x4 __attribute__((ext_vector_type(4)));
typedef float f32x16 __attribute__((ext_vector_type(16)));
typedef short bf16x8 __attribute__((ext_vector_type(8)));
typedef short s16x4 __attribute__((ext_vector_type(4)));
typedef __bf16 bf16x2h __attribute__((ext_vector_type(2)));
typedef GAS unsigned gu32;
#define RLX_AGENT __ATOMIC_RELAXED, __HIP_MEMORY_SCOPE_AGENT
#define LDS_WAIT() asm volatile("s_waitcnt lgkmcnt(0)" ::: "memory")
#define VM_WAIT() asm volatile("s_waitcnt vmcnt(0)" ::: "memory")
__device__ __forceinline__ unsigned cvtpk(float lo, float hi) { unsigned r; asm volatile("v_cvt_pk_bf16_f32 %0, %1, %2" : "=v"(r) : "v"(lo), "v"(hi)); return r; }

#define XB_TMO      128
#define XB_XCNT(j)  (256  + 64 * (j))
#define XB_XSUB(j)  (1280 + 64 * (j))
#define XB_XGEN(j)  (2304 + 64 * (j))
#define XB_TOP      3328
#define XB_TOPGEN   3392
#define XCD_BAR_WORDS 3456
#define XB_SPIN_CAP (1u << 18)
__device__ __forceinline__ unsigned xb_ld(unsigned* p)              { return __hip_atomic_load(p, __ATOMIC_RELAXED, __HIP_MEMORY_SCOPE_AGENT); }
__device__ __forceinline__ unsigned xb_add(unsigned* p, unsigned v) { return __hip_atomic_fetch_add(p, v, __ATOMIC_RELAXED, __HIP_MEMORY_SCOPE_AGENT); }
__device__ __forceinline__ unsigned xb_xcc_id() { return (unsigned)__builtin_amdgcn_s_getreg((3 << 11) | 20) & 0xFu; }
#define XB_SPIN(cond, bar) do { unsigned _sp = 0; while (cond) { __builtin_amdgcn_s_sleep(1); \
    if ((++_sp & 255u) == 0u) { if (xb_ld(&(bar)[XB_TMO])) break; if (_sp > XB_SPIN_CAP) { atomicAdd(&(bar)[XB_TMO], 1u); break; } } } } while (0)
struct XcdBarrier { unsigned* bar; unsigned x; volatile LAS unsigned* st; unsigned gsize; };
__device__ __forceinline__ XcdBarrier xcd_barrier_post(unsigned* bar, volatile LAS unsigned* st, unsigned gsize) {
    XcdBarrier b; b.bar = bar; b.x = xb_xcc_id(); b.st = st; b.gsize = gsize;
    if (threadIdx.x == 0) (void)xb_add(&bar[XB_XCNT(b.x)], 1u);
    return b;
}
__device__ __forceinline__ void xcd_barrier_complete(unsigned* bar, unsigned x, unsigned G, unsigned& nloc, unsigned& nx) {
    unsigned sum, cnt, mine, sp = 0u;
    for (;;) {
        sum = 0u; cnt = 0u; mine = 0u;
#pragma unroll
        for (unsigned j = 0; j < 16; ++j) { const unsigned c = xb_ld(&bar[XB_XCNT(j)]); sum += c; cnt += (c > 0u) ? 1u : 0u; mine = (j == x) ? c : mine; }
        if (sum == G) break;
        __builtin_amdgcn_s_sleep(1);
        if ((++sp & 255u) == 0u) { if (xb_ld(&bar[XB_TMO])) break; if (sp > XB_SPIN_CAP) { atomicAdd(&bar[XB_TMO], 1u); break; } }
    }
    nloc = mine > 0u ? mine : 1u; nx = cnt > 0u ? cnt : 1u;
}
__device__ __forceinline__ void xcd_barrier(const XcdBarrier& b) {
    asm volatile("s_waitcnt vmcnt(0)" ::: "memory");
    __syncthreads();
    if (threadIdx.x == 0) {
        unsigned* bar = b.bar;
        __builtin_amdgcn_s_waitcnt(0);
        unsigned nloc = b.st[0], nx = b.st[1];
        if (nloc == 0u) { xcd_barrier_complete(bar, b.x, b.gsize, nloc, nx); b.st[0] = nloc; b.st[1] = nx; }
        const unsigned old = xb_add(&bar[XB_XSUB(b.x)], 1u);
        const unsigned gen = old / nloc;
        if (old + 1u == (gen + 1u) * nloc) {
            __builtin_amdgcn_fence(__ATOMIC_RELEASE, "agent");
            asm volatile("s_waitcnt vmcnt(0)" ::: "memory");
            const unsigned og = xb_add(&bar[XB_TOP], 1u);
            const unsigned tg = og / nx;
            if (og + 1u == (tg + 1u) * nx) xb_add(&bar[XB_TOPGEN], 1u);
            else XB_SPIN(xb_ld(&bar[XB_TOPGEN]) == tg, bar);
            __builtin_amdgcn_fence(__ATOMIC_ACQUIRE, "agent");
            xb_add(&bar[XB_XGEN(b.x)], 1u);
            asm volatile("s_waitcnt vmcnt(0)" ::: "memory");
        } else {
            XB_SPIN(xb_ld(&bar[XB_XGEN(b.x)]) == gen, bar);
            __builtin_amdgcn_fence(__ATOMIC_ACQUIRE, "agent");
            asm volatile("s_waitcnt vmcnt(0)" ::: "memory");
        }
    }
    __syncthreads();
}

__device__ __forceinline__ int opaque_tid() { int t = threadIdx.x; asm volatile("" : "+v"(t)); return t; }
__device__ __forceinline__ float wave_sum(float v) {
#pragma unroll
    for (int o = 1; o < 64; o <<= 1) v += __shfl_xor(v, o);
    return v;
}

__device__ __forceinline__ void transpose_item(const float* __restrict__ W, int ldw, int Kdim, bf16* __restrict__ WT, int k0, int n0, int drow0, const float* __restrict__ gk, LAS float* scr, int lane) {
    const int nl = (lane & 15) * 4, kl = lane >> 4;
    f32x4 v[16];
#pragma unroll
    for (int i = 0; i < 16; ++i) v[i] = *(const GAS f32x4*)(W + (size_t)(k0 + 4 * i + kl) * ldw + n0 + nl);
#pragma unroll
    for (int i = 0; i < 16; ++i) { const float gg = gk ? gk[k0 + 4 * i + kl] : 1.0f; LAS float* s = scr + (4 * i + kl) * 65 + nl; s[0] = v[i].x * gg; s[1] = v[i].y * gg; s[2] = v[i].z * gg; s[3] = v[i].w * gg; }
    LDS_WAIT(); asm volatile("" ::: "memory");
    const int c = lane & 7;
#pragma unroll
    for (int j = 0; j < 8; ++j) { const int n = (lane >> 3) + 8 * j; const LAS float* s = scr + (8 * c) * 65 + n;
        v4u o; o.x = cvtpk(s[0 * 65], s[1 * 65]); o.y = cvtpk(s[2 * 65], s[3 * 65]); o.z = cvtpk(s[4 * 65], s[5 * 65]); o.w = cvtpk(s[6 * 65], s[7 * 65]);
        *(GAS v4u*)(WT + (size_t)(drow0 + n) * Kdim + k0 + 8 * c) = o; }
    LDS_WAIT(); asm volatile("" ::: "memory");
}

namespace att {
constexpr int D = 128, NW = 8, QBLK = 32, KVBLK = 64, QB = 256;
constexpr int SHM_K = KVBLK * D * 2, SHM_V = KVBLK * D * 2;
constexpr int L_V = 0, L_K = 2 * SHM_V, L_WS = L_K + 2 * SHM_K, L_TAB = L_WS + NW * 64 * 4, L_SCAN = L_TAB + 2304 * 4, L_FLAG = L_SCAN + 64, L_END = L_FLAG + 64;
constexpr int TAB_N = 2304;
constexpr int QPITCH = NQKV, OPITCH = DM;
constexpr float SCALE = 0.08838834764831845f;
constexpr float C2 = 1.4426950408889634f * SCALE;
constexpr float THR = 8.f;

#define KSWZ(row, colB) ((row) * 256 + ((colB) ^ (((row) & 7) << 4)))
#define SBAR() __builtin_amdgcn_sched_barrier(0)
__device__ __forceinline__ int v_st(int k, int c) { const int kk = (k & ~0xC) | ((k & 4) << 1) | ((k & 8) >> 1); return ((kk >> 3) * 4 + (c >> 5)) * 512 + ((kk & 7) * 32 + (c & 31)) * 2; }
__device__ __forceinline__ int v_rd_base(int lane) { return ((lane & 3) << 3) | (((lane >> 2) & 3) << 6) | (((lane >> 4) & 1) << 5) | (((lane >> 5) & 1) << 8); }
constexpr int v_rd_off(int d0, int ks, int half) { return d0 * 512 + ks * 4096 + half * 2048; }
__device__ __forceinline__ int crow(int r, int hi) { return (r & 3) + 8 * (r >> 2) + 4 * hi; }

template <bool STRICT>
__device__ __forceinline__ void mask_tile(f32x16& p0, f32x16& p1, int dq) {
    const float NEG = -__builtin_inff();
    const int lim = STRICT ? 1 : 0;
#pragma unroll
    for (int r = 0; r < 16; ++r) {
        const int c = (r & 3) + 8 * (r >> 2);
        if (dq - c < lim) p0[r] = NEG;
        if (dq - c - 32 < lim) p1[r] = NEG;
    }
}
__device__ __forceinline__ void partialSM(f32x16& p0, f32x16& p1, float& m_reg, float& mn, float& alpha) {
    float pmax = p0[0];
#pragma unroll
    for (int r = 1; r < 16; ++r) pmax = fmaxf(pmax, p0[r]);
#pragma unroll
    for (int r = 0; r < 16; ++r) pmax = fmaxf(pmax, p1[r]);
    { auto rr = __builtin_amdgcn_permlane32_swap(__float_as_uint(pmax), __float_as_uint(pmax), false, false);
      pmax = fmaxf(__uint_as_float(rr[0]), __uint_as_float(rr[1])); }
    if (__builtin_expect(__all((pmax - m_reg) * SCALE <= THR), 1)) { mn = m_reg; alpha = 1.f; }
    else { mn = fmaxf(m_reg, pmax); alpha = __builtin_amdgcn_exp2f((m_reg - mn) * C2); m_reg = mn; }
    const float mnL = -mn * C2;
#pragma unroll
    for (int r = 0; r < 16; ++r) p0[r] = fmaf(p0[r], C2, mnL);
#pragma unroll
    for (int r = 0; r < 16; ++r) p1[r] = fmaf(p1[r], C2, mnL);
#pragma unroll
    for (int r = 0; r < 16; ++r) p0[r] = __builtin_amdgcn_exp2f(p0[r]);
}
#define PK4(P, B_, OUT) do { unsigned a0 = cvtpk(P[B_+0], P[B_+1]), a1 = cvtpk(P[B_+2], P[B_+3]);                          \
        unsigned b0 = cvtpk(P[B_+4], P[B_+5]), b1 = cvtpk(P[B_+6], P[B_+7]);                                             \
        auto r0 = __builtin_amdgcn_permlane32_swap(a0, b0, false, false); auto r1 = __builtin_amdgcn_permlane32_swap(a1, b1, false, false); \
        v4u w = {r0[0], r1[0], r0[1], r1[1]}; OUT = __builtin_bit_cast(bf16x8, w); } while (0)
__device__ __forceinline__ void finishSM(f32x16& p0, f32x16& p1, float alpha, float& l_reg, bf16x8& pa0, bf16x8& pa1, bf16x8& pa2, bf16x8& pa3) {
#pragma unroll
    for (int r = 0; r < 16; ++r) p1[r] = __builtin_amdgcn_exp2f(p1[r]);
    float ps = 0;
#pragma unroll
    for (int r = 0; r < 16; ++r) ps += p0[r];
#pragma unroll
    for (int r = 0; r < 16; ++r) ps += p1[r];
    { auto rr = __builtin_amdgcn_permlane32_swap(__float_as_uint(ps), __float_as_uint(ps), false, false);
      ps = __uint_as_float(rr[0]) + __uint_as_float(rr[1]); }
    l_reg = l_reg * alpha + ps;
    PK4(p0, 0, pa0); PK4(p0, 8, pa1); PK4(p1, 0, pa2); PK4(p1, 8, pa3);
}
template <int KB>
__device__ __forceinline__ void qkt(f32x16& p0, f32x16& p1, const LAS char* K_lds, int r32, int hi, const bf16x8* qr) {
    const LAS char* kb[4];
#pragma unroll
    for (int dd = 0; dd < 4; ++dd) kb[dd] = K_lds + KB * SHM_K + KSWZ(r32, (dd * 16 + hi * 8) * 2);
#pragma unroll
    for (int d0 = 0; d0 < 8; ++d0) { const LAS char* a = kb[d0 & 3] + (d0 >> 2) * 128;
        bf16x8 b0 = *reinterpret_cast<const LAS bf16x8*>(a);
        bf16x8 b1 = *reinterpret_cast<const LAS bf16x8*>(a + 32 * 256);
        p0 = __builtin_amdgcn_mfma_f32_32x32x16_bf16(b0, qr[d0], p0, 0, 0, 0);
        p1 = __builtin_amdgcn_mfma_f32_32x32x16_bf16(b1, qr[d0], p1, 0, 0, 0); }
}
template <int VB>
__device__ __forceinline__ void pv_tile(f32x16* o, int vb0, bf16x8 pa0, bf16x8 pa1, bf16x8 pa2, bf16x8 pa3) {
#define TRRD(dst, off) asm volatile("ds_read_b64_tr_b16 %0, %1 offset:%2" : "=&v"(dst) : "v"(vb0), "i"(off) : "memory")
#define PV_D0(d0) do { s16x4 l0, l1, l2, l3, h0, h1, h2, h3; constexpr int b_ = VB * SHM_V + v_rd_off(d0, 0, 0); \
        TRRD(l0, b_); TRRD(h0, b_ + 2048); TRRD(l1, b_ + 4096); TRRD(h1, b_ + 6144); TRRD(l2, b_ + 8192); TRRD(h2, b_ + 10240); TRRD(l3, b_ + 12288); TRRD(h3, b_ + 14336); \
        asm volatile("s_waitcnt lgkmcnt(0)" ::: "memory"); SBAR();   \
        o[d0] = __builtin_amdgcn_mfma_f32_32x32x16_bf16(pa0, (bf16x8){l0[0], l0[1], l0[2], l0[3], h0[0], h0[1], h0[2], h0[3]}, o[d0], 0, 0, 0);   \
        o[d0] = __builtin_amdgcn_mfma_f32_32x32x16_bf16(pa1, (bf16x8){l1[0], l1[1], l1[2], l1[3], h1[0], h1[1], h1[2], h1[3]}, o[d0], 0, 0, 0);   \
        o[d0] = __builtin_amdgcn_mfma_f32_32x32x16_bf16(pa2, (bf16x8){l2[0], l2[1], l2[2], l2[3], h2[0], h2[1], h2[2], h2[3]}, o[d0], 0, 0, 0);   \
        o[d0] = __builtin_amdgcn_mfma_f32_32x32x16_bf16(pa3, (bf16x8){l3[0], l3[1], l3[2], l3[3], h3[0], h3[1], h3[2], h3[3]}, o[d0], 0, 0, 0); } while (0)
    PV_D0(0); PV_D0(1); PV_D0(2); PV_D0(3);
#undef PV_D0
#undef TRRD
}
__device__ __forceinline__ float suffix32(const f32x16& x, f32x16& aft, float base, int hi) {
    float c0[4], c1[4];
#pragma unroll
    for (int g = 0; g < 4; ++g) { const float c = (x[4 * g] + x[4 * g + 1]) + (x[4 * g + 2] + x[4 * g + 3]);
        auto rr = __builtin_amdgcn_permlane32_swap(__float_as_uint(c), __float_as_uint(c), false, false);
        c0[g] = __uint_as_float(rr[0]); c1[g] = __uint_as_float(rr[1]); }
    float s = base;
#pragma unroll
    for (int g = 3; g >= 0; --g) { const float sx1 = s; s += c1[g]; const float sx0 = s; s += c0[g];
        const float sx = hi ? sx1 : sx0;
        aft[4 * g + 3] = sx; aft[4 * g + 2] = aft[4 * g + 3] + x[4 * g + 3]; aft[4 * g + 1] = aft[4 * g + 2] + x[4 * g + 2]; aft[4 * g] = aft[4 * g + 1] + x[4 * g + 1]; }
    return s;
}

template <int MODE, int KVB>
__device__ __forceinline__ void attn_tile(f32x16* o, float& m_reg, float& l_reg, float& R, const bf16x8* qr, const LAS char* K_lds, int vb0, const LAS float* tab, LAS float* al_l,
                                          int kb, int qlo, int qm, int tl, int r32, int hi) {
    f32x16 p0, p1; bf16x8 pa0, pa1, pa2, pa3;
    if (MODE == 0) {
        const LAS float* tp = tab + (tl + kb);
#pragma unroll
        for (int r = 0; r < 16; ++r) { const int c = (r & 3) + 8 * (r >> 2); p0[r] = tp[c]; p1[r] = tp[c + 32]; }
    } else {
#pragma unroll
        for (int r = 0; r < 16; ++r) { p0[r] = 0.f; p1[r] = 0.f; }
    }
    qkt<KVB>(p0, p1, K_lds, r32, hi, qr);
    if (MODE == 0) {
        if (kb + KVBLK - 1 > qlo) mask_tile<false>(p0, p1, qm - kb);
        float mn, alpha;
        partialSM(p0, p1, m_reg, mn, alpha);
        if (__any(alpha < 1.f)) { if (hi == 0) al_l[r32] = alpha; LDS_WAIT();
#pragma unroll
            for (int d_ = 0; d_ < 4; ++d_)
#pragma unroll
                for (int r = 0; r < 16; ++r) o[d_][r] *= al_l[crow(r, hi)]; }
        finishSM(p0, p1, alpha, l_reg, pa0, pa1, pa2, pa3);
    } else {
        f32x16 x0, x1;
#pragma unroll
        for (int r = 0; r < 16; ++r) { const float y = p0[r] * C2; const float L = __builtin_amdgcn_logf(1.0f + __builtin_amdgcn_exp2f(-fabsf(y))); const float lb = fminf(y, 0.f) - L; p0[r] = lb; x0[r] = lb - y; }
#pragma unroll
        for (int r = 0; r < 16; ++r) { const float y = p1[r] * C2; const float L = __builtin_amdgcn_logf(1.0f + __builtin_amdgcn_exp2f(-fabsf(y))); const float lb = fminf(y, 0.f) - L; p1[r] = lb; x1[r] = lb - y; }
        if (kb + KVBLK - 1 >= qlo) {
            const int dq = qm - kb; const float NEG = -__builtin_inff();
#pragma unroll
            for (int r = 0; r < 16; ++r) { const int c = (r & 3) + 8 * (r >> 2);
                if (dq - c < 1) { p0[r] = NEG; x0[r] = 0.f; }
                if (dq - c - 32 < 1) { p1[r] = NEG; x1[r] = 0.f; } }
        }
        f32x16 a0, a1;
        const float s1 = suffix32(x1, a1, R, hi);
        const float s0 = suffix32(x0, a0, s1, hi);
        R = s0;
#pragma unroll
        for (int r = 0; r < 16; ++r) { p0[r] = __builtin_amdgcn_exp2f(p0[r] + a0[r]); p1[r] = __builtin_amdgcn_exp2f(p1[r] + a1[r]); }
        PK4(p0, 0, pa0); PK4(p0, 8, pa1); PK4(p1, 0, pa2); PK4(p1, 8, pa3);
    }
    SBAR();
    pv_tile<KVB>(o, vb0, pa0, pa1, pa2, pa3);
}
template <int MODE>
__device__ __forceinline__ void attn_block(const bf16* __restrict__ Qb, const bf16* __restrict__ Kh, const bf16* __restrict__ Vh, bf16* __restrict__ Ob, int P0, LAS char* lds, int toff_mul, int toff_add, float kmax, int kcov) {
    int tid = threadIdx.x; asm volatile("" : "+v"(tid));
    const int wid = __builtin_amdgcn_readfirstlane(tid >> 6), lane = tid & 63, r32 = lane & 31, hi = lane >> 5;
    LAS char* V_lds = lds + L_V; LAS char* K_lds = lds + L_K;
    LAS float* wsf = (LAS float*)(lds + L_WS) + wid * 64; LAS float* li_l = wsf; LAS float* al_l = wsf + 32;
    const LAS float* tab = (const LAS float*)(lds + L_TAB);
    volatile LAS unsigned* flags = (volatile LAS unsigned*)(lds + L_FLAG);
    bf16x8 qr[8];
    { const bf16* qrow = Qb + (size_t)(wid * QBLK + r32) * QPITCH + hi * 8;
#pragma unroll
      for (int d0 = 0; d0 < 8; ++d0) qr[d0] = *(const GAS bf16x8*)(qrow + d0 * 16); }
    const int qlo = P0 + wid * QBLK, qpos = qlo + r32, qm = qpos - 4 * hi;
    const int NT = P0 / KVBLK + 4;
    float qn = 0.f;
    if (MODE == 0) {
#pragma unroll
        for (int d0 = 0; d0 < 8; ++d0)
#pragma unroll
            for (int e = 0; e < 8; ++e) { const float qv = __uint_as_float(((unsigned)(unsigned short)qr[d0][e]) << 16); qn += qv * qv; }
        { auto rr = __builtin_amdgcn_permlane32_swap(__float_as_uint(qn), __float_as_uint(qn), false, false); qn = __uint_as_float(rr[0]) + __uint_as_float(rr[1]); }
        qn = sqrtf(qn) * 1.002f;
    }
    const int sr = tid >> 4, sc = (tid & 15) * 8;
    const int kws = KSWZ(sr, sc * 2), vst0 = v_st(sr, sc), vst1 = v_st(32 + sr, sc);
    const int vb0 = (int)(unsigned)(uintptr_t)V_lds + v_rd_base(lane);
    const int tl = toff_mul * qpos + toff_add + 4 * hi;
    float m_reg = -1e30f, l_reg = 0.f, R = 0.f;
    f32x16 o[4];
#pragma unroll
    for (int d = 0; d < 4; ++d)
#pragma unroll
        for (int r = 0; r < 16; ++r) o[d][r] = 0.f;
    bf16x8 sk0, sk1, sv0, sv1;
#define KB_OF(it_) ((NT - 1 - (it_)) * KVBLK)
#define ST_LOAD(kb_) do { const bf16* kp = Kh + (size_t)((kb_) + sr) * QPITCH + sc; const bf16* vp = Vh + (size_t)((kb_) + sr) * QPITCH + sc; \
        sk0 = *(const GAS bf16x8*)kp; sk1 = *(const GAS bf16x8*)(kp + (size_t)32 * QPITCH); sv0 = *(const GAS bf16x8*)vp; sv1 = *(const GAS bf16x8*)(vp + (size_t)32 * QPITCH); } while (0)
#define ST_WRITE(bf_) do { *(LAS bf16x8*)(K_lds + (bf_) * SHM_K + kws) = sk0; *(LAS bf16x8*)(K_lds + (bf_) * SHM_K + kws + 32 * 256) = sk1; \
        *(LAS bf16x8*)(V_lds + (bf_) * SHM_V + vst0) = sv0; *(LAS bf16x8*)(V_lds + (bf_) * SHM_V + vst1) = sv1; } while (0)
    __syncthreads();
    ST_LOAD(KB_OF(0)); ST_WRITE(0);
    if (tid < 16) flags[tid] = 0u;
    __syncthreads();
    bool stop = false, wdone = false;
#define STEP(it_, B_, NB_) { const int kb = KB_OF(it_); const bool more = (it_) + 1 < NT; \
        if (more) ST_LOAD(KB_OF((it_) + 1)); \
        if (kb <= qlo + QBLK - 1 && !wdone) attn_tile<MODE, B_>(o, m_reg, l_reg, R, qr, K_lds, vb0, tab, al_l, kb, qlo, qm, tl, r32, hi); \
        if (more) ST_WRITE(NB_); \
        if (MODE == 1) { wdone = (kb <= qlo + QBLK - 1) && __all(R <= -160.f); if (lane == 0) flags[((it_) & 1) * 8 + wid] = wdone ? 1u : 0u; } \
        if (MODE == 0) {   \
            wdone = (kmax > 0.f) && (kb <= qlo + QBLK - 1) && kb > 0 && kb <= kcov && __all((qn * kmax + tab[kb - 1] - m_reg) * C2 < -152.f); if (lane == 0) flags[((it_) & 1) * 8 + wid] = wdone ? 1u : 0u; } \
        __syncthreads(); \
        { unsigned a_ = 1u; _Pragma("unroll") for (int w_ = 0; w_ < 8; ++w_) a_ &= flags[((it_) & 1) * 8 + w_]; stop = (a_ != 0u); } }
    for (int it = 0; it < NT; it += 2) {
        STEP(it, 0, 1)
        if (stop) break;
        STEP(it + 1, 1, 0)
        if (stop) break;
    }
#undef STEP
#undef ST_LOAD
#undef ST_WRITE
#undef KB_OF
    float rli[16];
    if (MODE == 0) {
        if (hi == 0) li_l[r32] = l_reg; LDS_WAIT();
#pragma unroll
        for (int r = 0; r < 16; ++r) rli[r] = __builtin_amdgcn_rcpf(li_l[crow(r, hi)]);
    } else {
#pragma unroll
        for (int r = 0; r < 16; ++r) rli[r] = 1.f;
    }
    bf16* Ow = Ob + (size_t)(wid * QBLK) * OPITCH;
#pragma unroll
    for (int r = 0; r < 16; ++r) { const int orow = crow(r, hi);
#pragma unroll
        for (int d0 = 0; d0 < 4; ++d0) { const float v = o[d0][r] * rli[r];
            const float vn = __shfl_xor(v, 1);
            if ((r32 & 1) == 0) *(GAS unsigned*)(Ow + (size_t)orow * OPITCH + d0 * 32 + r32) = cvtpk(v, vn); } }
}
#undef PK4
}

__device__ __forceinline__ int t5_bucket(int d) {
    if (d < 16) return d;
    int b = 16;
    b += (d >= 22); b += (d >= 30); b += (d >= 40); b += (d >= 54); b += (d >= 73); b += (d >= 99); b += (d >= 134); b += (d >= 182);
    b += (d >= 246); b += (d >= 332); b += (d >= 450); b += (d >= 609); b += (d >= 825); b += (d >= 1117); b += (d >= 1513);
    return b;
}

struct Args {
    const float* x; const float* norm_g; const float* w_gate; const float* w_up; const float* w_down;
    const float* w_in[4]; const float* b_f0; const float* b_f3; const float* w_out; const float* rel_bias; const float* final_g;
    float* out; unsigned char* ws; int ph_lo, ph_hi;
};
static_assert(sizeof(Args) == 16 * 8 + 8, "Args has no padding");

__global__ void __launch_bounds__(NWAVES * 64, 2) mk_fwd(Args a) {
    extern __shared__ __attribute__((aligned(16))) unsigned char lds_raw[];
    LAS unsigned char* lds = (LAS unsigned char*)lds_raw;
    volatile LAS unsigned* MISC = (volatile LAS unsigned*)(lds + MISC_OFF);
    const int G = gridDim.x; const int bx = blockIdx.x; const int vcu = (G % 8 == 0) ? (bx % 8) * (G / 8) + bx / 8 : bx;
    unsigned char* ws = a.ws;
    gu32* ctl = (gu32*)(ws + WS_CTL);
    if (threadIdx.x < 64) MISC[threadIdx.x] = 0u;
    __syncthreads();
    const int lo = a.ph_lo, hi = a.ph_hi;
    const int grp = bx & 7, gidx = bx >> 3;
    XcdBarrier bar, barL; bar.bar = (unsigned*)(ctl + CW_BAR); bar.x = 0; bar.st = nullptr; bar.gsize = 0; barL = bar;
    if (hi - lo > 1) { bar = xcd_barrier_post((unsigned*)(ctl + CW_BAR), MISC + 8, (unsigned)G); barL = xcd_barrier_post((unsigned*)(ctl + CW_BAR) + (1 + grp) * XCD_BAR_WORDS, MISC + 10, (unsigned)(G / 8)); }
#define RUN(k) (lo <= (k) && (k) < hi)
#define SEAM(k) do { if (RUN(k) && RUN((k) + 1)) { if ((k) == 0) xcd_barrier(bar); else xcd_barrier(barL); if (PROBE_DUP == 9) xcd_barrier(barL); } } while (0)

    bf16* const Hb = (bf16*)(ws + WS_H); bf16* const AO = (bf16*)(ws + WS_AO);
    bf16* const ACT = (bf16*)(ws + WS_ACT + (size_t)(bx & 7) * ((size_t)SEQ * (NQKV - FF) * 2)); bf16* const QKV = (bf16*)(ws + WS_ACT);
    float* const LF = (float*)(ws + WS_LF);
    const int NGW = G * NWAVES;
    int ph = 0;
#define LANE_IDS() const int tid = opaque_tid(), lane = tid & 63, wave = __builtin_amdgcn_readfirstlane(tid >> 6), gw = vcu * NWAVES + wave; (void)lane; (void)gw

    constexpr int I_G = (DM / 64) * (FF / 64), I_D = (FF / 64) * (DM / 64), I_Q = (DM / 64) * (NQKV / 64), I_O = (DM / 64) * (DM / 64);
    constexpr int PER_LAYER = 6 * I_G + I_Q + I_O;
    static_assert(I_G == I_D && PER_LAYER % 8 == 0 && I_G % 8 == 0 && I_Q % 8 == 0 && I_O % 8 == 0, "items");
    auto conv_item = [&](int it, LAS float* scr, int lane) __attribute__((always_inline)) {
            const int l = it / PER_LAYER; int r = it - l * PER_LAYER;
            if (r < 6 * I_G) {
                const int mm = r / I_G, idx = r - mm * I_G, kind = mm >> 1, f = mm & 1;
                if (kind < 2) {
                    const float* W = (kind == 0 ? a.w_gate : a.w_up) + (size_t)(l * 2 + f) * DM * FF;
                    const int nblk = FF / 64, kb = idx / nblk, nb = idx - kb * nblk, n0 = nb * 64;
                    transpose_item(W, FF, DM, (bf16*)(ws + WS_WGU + (size_t)(l * 2 + f) * SZ_WGU), kb * 64, n0, (n0 >> 7) * 256 + (n0 & 127) + kind * 128, a.norm_g + (size_t)(l * 3 + 2 * f) * DM, scr, lane);
                } else {
                    const float* W = a.w_down + (size_t)(l * 2 + f) * FF * DM;
                    const int nblk = DM / 64, kb = idx / nblk, nb = idx - kb * nblk;
                    transpose_item(W, DM, FF, (bf16*)(ws + WS_WD + (size_t)(l * 2 + f) * SZ_WD), kb * 64, nb * 64, nb * 64, nullptr, scr, lane);
                }
            } else { r -= 6 * I_G;
                if (r < I_Q) {
                    const float* W = a.w_in[l]; const int ldw = (l == 0 || l == 3) ? NQKV + NH : NQKV;
                    const int nblk = NQKV / 64, kb = r / nblk, nb = r - kb * nblk;
                    transpose_item(W, ldw, DM, (bf16*)(ws + WS_WQKV + (size_t)l * SZ_WQKV), kb * 64, nb * 64, nb * 64, a.norm_g + (size_t)(l * 3 + 1) * DM, scr, lane);
                } else { r -= I_Q;
                    const float* W = a.w_out + (size_t)l * DM * DM;
                    const int nblk = DM / 64, kb = r / nblk, nb = r - kb * nblk;
                    transpose_item(W, DM, DM, (bf16*)(ws + WS_WO + (size_t)l * SZ_WO), kb * 64, nb * 64, nb * 64, nullptr, scr, lane);
                }
            }
    };
    const int n_static = (hi - lo > 1) ? (DEPTH - 2) * PER_LAYER : DEPTH * PER_LAYER;
    if (RUN(ph)) REP(1) {
        LANE_IDS();
        LAS float* scr = (LAS float*)(lds + wave * 16640);
        for (int it = gw; it < n_static; it += NGW) conv_item(it, scr, lane);
    }
    if (RUN(ph)) REP(1) {
        LANE_IDS();
        for (int idx = bx * (NWAVES * 64) + tid; idx < 2 * 16 * DM; idx += G * NWAVES * 64) {
            const int sl = idx >> 15, n = (idx >> 11) & 15, k = idx & (DM - 1), l = sl ? 3 : 0;
            const float w = a.w_in[l][(size_t)k * (NQKV + NH) + NQKV + n] * a.norm_g[(size_t)(l * 3 + 1) * DM + k];
            ((bf16*)(ws + WS_WF))[idx] = (bf16)(cvtpk(w, 0.f) & 0xffffu);
        }
        float* const part = (float*)(ws + WS_PART);
        for (int m = gw; m < M; m += NGW) {
            const GAS f32x4* xr = (const GAS f32x4*)(a.x + (size_t)m * DM) + lane;
            f32x4 v[8]; float ss = 0.f;
#pragma unroll
            for (int j = 0; j < 8; ++j) { v[j] = xr[64 * j]; ss += (v[j].x * v[j].x + v[j].y * v[j].y) + (v[j].z * v[j].z + v[j].w * v[j].w); }
            ss = wave_sum(ss);
            GAS v2u* o8 = (GAS v2u*)(Hb + (size_t)m * DM) + lane;
#pragma unroll
            for (int j = 0; j < 8; ++j) { v2u w; w.x = cvtpk(v[j].x, v[j].y); w.y = cvtpk(v[j].z, v[j].w); o8[64 * j] = w; }
            if (lane < 32) part[(size_t)m * 32 + lane] = (lane == 0) ? ss : 0.f;
        }
    }
    SEAM(ph); ++ph;

    for (int sb = 0; sb < 3 * DEPTH; ++sb) {
        const int l = sb / 3, ty = sb - 3 * l;
        if (hi - lo > 1 && (sb == 3 * (DEPTH - 2) || sb == 3 * (DEPTH - 1) || sb == 3 * DEPTH - 1)) {
            LANE_IDS();
            LAS float* scr = (LAS float*)(lds + wave * 16640);
            volatile LAS unsigned* qslot = MISC + 16;
            const int qB = (sb == 3 * DEPTH - 1) ? 1 : 0, qL2 = (sb == 3 * (DEPTH - 2)) ? 1 : 0;
            const unsigned qn = qL2 ? (unsigned)PER_LAYER : (qB ? 3u * I_G : 3u * I_G + I_Q + I_O);
            unsigned* qctr = (unsigned*)ctl + CW_Q + (qL2 ? 2 : qB) * 128; unsigned* dctr = qctr + 64;
            unsigned mine = 0u;
            for (;;) {
                __syncthreads();
                if (tid == 0) *qslot = xb_add(qctr, 8u);
                __syncthreads();
                const unsigned base = *qslot;
                if (base >= qn) break;
                const unsigned q = base + (unsigned)wave, seg = q / (unsigned)I_G;
                const unsigned r = qB ? (2u * seg + 1u) * I_G + (q - seg * I_G) : (seg < 3u ? 2u * seg * I_G + (q - seg * I_G) : 6u * I_G + (q - 3u * I_G));
                conv_item(qL2 ? (DEPTH - 2) * PER_LAYER + (int)q : (DEPTH - 1) * PER_LAYER + (int)r, scr, lane);
                mine += 8u;
            }
            asm volatile("s_waitcnt vmcnt(0)" ::: "memory");
            __syncthreads();
            if (tid == 0) {
                if (mine) { __builtin_amdgcn_fence(__ATOMIC_RELEASE, "agent"); asm volatile("s_waitcnt vmcnt(0)" ::: "memory"); (void)xb_add(dctr, mine); }
                XB_SPIN(xb_ld(dctr) < qn, (unsigned*)(ctl + CW_BAR));
                __builtin_amdgcn_fence(__ATOMIC_ACQUIRE, "agent");
                asm volatile("s_waitcnt vmcnt(0)" ::: "memory");
            }
            __syncthreads();
        }
        const float* xsrc = (sb == 0) ? a.x : (const float*)a.out;
        if (ty != 1) {
            const int f = ty >> 1;
            if (PROBE_DUP == 10 && RUN(ph)) {
                pg8::Gemm g{Hb, (const bf16*)(ws + WS_WGU + (size_t)(l * 2 + f) * SZ_WGU), M, NGU, DM}; pg8::StaticOrder S; S.init(M, NGU, G, bx);
                pg8::Unit u0; S.next(0, u0); pg8::build_rstd_table((LAS float*)(lds + RST_OFF), (const float*)(ws + WS_PART), u0.pm, opaque_tid());
                pg8::EpiSwiGLULocal E{pg8::EpiSwiGLU{(bf16*)(ws + WS_END) + (size_t)bx * 256 * 128, 128, (const float*)(ws + WS_PART), (const LAS float*)(lds + RST_OFF), 0}};
                pg8::gemm_phase<pg8::EpiSwiGLULocal, pg8::StaticOrder, true, true>(lds + RING_OFF, g, S, E);
            }
            if (PROBE_DUP == 8 && RUN(ph)) {
                pg8::Gemm g{Hb, (const bf16*)(ws + WS_WGU + (size_t)(l * 2 + f) * SZ_WGU), M, NGU, DM};
#if PROBE_KL == 3
                pg8::ProbeOrder S; S.init(M, NGU, G, bx);
                pg8::EpiNull E{(float*)(ws + WS_END)};
                pg8::gemm_phase<pg8::EpiNull, pg8::ProbeOrder, true, true>(lds + RING_OFF, g, S, E);
#else
                pg8::StaticOrder S; S.init(M, NGU, G, bx);
                pg8::EpiNull E{(float*)(ws + WS_END)};
                pg8::gemm_phase<pg8::EpiNull, pg8::StaticOrder, true, true>(lds + RING_OFF, g, S, E);
#endif
            }
            if (RUN(ph)) REP(3) {
                pg8::Gemm g{Hb, (const bf16*)(ws + WS_WGU + (size_t)(l * 2 + f) * SZ_WGU), M, NGU, DM}; pg8::StaticOrder S; S.init(M, NGU, G, bx);
                pg8::Unit u0; S.next(0, u0); pg8::build_rstd_table((LAS float*)(lds + RST_OFF), (const float*)(ws + WS_PART), u0.pm, opaque_tid());
                pg8::EpiSwiGLU E{ACT, FF, (const float*)(ws + WS_PART), (const LAS float*)(lds + RST_OFF), u0.pm};
                pg8::gemm_phase<pg8::EpiSwiGLU, pg8::StaticOrder, true, true>(lds + RING_OFF, g, S, E);
            }
            SEAM(ph); ++ph;
            if (RUN(ph)) REP(6) {
                pg8::Gemm g{ACT, (const bf16*)(ws + WS_WD + (size_t)(l * 2 + f) * SZ_WD), M, DM, FF}; pg8::StaticOrder S; S.init(M, DM, G, bx);
#if RESID_BF16
                pg8::EpiResidB E{(PROBE_DUP == 6 && rep_ == 0) ? (bf16*)(ws + WS_END) : Hb, (float*)(ws + WS_PART), DM, 0.5f};
                pg8::gemm_phase<pg8::EpiResidB, pg8::StaticOrder, true, true>(lds + RING_OFF, g, S, E);
#else
                pg8::EpiResid E{xsrc, (PROBE_DUP == 6 && rep_ == 0) ? (float*)(ws + WS_END) : a.out, Hb, (float*)(ws + WS_PART), DM, 0.5f};
                pg8::gemm_phase<pg8::EpiResid, pg8::StaticOrder, true, true>(lds + RING_OFF, g, S, E);
#endif
            }
            SEAM(ph); ++ph;
        } else {
            if (RUN(ph) && (l == 0 || l == 3)) {
                LANE_IDS();
                const int fr = lane & 15, fq = lane >> 4;
                const bf16* wf = (const bf16*)(ws + WS_WF) + (size_t)(l ? 1 : 0) * 16 * DM + (size_t)fr * DM + 8 * fq;
                const float* bfp = (l == 0) ? a.b_f0 : a.b_f3;
                for (int rgl = gidx * NWAVES + wave; rgl < SEQ / 16; rgl += (G / 8) * NWAVES) { const int rg = grp * (SEQ / 16) + rgl;
                    const bf16* ap = Hb + (size_t)(rg * 16 + fr) * DM + 8 * fq;
                    f32x4 acc = {0.f, 0.f, 0.f, 0.f};
#pragma unroll 8
                    for (int k0 = 0; k0 < DM; k0 += 32) { const bf16x8 av = *(const GAS bf16x8*)(ap + k0), bv = *(const GAS bf16x8*)(wf + k0);
                        acc = __builtin_amdgcn_mfma_f32_16x16x32_bf16(bv, av, acc, 0, 0, 0); }
                    const float r = pg8::row_rstd((const float*)(ws + WS_PART), rg * 16 + fr, fq);
                    const f32x4 bb = *(const GAS f32x4*)(bfp + 4 * fq);
                    f32x4 o;
#pragma unroll
                    for (int i = 0; i < 4; ++i) { const float z = acc[i] * r + bb[i]; o[i] = fminf(z, 0.f) - __logf(1.0f + __expf(-fabsf(z))); }
                    *(GAS f32x4*)(LF + (size_t)(rg * 16 + fr) * 16 + 4 * fq) = o;
                }
            }
            if (RUN(ph)) _Pragma("unroll 1") for (int rep_ = 0; rep_ < ((PROBE_DUP == 4 || PROBE_DUP == 13) ? 2 : 1); ++rep_) {
                pg8::Gemm g{Hb, (const bf16*)(ws + WS_WQKV + (size_t)l * SZ_WQKV), M, NQKV, DM}; pg8::StaticOrder S; S.init(M, NQKV, G, bx);
                pg8::Unit u0; S.next(0, u0); pg8::build_rstd_table((LAS float*)(lds + RST_OFF), (const float*)(ws + WS_PART), u0.pm, opaque_tid());
                pg8::EpiBf16 E{(PROBE_DUP == 13 && rep_ == 0) ? (bf16*)(ws + WS_END) + (size_t)bx * 256 * 256 : QKV, (PROBE_DUP == 13 && rep_ == 0) ? 256 : NQKV, (const float*)(ws + WS_PART), (const LAS float*)(lds + RST_OFF), u0.pm, (PROBE_DUP == 13 && rep_ == 0) ? 1 : 0, (l % 3 == 0) ? (unsigned*)ws + CW_KMAX + (l ? 512 : 0) : nullptr};
                pg8::gemm_phase<pg8::EpiBf16, pg8::StaticOrder, true, true>(lds + RING_OFF, g, S, E);
            }
            SEAM(ph); ++ph;
            if (RUN(ph)) REP(5) {
                LANE_IDS();
                const int mixer = l % 3;
                LAS char* al = (LAS char*)(lds + RING_OFF);
                LAS float* tab = (LAS float*)(al + att::L_TAB);
                LAS float* scan = (LAS float*)(al + att::L_SCAN);
                for (int j = gidx; j < NH * 4; j += G / 8) {
                    const int b = grp, h = j >> 2, xq = (j & 32) ? 3 - (j & 3) : (j & 3);
                    const bf16* Qh = QKV + (size_t)b * SEQ * NQKV + h * HD; const bf16* Kh = Qh + DM; const bf16* Vh = Qh + 2 * DM;
                    bf16* Oh = AO + (size_t)b * SEQ * DM + h * HD;
                    __syncthreads();
                    int tmul = 0, tadd = 0;
                    const int kcov = SEQ;
                    if (mixer == 0) {
                        const float* lf = LF + (size_t)b * SEQ * 16 + h;
                        const float v0 = lf[(size_t)(4 * tid) * 16], v1 = lf[(size_t)(4 * tid + 1) * 16], v2 = lf[(size_t)(4 * tid + 2) * 16], v3 = lf[(size_t)(4 * tid + 3) * 16];
                        const float a0 = v0, a1 = a0 + v1, a2 = a1 + v2, a3 = a2 + v3;
                        float inc = a3;
#pragma unroll
                        for (int d = 1; d < 64; d <<= 1) { const float y = __shfl_up(inc, d); if (lane >= d) inc += y; }
                        if (lane == 63) scan[wave] = inc;
                        __syncthreads();
                        float pre = inc - a3;
                        for (int w = 0; w < wave; ++w) pre += scan[w];
                        const float ns = -11.313708498984761f;
                        tab[4 * tid] = (pre + a0) * ns; tab[4 * tid + 1] = (pre + a1) * ns; tab[4 * tid + 2] = (pre + a2) * ns; tab[4 * tid + 3] = (pre + a3) * ns;
                    } else if (mixer == 1) {
                        const float* rb = a.rel_bias + h * 32;
                        for (int j = tid; j < att::TAB_N; j += NWAVES * 64) {
                            const int d = 2047 - j; float v = 0.f;
                            if (d >= 0) { const int mult = (d <= 128 ? 1 : 0) + (((d & 3) == 0 && d <= 512) ? 1 : 0) + (((d & 15) == 0) ? 1 : 0);
                                v = (mult == 0) ? -__builtin_inff() : (rb[t5_bucket(d)] + (mult == 1 ? 0.f : (mult == 2 ? 0.6931471805599453f : 1.0986122886681098f))) * 11.313708498984761f; }
                            tab[j] = v; }
                        tmul = -1; tadd = 2047;
                    }
                    float kmaxh = 0.f;
                    if (mixer == 0) {
                        unsigned* kp = (unsigned*)ws + CW_KMAX + (l ? 512 : 0) + (b * 16 + h) * 4; float k2m = 0.f;
#pragma unroll
                        for (int w = 0; w < 4; ++w) k2m += __uint_as_float(__hip_atomic_load(kp + w, __ATOMIC_RELAXED, __HIP_MEMORY_SCOPE_AGENT));
                        kmaxh = sqrtf(k2m) * 1.002f; }
#pragma unroll 1
                    for (int pass = 0; pass < 2; ++pass) {
                        const int qb = pass ? 7 - xq : xq, P0 = qb * att::QB;
                        if (mixer == 2) att::attn_block<1>(Qh + (size_t)P0 * NQKV, Kh, Vh, Oh + (size_t)P0 * DM, P0, al, 0, 0, 0.f, 0);
                        else att::attn_block<0>(Qh + (size_t)P0 * NQKV, Kh, Vh, Oh + (size_t)P0 * DM, P0, al, tmul, tadd, kmaxh, kcov);
                    }
                }
            }
            SEAM(ph); ++ph;
            if (RUN(ph)) REP(7) {
                pg8::Gemm g{AO, (const bf16*)(ws + WS_WO + (size_t)l * SZ_WO), M, DM, DM}; pg8::StaticOrder S; S.init(M, DM, G, bx);
#if RESID_BF16
                pg8::EpiResidB E{(PROBE_DUP == 7 && rep_ == 0) ? (bf16*)(ws + WS_ACT) : Hb, (float*)(ws + WS_PART), DM, 1.0f};
                pg8::gemm_phase<pg8::EpiResidB, pg8::StaticOrder, true, true>(lds + RING_OFF, g, S, E);
#else
                pg8::EpiResid E{a.out, (PROBE_DUP == 7 && rep_ == 0) ? (float*)(ws + WS_ACT) : a.out, Hb, (float*)(ws + WS_PART), DM, 1.0f};
                pg8::gemm_phase<pg8::EpiResid, pg8::StaticOrder, true, true>(lds + RING_OFF, g, S, E);
#endif
            }
            SEAM(ph); ++ph;
        }
    }
    if (RUN(ph)) {
        LANE_IDS();
        f32x4 gv[8];
#pragma unroll
        for (int j = 0; j < 8; ++j) gv[j] = *((const GAS f32x4*)a.final_g + lane + 64 * j);
        for (int ml = gidx * NWAVES + wave; ml < SEQ; ml += (G / 8) * NWAVES) { const int m = grp * SEQ + ml;
            GAS f32x4* xr = (GAS f32x4*)(a.out + (size_t)m * DM) + lane;
            f32x4 v[8]; float ss = 0.f;
#pragma unroll
            for (int j = 0; j < 8; ++j) {
#if RESID_BF16
                const v2u w = *((const GAS v2u*)(Hb + (size_t)m * DM) + lane + 64 * j);
                v[j] = (f32x4){__uint_as_float(w.x << 16), __uint_as_float(w.x & 0xffff0000u), __uint_as_float(w.y << 16), __uint_as_float(w.y & 0xffff0000u)};
#else
                v[j] = xr[64 * j];
#endif
                ss += (v[j].x * v[j].x + v[j].y * v[j].y) + (v[j].z * v[j].z + v[j].w * v[j].w); }
            const float rstd = 1.0f / sqrtf(wave_sum(ss) * (1.0f / DM) + RMS_EPS);
#pragma unroll
            for (int j = 0; j < 8; ++j) xr[64 * j] = v[j] * rstd * gv[j];
        }
    }
#undef RUN
#undef SEAM
}
constexpr int N_PHASES = 1 + DEPTH * 7 + 1;

extern "C" void kernel_launch(void* const* d_in, const int* in_sizes, int n_in, void* d_out, int out_size, void* d_ws, size_t ws_size, hipStream_t stream) {
    static int grid = 0;
    if (grid == 0) {
        if (n_in != 14 || in_sizes[0] != M * DM || out_size != M * DM || ws_size < WS_END + (PROBE_DUP == 6 ? (size_t)M * DM * 4 : 0) + (PROBE_DUP == 8 ? 4096 : 0) + (PROBE_DUP == 10 ? (size_t)256 * 65536 : 0) + ((PROBE_DUP == 13) ? (size_t)256 * 131072 : 0)) {
            fprintf(stderr, "kernel_launch: unexpected shapes (n_in %d, in0 %d, out %d, ws %zu < %zu?); nothing launched\n", n_in, n_in > 0 ? in_sizes[0] : -1, out_size, ws_size, (size_t)WS_END); grid = -1; return; }
        int dev = 0, cus = 0;
        if (hipGetDevice(&dev) != hipSuccess || hipDeviceGetAttribute(&cus, hipDeviceAttributeMultiprocessorCount, dev) != hipSuccess) { grid = -1; return; }
        if (hipFuncSetAttribute((const void*)mk_fwd, hipFuncAttributeMaxDynamicSharedMemorySize, LDS_BYTES) != hipSuccess) { fprintf(stderr, "kernel_launch: hipFuncSetAttribute failed\n"); grid = -1; return; }
        int per_cu = 0;
        if (hipOccupancyMaxActiveBlocksPerMultiprocessor(&per_cu, (const void*)mk_fwd, NWAVES * 64, LDS_BYTES) != hipSuccess || per_cu < 1)
            fprintf(stderr, "kernel_launch: note: occupancy query reports %d workgroups per CU\n", per_cu);
        (void)hipGetLastError();
        grid = cus;
        if (grid != 256) { fprintf(stderr, "kernel_launch: built for a 256-CU device (8 groups of 32 workgroups own the 8 batch elements); found %d CUs; nothing launched\n", grid); grid = -1; return; }
    }
    if (grid < 0) return;
    if (hipMemsetAsync((char*)d_ws + WS_CTL, 0, CTL_ZERO_BYTES, stream) != hipSuccess) return;
    Args a{};
    a.x = (const float*)d_in[0]; a.norm_g = (const float*)d_in[1]; a.w_gate = (const float*)d_in[2]; a.w_up = (const float*)d_in[3]; a.w_down = (const float*)d_in[4];
    a.w_in[0] = (const float*)d_in[5]; a.b_f0 = (const float*)d_in[6]; a.w_in[1] = (const float*)d_in[7]; a.w_in[2] = (const float*)d_in[8]; a.w_in[3] = (const float*)d_in[9];
    a.b_f3 = (const float*)d_in[10]; a.w_out = (const float*)d_in[11]; a.rel_bias = (const float*)d_in[12]; a.final_g = (const float*)d_in[13];
    a.out = (float*)d_out; a.ws = (unsigned char*)d_ws;
#if MK_ONE_LAUNCH
    a.ph_lo = 0; a.ph_hi = N_PHASES;
    hipLaunchKernelGGL(mk_fwd, dim3(grid), dim3(NWAVES * 64), LDS_BYTES, stream, a);
#else
    for (int p = 0; p < N_PHASES; ++p) { a.ph_lo = p; a.ph_hi = p + 1; hipLaunchKernelGGL(mk_fwd, dim3(grid), dim3(NWAVES * 64), LDS_BYTES, stream, a); }
#endif
    const hipError_t le = hipPeekAtLastError();
    if (le != hipSuccess) fprintf(stderr, "kernel_launch: launch failed: %s\n", hipGetErrorName(le));
}
```

```cpp
#include <hip/hip_runtime.h>
#include <cstdio>
#include <cstdint>

#ifndef PROBE_DUP
#define PROBE_DUP 0
#endif
#define REP(k) _Pragma("unroll 1") for (int rep_ = 0; rep_ < ((PROBE_DUP == (k)) ? 2 : 1); ++rep_)
#ifndef PROBE_KL
#define PROBE_KL 0
#endif
#ifndef EPI_RELAX
#define EPI_RELAX 0
#endif
#ifndef RESID_BF16
#define RESID_BF16 1
#endif
#ifndef MK_ONE_LAUNCH
#define MK_ONE_LAUNCH 1
#endif

namespace pg8 {
#define PG8_LAS __attribute__((address_space(3)))
typedef unsigned short bf16_t;
typedef short bf16x8 __attribute__((ext_vector_type(8)));
typedef float f32x4 __attribute__((ext_vector_type(4)));
typedef unsigned u32x4 __attribute__((ext_vector_type(4)));
constexpr int BM = 256, BK = 64, HALF = 128, HTB = HALF * BK * 2, STAGE_BYTES = 8 * HTB, NXCD = 8, WGM = 8;

__host__ __device__ __forceinline__ int lds_byte(int r, int c) { const int st = (r >> 4) * 2 + (c >> 5), rr = r & 15, cc = c & 31, ob = rr * 64 + cc * 2; return st * 1024 + (ob ^ (((ob >> 9) & 1) << 5)); }
__host__ __device__ __forceinline__ void stage_rc(int b, int& R, int& C) { const int st = b / 1024, sb = b % 1024, swz = sb ^ (((sb >> 9) & 1) << 5); R = (st >> 1) * 16 + swz / 64; C = (st & 1) * 32 + (swz % 64) / 2; }
__host__ __device__ __forceinline__ int perm32(int rho) { const int n = rho >> 4, i = rho & 15; return 8 * (i >> 2) + 4 * n + (i & 3); }

typedef __bf16 bf16x2e __attribute__((ext_vector_type(2)));
struct Unit { int pm, pn; };
struct Gemm { const bf16_t* A; const bf16_t* Bt; int M, N, K; };

struct StaticOrder {
    int nM, nN, nwg, G, c;
    __host__ __device__ void init(int M, int N, int G_, int c_) { nM = M / BM; nN = N / BM; nwg = nM * nN; G = G_; c = c_; }
    __host__ __device__ __forceinline__ bool next(int i, Unit& u) const {
        const long L = (long)i * G + c; if (L >= nwg) return false;
        int wgid = (int)L; { const int q = nwg / NXCD, r = nwg % NXCD, xcd = wgid % NXCD, off = wgid / NXCD; wgid = (xcd < r ? xcd * (q + 1) : r * (q + 1) + (xcd - r) * q) + off; }
        const int nig = WGM * nN, gid = wgid / nig, fm = gid * WGM, gsz = (nM - fm) < WGM ? (nM - fm) : WGM;
        u.pm = fm + ((wgid % nig) % gsz); u.pn = (wgid % nig) / gsz; return true;
    }
    __device__ __forceinline__ void a_ready(const Unit&) const {}
    __device__ __forceinline__ void done(const Unit&) const {}
};

__device__ __forceinline__ unsigned cvt_pk_bf16(float lo, float hi) { unsigned r; asm volatile("v_cvt_pk_bf16_f32 %0, %1, %2" : "=v"(r) : "v"(lo), "v"(hi)); return r; }

__device__ __forceinline__ float fq_sum(float s) {
    { auto rr = __builtin_amdgcn_permlane16_swap(__float_as_uint(s), __float_as_uint(s), false, false); s = __uint_as_float(rr[0]) + __uint_as_float(rr[1]); }
    { auto rr = __builtin_amdgcn_permlane32_swap(__float_as_uint(s), __float_as_uint(s), false, false); s = __uint_as_float(rr[0]) + __uint_as_float(rr[1]); }
    return s;
}
__device__ __forceinline__ float row_rstd(const float* part, int row, int fq) {
    const f32x4 a = *(const f32x4*)(part + (size_t)row * 32 + fq * 8), b = *(const f32x4*)(part + (size_t)row * 32 + fq * 8 + 4);
    const float s = fq_sum(((a[0] + a[1]) + (a[2] + a[3])) + ((b[0] + b[1]) + (b[2] + b[3])));
    return __builtin_amdgcn_rsqf(s * (1.0f / 2048.0f) + 1e-6f);
}
__device__ __forceinline__ void build_rstd_table(PG8_LAS float* rst, const float* part, int pm0, int tid) {
    if (tid < 256) { const f32x4* p = (const f32x4*)(part + (size_t)(pm0 * BM + tid) * 32); float s = 0.f;
#pragma unroll
        for (int j = 0; j < 8; ++j) { const f32x4 v = p[j]; s += (v[0] + v[1]) + (v[2] + v[3]); }
        rst[tid] = __builtin_amdgcn_rsqf(s * (1.0f / 2048.0f) + 1e-6f); }
    __syncthreads();
}
struct EpiBf16 {
    static constexpr bool PERM = true, AFTER_DRAIN = false; static constexpr int KL = 0; static constexpr int NVM = 16;
    bf16_t* O; int ldc; const float* part; const PG8_LAS float* rst; int pm0; int local;
    unsigned* kmaxp;
    __device__ __forceinline__ void operator()(const f32x4 (&acc)[2][2][4][2], const Unit& u, int wr, int wc, int fr, int fq) const {
        const int row0 = (local ? 0 : u.pm * BM) + wr * 64 + fr, col0 = (local ? 0 : u.pn * BM) + wc * 32 + 8 * fq;
        const bool kn = (kmaxp != nullptr) && u.pn >= 8 && u.pn < 16;
        float km0 = 0.f, km1 = 0.f;
        float rs[2][4];
        if (u.pm == pm0) {
#pragma unroll
            for (int ai = 0; ai < 2; ++ai)
#pragma unroll
                for (int m = 0; m < 4; ++m) rs[ai][m] = rst[wr * 64 + fr + ai * HALF + m * 16];
        } else {
#pragma unroll
            for (int ai = 0; ai < 2; ++ai)
#pragma unroll
                for (int m = 0; m < 4; ++m) rs[ai][m] = row_rstd(part, row0 + ai * HALF + m * 16, fq);
        }
#pragma unroll
        for (int ai = 0; ai < 2; ++ai)
#pragma unroll
            for (int m = 0; m < 4; ++m) { bf16_t* rowp = O + (size_t)(row0 + ai * HALF + m * 16) * ldc + col0; const float r = rs[ai][m];
#pragma unroll
                for (int bj = 0; bj < 2; ++bj) { const f32x4 v0 = acc[ai][bj][m][0] * r, v1 = acc[ai][bj][m][1] * r;
                    u32x4 w; w.x = cvt_pk_bf16(v0[0], v0[1]); w.y = cvt_pk_bf16(v0[2], v0[3]); w.z = cvt_pk_bf16(v1[0], v1[1]); w.w = cvt_pk_bf16(v1[2], v1[3]);
                    *(u32x4*)(rowp + bj * HALF) = w;
                    if (kn) { float q = __builtin_amdgcn_fdot2_f32_bf16(__builtin_bit_cast(bf16x2e, w.x), __builtin_bit_cast(bf16x2e, w.x), 0.f, false);
                        q = __builtin_amdgcn_fdot2_f32_bf16(__builtin_bit_cast(bf16x2e, w.y), __builtin_bit_cast(bf16x2e, w.y), q, false);
                        q = __builtin_amdgcn_fdot2_f32_bf16(__builtin_bit_cast(bf16x2e, w.z), __builtin_bit_cast(bf16x2e, w.z), q, false);
                        q = __builtin_amdgcn_fdot2_f32_bf16(__builtin_bit_cast(bf16x2e, w.w), __builtin_bit_cast(bf16x2e, w.w), q, false);
                        q = fq_sum(q); if (bj == 0) km0 = fmaxf(km0, q); else km1 = fmaxf(km1, q); } } }
        if (kn) {
#pragma unroll
            for (int d = 1; d < 16; d <<= 1) { km0 = fmaxf(km0, __shfl_xor(km0, d)); km1 = fmaxf(km1, __shfl_xor(km1, d)); }
            if ((fr | fq) == 0) { unsigned* kp = kmaxp + (((u.pm >> 3) * 16 + 2 * (u.pn - 8)) * 4 + wc);
                (void)__hip_atomic_fetch_max(kp, __float_as_uint(km0), __ATOMIC_RELAXED, __HIP_MEMORY_SCOPE_AGENT);
                (void)__hip_atomic_fetch_max(kp + 4, __float_as_uint(km1), __ATOMIC_RELAXED, __HIP_MEMORY_SCOPE_AGENT); }
        }
    }
};
typedef float f32x2 __attribute__((ext_vector_type(2)));
__device__ __forceinline__ f32x2 silu_mul2(f32x2 g, f32x2 u, float nrl  , float r2  ) {
    const f32x2 a = g * nrl; f32x2 e; e.x = __builtin_amdgcn_exp2f(a.x); e.y = __builtin_amdgcn_exp2f(a.y);
    const f32x2 d = e + 1.0f; f32x2 s; s.x = __builtin_amdgcn_rcpf(d.x); s.y = __builtin_amdgcn_rcpf(d.y);
    return (g * u) * (s * r2);
}
struct EpiSwiGLU {
    static constexpr bool PERM = true, AFTER_DRAIN = false; static constexpr int KL = 0; static constexpr int NVM = 8;
    bf16_t* O; int ldc; const float* part; const PG8_LAS float* rst; int pm0;
    __device__ __forceinline__ void operator()(const f32x4 (&acc)[2][2][4][2], const Unit& u, int wr, int wc, int fr, int fq) const {
        const int row0 = u.pm * BM + wr * 64 + fr, col0 = u.pn * HALF + wc * 32 + 8 * fq;
        float rs[2][4];
        if (u.pm == pm0) {
#pragma unroll
            for (int ai = 0; ai < 2; ++ai)
#pragma unroll
                for (int m = 0; m < 4; ++m) rs[ai][m] = rst[wr * 64 + fr + ai * HALF + m * 16];
        } else {
#pragma unroll
            for (int ai = 0; ai < 2; ++ai)
#pragma unroll
                for (int m = 0; m < 4; ++m) rs[ai][m] = row_rstd(part, row0 + ai * HALF + m * 16, fq);
        }
#pragma unroll
        for (int ai = 0; ai < 2; ++ai)
#pragma unroll
            for (int m = 0; m < 4; ++m) { bf16_t* rowp = O + (size_t)(row0 + ai * HALF + m * 16) * ldc + col0; const float r = rs[ai][m], nrl = r * -1.4426950408889634f, r2 = r * r;
                const f32x4 g0 = acc[ai][0][m][0], g1 = acc[ai][0][m][1], u0 = acc[ai][1][m][0], u1 = acc[ai][1][m][1];
                const f32x2 a = silu_mul2((f32x2){g0[0], g0[1]}, (f32x2){u0[0], u0[1]}, nrl, r2), b = silu_mul2((f32x2){g0[2], g0[3]}, (f32x2){u0[2], u0[3]}, nrl, r2);
                const f32x2 c = silu_mul2((f32x2){g1[0], g1[1]}, (f32x2){u1[0], u1[1]}, nrl, r2), d = silu_mul2((f32x2){g1[2], g1[3]}, (f32x2){u1[2], u1[3]}, nrl, r2);
                u32x4 w; w.x = cvt_pk_bf16(a.x, a.y); w.y = cvt_pk_bf16(b.x, b.y); w.z = cvt_pk_bf16(c.x, c.y); w.w = cvt_pk_bf16(d.x, d.y);
                *(u32x4*)rowp = w; }
    }
};
struct EpiResid {
    static constexpr bool PERM = true, AFTER_DRAIN = false; static constexpr int KL = 0; static constexpr int NVM = 32;
    const float* base; float* out; bf16_t* xb; float* part; int ldc; float alpha;
    __device__ __forceinline__ void operator()(const f32x4 (&acc)[2][2][4][2], const Unit& u, int wr, int wc, int fr, int fq) const {
        const int row0 = u.pm * BM + wr * 64 + fr, col0 = u.pn * BM + wc * 32 + 8 * fq;
#pragma unroll
        for (int ai = 0; ai < 2; ++ai)
#pragma unroll
            for (int m = 0; m < 4; ++m) { const int row = row0 + ai * HALF + m * 16; const size_t off = (size_t)row * ldc + col0; float s = 0.f;
#pragma unroll
                for (int bj = 0; bj < 2; ++bj) { const f32x4 b0 = *(const f32x4*)(base + off + bj * HALF), b1 = *(const f32x4*)(base + off + bj * HALF + 4);
                    const f32x4 o0 = b0 + alpha * acc[ai][bj][m][0], o1 = b1 + alpha * acc[ai][bj][m][1];
                    *(f32x4*)(out + off + bj * HALF) = o0; *(f32x4*)(out + off + bj * HALF + 4) = o1;
                    u32x4 w; w.x = cvt_pk_bf16(o0[0], o0[1]); w.y = cvt_pk_bf16(o0[2], o0[3]); w.z = cvt_pk_bf16(o1[0], o1[1]); w.w = cvt_pk_bf16(o1[2], o1[3]);
                    *(u32x4*)(xb + off + bj * HALF) = w;
                    s += ((o0[0] * o0[0] + o0[1] * o0[1]) + (o0[2] * o0[2] + o0[3] * o0[3])) + ((o1[0] * o1[0] + o1[1] * o1[1]) + (o1[2] * o1[2] + o1[3] * o1[3])); }
                s = fq_sum(s);
                if (fq == 0) part[(size_t)row * 32 + u.pn * 4 + wc] = s;
                if (m & 1) asm volatile("" ::: "memory"); }
    }
};

struct EpiResidB {
    static constexpr bool PERM = true, AFTER_DRAIN = false; static constexpr int KL = 0; static constexpr int NVM = 32;
    bf16_t* xb; float* part; int ldc; float alpha;
    __device__ __forceinline__ void operator()(const f32x4 (&acc)[2][2][4][2], const Unit& u, int wr, int wc, int fr, int fq) const {
        const int row0 = u.pm * BM + wr * 64 + fr, col0 = u.pn * BM + wc * 32 + 8 * fq;
#pragma unroll
        for (int ai = 0; ai < 2; ++ai)
#pragma unroll
            for (int m = 0; m < 4; ++m) { const int row = row0 + ai * HALF + m * 16; const size_t off = (size_t)row * ldc + col0; float s = 0.f;
#pragma unroll
                for (int bj = 0; bj < 2; ++bj) { const u32x4 b = *(const u32x4*)(xb + off + bj * HALF);
                    const f32x4 b0 = {__uint_as_float(b.x << 16), __uint_as_float(b.x & 0xffff0000u), __uint_as_float(b.y << 16), __uint_as_float(b.y & 0xffff0000u)};
                    const f32x4 b1 = {__uint_as_float(b.z << 16), __uint_as_float(b.z & 0xffff0000u), __uint_as_float(b.w << 16), __uint_as_float(b.w & 0xffff0000u)};
                    const f32x4 o0 = b0 + alpha * acc[ai][bj][m][0], o1 = b1 + alpha * acc[ai][bj][m][1];
                    u32x4 w; w.x = cvt_pk_bf16(o0[0], o0[1]); w.y = cvt_pk_bf16(o0[2], o0[3]); w.z = cvt_pk_bf16(o1[0], o1[1]); w.w = cvt_pk_bf16(o1[2], o1[3]);
                    *(u32x4*)(xb + off + bj * HALF) = w;
                    const f32x4 r0 = {__uint_as_float(w.x << 16), __uint_as_float(w.x & 0xffff0000u), __uint_as_float(w.y << 16), __uint_as_float(w.y & 0xffff0000u)};
                    const f32x4 r1 = {__uint_as_float(w.z << 16), __uint_as_float(w.z & 0xffff0000u), __uint_as_float(w.w << 16), __uint_as_float(w.w & 0xffff0000u)};
                    s += ((r0[0] * r0[0] + r0[1] * r0[1]) + (r0[2] * r0[2] + r0[3] * r0[3])) + ((r1[0] * r1[0] + r1[1] * r1[1]) + (r1[2] * r1[2] + r1[3] * r1[3])); }
                s = fq_sum(s);
                if (fq == 0) part[(size_t)row * 32 + u.pn * 4 + wc] = s; }
    }
};
struct ProbeOrder : StaticOrder {
    __host__ __device__ bool next(int i, Unit& u) const { const bool r = StaticOrder::next(i, u); u.pm = c & 7; u.pn = (c >> 3) & 3; return r; }
};
struct EpiSwiGLULocal {
    static constexpr bool PERM = true, AFTER_DRAIN = false; static constexpr int KL = 0; static constexpr int NVM = 8;
    EpiSwiGLU inner;
    __device__ __forceinline__ void operator()(const f32x4 (&acc)[2][2][4][2], const Unit& u, int wr, int wc, int fr, int fq) const {
        Unit v; v.pm = 0; v.pn = 0; EpiSwiGLU e = inner; e.pm0 = 0; e(acc, v, wr, wc, fr, fq);
    }
};
struct EpiNull {
    static constexpr bool PERM = true, AFTER_DRAIN = false; static constexpr int KL = PROBE_KL; static constexpr int NVM = 0;
    float* sink;
    __device__ __forceinline__ void operator()(const f32x4 (&acc)[2][2][4][2], const Unit& u, int wr, int wc, int fr, int fq) const {
        f32x4 t = {0.f, 0.f, 0.f, 0.f};
#pragma unroll
        for (int ai = 0; ai < 2; ++ai)
#pragma unroll
            for (int bj = 0; bj < 2; ++bj)
#pragma unroll
                for (int m = 0; m < 4; ++m)
#pragma unroll
                    for (int n = 0; n < 2; ++n) t += acc[ai][bj][m][n];
        if ((t[0] + t[1]) + (t[2] + t[3]) == 1.2345678e30f) sink[0] = 1.f;
    }
};
template <class Epi, class Sched, bool ALIGN_EPI = false, bool SP2 = false>
__device__ __forceinline__ void gemm_phase(PG8_LAS unsigned char* lds, const Gemm g, const Sched& S, const Epi& E) {
    int tid = threadIdx.x; asm volatile("" : "+v"(tid));
    const int wid = __builtin_amdgcn_readfirstlane(tid >> 6), lane = tid & 63, wr = wid >> 2, wc = wid & 3, fr = lane & 15, fq = lane >> 4;
    constexpr int KL_ = Epi::KL;
    const int K = g.K, nt = K / BK;
    unsigned voffA[2], voffB[2];
#pragma unroll
    for (int i = 0; i < 2; ++i) { int R, C; stage_rc(tid * 16 + i * 8192, R, C); const int Rb = Epi::PERM ? ((R & ~31) + perm32(R & 31)) : R;
        voffA[i] = (unsigned)(R * K + C) * 2u; voffB[i] = (unsigned)(Rb * K + C) * 2u; }
    const size_t kstep = (size_t)(BK * 2);
    const size_t hstep = (size_t)HALF * K * 2;
    const size_t tstep = 2 * hstep;
    const unsigned ldsw = (unsigned)wid * 1024u;
    const int aoff = lds_byte(wr * 64 + fr, fq * 8), boff = lds_byte(wc * 32 + fr, fq * 8);
#define PG8_SA(b, h) (((b) * 2 + (h)) * HTB)
#define PG8_SB(b, h) ((4 + (b) * 2 + (h)) * HTB)
#define PG8_STAGE(bufoff, gbase, voff) do { _Pragma("unroll") for (int _i = 0; _i < 2; ++_i) \
        __builtin_amdgcn_global_load_lds((const unsigned*)((const char*)(gbase) + (voff)[_i]), (PG8_LAS unsigned*)(lds + (bufoff) + ldsw + _i * 8192), 16, 0, 0); } while (0)
#define PG8_LDA(dst, b, h) do { _Pragma("unroll") for (int m = 0; m < 4; ++m) _Pragma("unroll") for (int k = 0; k < 2; ++k) dst[m][k] = *(const PG8_LAS bf16x8*)(lds + PG8_SA(b, h) + aoff + m * 2048 + k * 1024); } while (0)
#define PG8_LDB(dst, b, h) do { _Pragma("unroll") for (int n = 0; n < 2; ++n) _Pragma("unroll") for (int k = 0; k < 2; ++k) dst[n][k] = *(const PG8_LAS bf16x8*)(lds + PG8_SB(b, h) + boff + n * 2048 + k * 1024); } while (0)
#define PG8_MMA(ai, bj, At, Bt) do { __builtin_amdgcn_s_setprio(1); _Pragma("unroll") for (int m = 0; m < 4; ++m) _Pragma("unroll") for (int n = 0; n < 2; ++n) _Pragma("unroll") for (int k = 0; k < 2; ++k) \
        acc[ai][bj][m][n] = __builtin_amdgcn_mfma_f32_16x16x32_bf16(Bt[n][k], At[m][k], acc[ai][bj][m][n], 0, 0, 0); __builtin_amdgcn_s_setprio(0); } while (0)
#define PG8_WAIT_V(n) asm volatile("s_waitcnt vmcnt(" #n ")" ::: "memory")
#define PG8_WAIT_L(n) asm volatile("s_waitcnt lgkmcnt(" #n ")" ::: "memory")
#define PG8_BAR __builtin_amdgcn_s_barrier()
#define PG8_SCHED __builtin_amdgcn_sched_barrier(0)
    Unit cur, nxt; int ui = 0;
    if (!S.next(0, cur)) return;
    f32x4 acc[2][2][4][2];
#pragma unroll
    for (int a = 0; a < 2; ++a)
#pragma unroll
        for (int b = 0; b < 2; ++b)
#pragma unroll
            for (int m = 0; m < 4; ++m)
#pragma unroll
                for (int n = 0; n < 2; ++n) acc[a][b][m][n] = (f32x4){0.f, 0.f, 0.f, 0.f};
    bf16x8 At[4][2], B0[2][2], B1[2][2];
    const char* cA = (const char*)g.A + (size_t)cur.pm * tstep; const char* cB = (const char*)g.Bt + (size_t)cur.pn * tstep;
    S.a_ready(cur);
    if constexpr (SP2) {
        PG8_STAGE(PG8_SB(0, 0), cB, voffB); PG8_STAGE(PG8_SB(0, 1), cB + hstep, voffB); PG8_STAGE(PG8_SA(0, 0), cA, voffA); PG8_STAGE(PG8_SA(0, 1), cA + hstep, voffA);
        if (wr == 1) PG8_BAR;
        PG8_WAIT_V(2); PG8_BAR;
        PG8_STAGE(PG8_SB(1, 0), cB + kstep, voffB); PG8_STAGE(PG8_SA(1, 0), cA + kstep, voffA); PG8_STAGE(PG8_SB(1, 1), cB + hstep + kstep, voffB);
        PG8_WAIT_V(6); PG8_BAR;
    } else {
        PG8_STAGE(PG8_SB(0, 0), cB, voffB); PG8_STAGE(PG8_SA(0, 0), cA, voffA); PG8_STAGE(PG8_SB(0, 1), cB + hstep, voffB); PG8_STAGE(PG8_SA(0, 1), cA + hstep, voffA);
        if (wr == 1) PG8_BAR;
        PG8_WAIT_V(4); PG8_BAR;
        PG8_STAGE(PG8_SB(1, 0), cB + kstep, voffB); PG8_STAGE(PG8_SA(1, 0), cA + kstep, voffA); PG8_STAGE(PG8_SB(1, 1), cB + hstep + kstep, voffB);
        PG8_WAIT_V(6); PG8_BAR;
    }
    for (;;) {
        const bool has_next = S.next(ui + 1, nxt);
        const char* nA = has_next ? (const char*)g.A + (size_t)nxt.pm * tstep : cA; const char* nB = has_next ? (const char*)g.Bt + (size_t)nxt.pn * tstep : cB;
        for (int t = 0; t < nt; t += 2) {
            const bool last = (t == nt - 2);
            const char* a1 = cA + (size_t)(t + 1) * kstep;
            const char* a2 = last ? nA : cA + (size_t)(t + 2) * kstep; const char* b2 = last ? nB : cB + (size_t)(t + 2) * kstep;
            const char* a3 = a2 + kstep; const char* b3 = b2 + kstep;
            if (last && has_next) S.a_ready(nxt);
            if constexpr (SP2) {
#define PG8_KT_PAIR(W1_, W2_) do { \
            if (KL_ != 4) { PG8_LDB(B0, 0, 0); PG8_LDB(B1, 0, 1); } PG8_SCHED; PG8_LDA(At, 0, 0); if (KL_ != 2) PG8_STAGE(PG8_SA(1, 1), a1 + hstep, voffA); \
            W1_; PG8_WAIT_L(0); PG8_BAR; PG8_MMA(0, 0, At, B0); PG8_MMA(0, 1, At, B1); PG8_BAR; PG8_SCHED; \
            if (KL_ != 1) PG8_LDA(At, 0, 1); if (KL_ != 2) { PG8_STAGE(PG8_SB(0, 0), b2, voffB); PG8_STAGE(PG8_SB(0, 1), b2 + hstep, voffB); PG8_STAGE(PG8_SA(0, 0), a2, voffA); } \
            W2_; PG8_WAIT_L(0); PG8_BAR; PG8_MMA(1, 0, At, B0); PG8_MMA(1, 1, At, B1); PG8_BAR; PG8_SCHED; \
            if (KL_ != 4) { PG8_LDB(B0, 1, 0); PG8_LDB(B1, 1, 1); } PG8_SCHED; PG8_LDA(At, 1, 0); if (KL_ != 2) PG8_STAGE(PG8_SA(0, 1), a2 + hstep, voffA); \
            PG8_WAIT_V(8); PG8_WAIT_L(0); PG8_BAR; PG8_MMA(0, 0, At, B0); PG8_MMA(0, 1, At, B1); PG8_BAR; PG8_SCHED; \
            if (KL_ != 1) PG8_LDA(At, 1, 1); if (KL_ != 2) { PG8_STAGE(PG8_SB(1, 0), b3, voffB); PG8_STAGE(PG8_SB(1, 1), b3 + hstep, voffB); PG8_STAGE(PG8_SA(1, 0), a3, voffA); } \
            PG8_WAIT_V(8); PG8_WAIT_L(0); PG8_BAR; PG8_MMA(1, 0, At, B0); PG8_MMA(1, 1, At, B1); PG8_BAR; PG8_SCHED; } while (0)
#define PG8_WAIT_VN(n_) asm volatile("s_waitcnt vmcnt(%0)" :: "n"(n_) : "memory")
            const int relax = (EPI_RELAX && t == 0 && ui > 0) ? 1 : 0;
#define PG8_WAIT_SEL() asm volatile("s_cmp_eq_u32 %0, 0\n\ts_cbranch_scc1 .Lw8_%=\n\ts_waitcnt vmcnt(%1)\n\ts_branch .Lwd_%=\n.Lw8_%=:\n\ts_waitcnt vmcnt(8)\n.Lwd_%=:" :: "s"(__builtin_amdgcn_readfirstlane(relax)), "n"(8 + Epi::NVM) : "scc", "memory")
            PG8_KT_PAIR(PG8_WAIT_SEL(), PG8_WAIT_SEL());
#undef PG8_WAIT_SEL
#undef PG8_KT_PAIR
#undef PG8_WAIT_VN
            } else {
            PG8_LDB(B0, 0, 0); PG8_SCHED; PG8_LDA(At, 0, 0); PG8_STAGE(PG8_SA(1, 1), a1 + hstep, voffA);
            PG8_WAIT_L(8); PG8_BAR; PG8_WAIT_L(0); PG8_MMA(0, 0, At, B0); PG8_BAR; PG8_SCHED;
            PG8_LDB(B1, 0, 1); PG8_STAGE(PG8_SB(0, 0), b2, voffB);
            PG8_BAR; PG8_WAIT_L(0); PG8_MMA(0, 1, At, B1); PG8_BAR;
            PG8_LDA(At, 0, 1); PG8_STAGE(PG8_SA(0, 0), a2, voffA);
            PG8_BAR; PG8_WAIT_L(0); PG8_MMA(1, 0, At, B0); PG8_BAR; PG8_SCHED;
            PG8_STAGE(PG8_SB(0, 1), b2 + hstep, voffB);
            PG8_WAIT_V(6); PG8_BAR; PG8_MMA(1, 1, At, B1); PG8_BAR;
            PG8_LDB(B0, 1, 0); PG8_SCHED; PG8_LDA(At, 1, 0); PG8_STAGE(PG8_SA(0, 1), a2 + hstep, voffA);
            PG8_WAIT_L(8); PG8_BAR; PG8_WAIT_L(0); PG8_MMA(0, 0, At, B0); PG8_BAR; PG8_SCHED;
            PG8_LDB(B1, 1, 1); PG8_STAGE(PG8_SB(1, 0), b3, voffB);
            PG8_BAR; PG8_WAIT_L(0); PG8_MMA(0, 1, At, B1); PG8_BAR;
            PG8_LDA(At, 1, 1); PG8_STAGE(PG8_SA(1, 0), a3, voffA);
            PG8_BAR; PG8_WAIT_L(0); PG8_MMA(1, 0, At, B0); PG8_BAR; PG8_SCHED;
            PG8_STAGE(PG8_SB(1, 1), b3 + hstep, voffB);
            PG8_WAIT_V(6); PG8_BAR; PG8_MMA(1, 1, At, B1); PG8_BAR;
            }
        }
        if constexpr (ALIGN_EPI) { if (wr == 0) PG8_BAR; }
        if constexpr (!Epi::AFTER_DRAIN) { E(acc, cur, wr, wc, fr, fq); S.done(cur); }
        if (!has_next) break;
#pragma unroll
        for (int a = 0; a < 2; ++a)
#pragma unroll
            for (int b = 0; b < 2; ++b)
#pragma unroll
                for (int m = 0; m < 4; ++m)
#pragma unroll
                    for (int n = 0; n < 2; ++n) acc[a][b][m][n] = (f32x4){0.f, 0.f, 0.f, 0.f};
        cur = nxt; cA = nA; cB = nB; ++ui;
        if constexpr (ALIGN_EPI) { if (wr == 1) PG8_BAR; }
    }
    PG8_WAIT_V(0);
    if constexpr (!ALIGN_EPI) { if (wr == 0) PG8_BAR; }
    PG8_BAR;
#undef PG8_SA
#undef PG8_SB
#undef PG8_STAGE
#undef PG8_LDA
#undef PG8_LDB
#undef PG8_MMA
#undef PG8_WAIT_V
#undef PG8_WAIT_L
#undef PG8_BAR
#undef PG8_SCHED
}
}

constexpr int DM = 2048, NBATCH = 8, SEQ = 2048, DEPTH = 4, NH = 16, HD = 128, FF = 5632;
constexpr int M = NBATCH * SEQ;
constexpr int NGU = 2 * FF, NQKV = 3 * DM;
constexpr float RMS_EPS = 1e-6f;
constexpr int NWAVES = 8;

constexpr size_t MiB = 1u << 20;
constexpr size_t WS_CTL = 0, CTL_ZERO_BYTES = 1 * MiB;
constexpr size_t WS_LF = 1 * MiB;
constexpr size_t WS_PART = 2 * MiB;
constexpr size_t WS_WF = 4 * MiB;
constexpr size_t WS_WGU = 5 * MiB;
constexpr size_t SZ_WGU = (size_t)NGU * DM * 2;
constexpr size_t WS_WD = WS_WGU + 8 * SZ_WGU;
constexpr size_t SZ_WD = (size_t)DM * FF * 2;
constexpr size_t WS_WQKV = WS_WD + 8 * SZ_WD;
constexpr size_t SZ_WQKV = (size_t)NQKV * DM * 2;
constexpr size_t WS_WO = WS_WQKV + 4 * SZ_WQKV;
constexpr size_t SZ_WO = (size_t)DM * DM * 2;
constexpr size_t WS_H = WS_WO + 4 * SZ_WO;
constexpr size_t WS_AO = WS_H + (size_t)M * DM * 2;
constexpr size_t WS_ACT = WS_AO + (size_t)M * DM * 2;
constexpr size_t WS_END = WS_ACT + (size_t)M * NQKV * 2;
static_assert(WS_WGU % 256 == 0 && WS_WD % 256 == 0 && WS_WQKV % 256 == 0 && WS_WO % 256 == 0 && WS_H % 256 == 0 && WS_ACT % 256 == 0, "alignment");

constexpr int CW_TMO = 0;
constexpr int CW_BAR = 4096;
constexpr int CW_Q = 200000;
constexpr int CW_KMAX = 65536;

constexpr int RING_OFF = 0, RING_BYTES = 131072;
constexpr int LDS_BYTES = 147456;
constexpr int RST_OFF = RING_BYTES;
constexpr int MISC_OFF = LDS_BYTES - 256;

#define GAS __attribute__((address_space(1)))
#define LAS __attribute__((address_space(3)))
typedef unsigned short bf16;
typedef unsigned v4u __attribute__((ext_vector_type(4)));
typedef unsigned v2u __attribute__((ext_vector_type(2)));
typedef float f32x4 __attribute__((ext_vector_type(4)));
typedef float f32x16 __attribute__((ext_vector_type(16)));
typedef short bf16x8 __attribute__((ext_vector_type(8)));
typedef short s16x4 __attribute__((ext_vector_type(4)));
typedef __bf16 bf16x2h __attribute__((ext_vector_type(2)));
typedef GAS unsigned gu32;
#define RLX_AGENT __ATOMIC_RELAXED, __HIP_MEMORY_SCOPE_AGENT
#define LDS_WAIT() asm volatile("s_waitcnt lgkmcnt(0)" ::: "memory")
#define VM_WAIT() asm volatile("s_waitcnt vmcnt(0)" ::: "memory")
__device__ __forceinline__ unsigned cvtpk(float lo, float hi) { unsigned r; asm volatile("v_cvt_pk_bf16_f32 %0, %1, %2" : "=v"(r) : "v"(lo), "v"(hi)); return r; }

#define XB_TMO      128
#define XB_XCNT(j)  (256  + 64 * (j))
#define XB_XSUB(j)  (1280 + 64 * (j))
#define XB_XGEN(j)  (2304 + 64 * (j))
#define XB_TOP      3328
#define XB_TOPGEN   3392
#define XCD_BAR_WORDS 3456
#define XB_SPIN_CAP (1u << 18)
__device__ __forceinline__ unsigned xb_ld(unsigned* p)              { return __hip_atomic_load(p, __ATOMIC_RELAXED, __HIP_MEMORY_SCOPE_AGENT); }
__device__ __forceinline__ unsigned xb_add(unsigned* p, unsigned v) { return __hip_atomic_fetch_add(p, v, __ATOMIC_RELAXED, __HIP_MEMORY_SCOPE_AGENT); }
__device__ __forceinline__ unsigned xb_xcc_id() { return (unsigned)__builtin_amdgcn_s_getreg((3 << 11) | 20) & 0xFu; }
#define XB_SPIN(cond, bar) do { unsigned _sp = 0; while (cond) { __builtin_amdgcn_s_sleep(1); \
    if ((++_sp & 255u) == 0u) { if (xb_ld(&(bar)[XB_TMO])) break; if (_sp > XB_SPIN_CAP) { atomicAdd(&(bar)[XB_TMO], 1u); break; } } } } while (0)
struct XcdBarrier { unsigned* bar; unsigned x; volatile LAS unsigned* st; unsigned gsize; };
__device__ __forceinline__ XcdBarrier xcd_barrier_post(unsigned* bar, volatile LAS unsigned* st, unsigned gsize) {
    XcdBarrier b; b.bar = bar; b.x = xb_xcc_id(); b.st = st; b.gsize = gsize;
    if (threadIdx.x == 0) (void)xb_add(&bar[XB_XCNT(b.x)], 1u);
    return b;
}
__device__ __forceinline__ void xcd_barrier_complete(unsigned* bar, unsigned x, unsigned G, unsigned& nloc, unsigned& nx) {
    unsigned sum, cnt, mine, sp = 0u;
    for (;;) {
        sum = 0u; cnt = 0u; mine = 0u;
#pragma unroll
        for (unsigned j = 0; j < 16; ++j) { const unsigned c = xb_ld(&bar[XB_XCNT(j)]); sum += c; cnt += (c > 0u) ? 1u : 0u; mine = (j == x) ? c : mine; }
        if (sum == G) break;
        __builtin_amdgcn_s_sleep(1);
        if ((++sp & 255u) == 0u) { if (xb_ld(&bar[XB_TMO])) break; if (sp > XB_SPIN_CAP) { atomicAdd(&bar[XB_TMO], 1u); break; } }
    }
    nloc = mine > 0u ? mine : 1u; nx = cnt > 0u ? cnt : 1u;
}
__device__ __forceinline__ void xcd_barrier(const XcdBarrier& b) {
    asm volatile("s_waitcnt vmcnt(0)" ::: "memory");
    __syncthreads();
    if (threadIdx.x == 0) {
        unsigned* bar = b.bar;
        __builtin_amdgcn_s_waitcnt(0);
        unsigned nloc = b.st[0], nx = b.st[1];
        if (nloc == 0u) { xcd_barrier_complete(bar, b.x, b.gsize, nloc, nx); b.st[0] = nloc; b.st[1] = nx; }
        const unsigned old = xb_add(&bar[XB_XSUB(b.x)], 1u);
        const unsigned gen = old / nloc;
        if (old + 1u == (gen + 1u) * nloc) {
            __builtin_amdgcn_fence(__ATOMIC_RELEASE, "agent");
            asm volatile("s_waitcnt vmcnt(0)" ::: "memory");
            const unsigned og = xb_add(&bar[XB_TOP], 1u);
            const unsigned tg = og / nx;
            if (og + 1u == (tg + 1u) * nx) xb_add(&bar[XB_TOPGEN], 1u);
            else XB_SPIN(xb_ld(&bar[XB_TOPGEN]) == tg, bar);
            __builtin_amdgcn_fence(__ATOMIC_ACQUIRE, "agent");
            xb_add(&bar[XB_XGEN(b.x)], 1u);
            asm volatile("s_waitcnt vmcnt(0)" ::: "memory");
        } else {
            XB_SPIN(xb_ld(&bar[XB_XGEN(b.x)]) == gen, bar);
            __builtin_amdgcn_fence(__ATOMIC_ACQUIRE, "agent");
            asm volatile("s_waitcnt vmcnt(0)" ::: "memory");
        }
    }
    __syncthreads();
}

__device__ __forceinline__ int opaque_tid() { int t = threadIdx.x; asm volatile("" : "+v"(t)); return t; }
__device__ __forceinline__ float wave_sum(float v) {
#pragma unroll
    for (int o = 1; o < 64; o <<= 1) v += __shfl_xor(v, o);
    return v;
}

__device__ __forceinline__ void transpose_item(const float* __restrict__ W, int ldw, int Kdim, bf16* __restrict__ WT, int k0, int n0, int drow0, const float* __restrict__ gk, LAS float* scr, int lane) {
    const int nl = (lane & 15) * 4, kl = lane >> 4;
    f32x4 v[16];
#pragma unroll
    for (int i = 0; i < 16; ++i) v[i] = *(const GAS f32x4*)(W + (size_t)(k0 + 4 * i + kl) * ldw + n0 + nl);
#pragma unroll
    for (int i = 0; i < 16; ++i) { const float gg = gk ? gk[k0 + 4 * i + kl] : 1.0f; LAS float* s = scr + (4 * i + kl) * 65 + nl; s[0] = v[i].x * gg; s[1] = v[i].y * gg; s[2] = v[i].z * gg; s[3] = v[i].w * gg; }
    LDS_WAIT(); asm volatile("" ::: "memory");
    const int c = lane & 7;
#pragma unroll
    for (int j = 0; j < 8; ++j) { const int n = (lane >> 3) + 8 * j; const LAS float* s = scr + (8 * c) * 65 + n;
        v4u o; o.x = cvtpk(s[0 * 65], s[1 * 65]); o.y = cvtpk(s[2 * 65], s[3 * 65]); o.z = cvtpk(s[4 * 65], s[5 * 65]); o.w = cvtpk(s[6 * 65], s[7 * 65]);
        *(GAS v4u*)(WT + (size_t)(drow0 + n) * Kdim + k0 + 8 * c) = o; }
    LDS_WAIT(); asm volatile("" ::: "memory");
}

namespace att {
constexpr int D = 128, NW = 8, QBLK = 32, KVBLK = 64, QB = 256;
constexpr int SHM_K = KVBLK * D * 2, SHM_V = KVBLK * D * 2;
constexpr int L_V = 0, L_K = 2 * SHM_V, L_WS = L_K + 2 * SHM_K, L_TAB = L_WS + NW * 64 * 4, L_SCAN = L_TAB + 2304 * 4, L_FLAG = L_SCAN + 64, L_END = L_FLAG + 64;
constexpr int TAB_N = 2304;
constexpr int QPITCH = NQKV, OPITCH = DM;
constexpr float SCALE = 0.08838834764831845f;
constexpr float C2 = 1.4426950408889634f * SCALE;
constexpr float THR = 8.f;

#define KSWZ(row, colB) ((row) * 256 + ((colB) ^ (((row) & 7) << 4)))
#define SBAR() __builtin_amdgcn_sched_barrier(0)
__device__ __forceinline__ int v_st(int k, int c) { const int kk = (k & ~0xC) | ((k & 4) << 1) | ((k & 8) >> 1); return ((kk >> 3) * 4 + (c >> 5)) * 512 + ((kk & 7) * 32 + (c & 31)) * 2; }
__device__ __forceinline__ int v_rd_base(int lane) { return ((lane & 3) << 3) | (((lane >> 2) & 3) << 6) | (((lane >> 4) & 1) << 5) | (((lane >> 5) & 1) << 8); }
constexpr int v_rd_off(int d0, int ks, int half) { return d0 * 512 + ks * 4096 + half * 2048; }
__device__ __forceinline__ int crow(int r, int hi) { return (r & 3) + 8 * (r >> 2) + 4 * hi; }

template <bool STRICT>
__device__ __forceinline__ void mask_tile(f32x16& p0, f32x16& p1, int dq) {
    const float NEG = -__builtin_inff();
    const int lim = STRICT ? 1 : 0;
#pragma unroll
    for (int r = 0; r < 16; ++r) {
        const int c = (r & 3) + 8 * (r >> 2);
        if (dq - c < lim) p0[r] = NEG;
        if (dq - c - 32 < lim) p1[r] = NEG;
    }
}
__device__ __forceinline__ void partialSM(f32x16& p0, f32x16& p1, float& m_reg, float& mn, float& alpha) {
    float pmax = p0[0];
#pragma unroll
    for (int r = 1; r < 16; ++r) pmax = fmaxf(pmax, p0[r]);
#pragma unroll
    for (int r = 0; r < 16; ++r) pmax = fmaxf(pmax, p1[r]);
    { auto rr = __builtin_amdgcn_permlane32_swap(__float_as_uint(pmax), __float_as_uint(pmax), false, false);
      pmax = fmaxf(__uint_as_float(rr[0]), __uint_as_float(rr[1])); }
    if (__builtin_expect(__all((pmax - m_reg) * SCALE <= THR), 1)) { mn = m_reg; alpha = 1.f; }
    else { mn = fmaxf(m_reg, pmax); alpha = __builtin_amdgcn_exp2f((m_reg - mn) * C2); m_reg = mn; }
    const float mnL = -mn * C2;
#pragma unroll
    for (int r = 0; r < 16; ++r) p0[r] = fmaf(p0[r], C2, mnL);
#pragma unroll
    for (int r = 0; r < 16; ++r) p1[r] = fmaf(p1[r], C2, mnL);
#pragma unroll
    for (int r = 0; r < 16; ++r) p0[r] = __builtin_amdgcn_exp2f(p0[r]);
}
#define PK4(P, B_, OUT) do { unsigned a0 = cvtpk(P[B_+0], P[B_+1]), a1 = cvtpk(P[B_+2], P[B_+3]);                          \
        unsigned b0 = cvtpk(P[B_+4], P[B_+5]), b1 = cvtpk(P[B_+6], P[B_+7]);                                             \
        auto r0 = __builtin_amdgcn_permlane32_swap(a0, b0, false, false); auto r1 = __builtin_amdgcn_permlane32_swap(a1, b1, false, false); \
        v4u w = {r0[0], r1[0], r0[1], r1[1]}; OUT = __builtin_bit_cast(bf16x8, w); } while (0)
__device__ __forceinline__ void finishSM(f32x16& p0, f32x16& p1, float alpha, float& l_reg, bf16x8& pa0, bf16x8& pa1, bf16x8& pa2, bf16x8& pa3) {
#pragma unroll
    for (int r = 0; r < 16; ++r) p1[r] = __builtin_amdgcn_exp2f(p1[r]);
    float ps = 0;
#pragma unroll
    for (int r = 0; r < 16; ++r) ps += p0[r];
#pragma unroll
    for (int r = 0; r < 16; ++r) ps += p1[r];
    { auto rr = __builtin_amdgcn_permlane32_swap(__float_as_uint(ps), __float_as_uint(ps), false, false);
      ps = __uint_as_float(rr[0]) + __uint_as_float(rr[1]); }
    l_reg = l_reg * alpha + ps;
    PK4(p0, 0, pa0); PK4(p0, 8, pa1); PK4(p1, 0, pa2); PK4(p1, 8, pa3);
}
template <int KB>
__device__ __forceinline__ void qkt(f32x16& p0, f32x16& p1, const LAS char* K_lds, int r32, int hi, const bf16x8* qr) {
    const LAS char* kb[4];
#pragma unroll
    for (int dd = 0; dd < 4; ++dd) kb[dd] = K_lds + KB * SHM_K + KSWZ(r32, (dd * 16 + hi * 8) * 2);
#pragma unroll
    for (int d0 = 0; d0 < 8; ++d0) { const LAS char* a = kb[d0 & 3] + (d0 >> 2) * 128;
        bf16x8 b0 = *reinterpret_cast<const LAS bf16x8*>(a);
        bf16x8 b1 = *reinterpret_cast<const LAS bf16x8*>(a + 32 * 256);
        p0 = __builtin_amdgcn_mfma_f32_32x32x16_bf16(b0, qr[d0], p0, 0, 0, 0);
        p1 = __builtin_amdgcn_mfma_f32_32x32x16_bf16(b1, qr[d0], p1, 0, 0, 0); }
}
template <int VB>
__device__ __forceinline__ void pv_tile(f32x16* o, int vb0, bf16x8 pa0, bf16x8 pa1, bf16x8 pa2, bf16x8 pa3) {
#define TRRD(dst, off) asm volatile("ds_read_b64_tr_b16 %0, %1 offset:%2" : "=&v"(dst) : "v"(vb0), "i"(off) : "memory")
#define PV_D0(d0) do { s16x4 l0, l1, l2, l3, h0, h1, h2, h3; constexpr int b_ = VB * SHM_V + v_rd_off(d0, 0, 0); \
        TRRD(l0, b_); TRRD(h0, b_ + 2048); TRRD(l1, b_ + 4096); TRRD(h1, b_ + 6144); TRRD(l2, b_ + 8192); TRRD(h2, b_ + 10240); TRRD(l3, b_ + 12288); TRRD(h3, b_ + 14336); \
        asm volatile("s_waitcnt lgkmcnt(0)" ::: "memory"); SBAR();   \
        o[d0] = __builtin_amdgcn_mfma_f32_32x32x16_bf16(pa0, (bf16x8){l0[0], l0[1], l0[2], l0[3], h0[0], h0[1], h0[2], h0[3]}, o[d0], 0, 0, 0);   \
        o[d0] = __builtin_amdgcn_mfma_f32_32x32x16_bf16(pa1, (bf16x8){l1[0], l1[1], l1[2], l1[3], h1[0], h1[1], h1[2], h1[3]}, o[d0], 0, 0, 0);   \
        o[d0] = __builtin_amdgcn_mfma_f32_32x32x16_bf16(pa2, (bf16x8){l2[0], l2[1], l2[2], l2[3], h2[0], h2[1], h2[2], h2[3]}, o[d0], 0, 0, 0);   \
        o[d0] = __builtin_amdgcn_mfma_f32_32x32x16_bf16(pa3, (bf16x8){l3[0], l3[1], l3[2], l3[3], h3[0], h3[1], h3[2], h3[3]}, o[d0], 0, 0, 0); } while (0)
    PV_D0(0); PV_D0(1); PV_D0(2); PV_D0(3);
#undef PV_D0
#undef TRRD
}
__device__ __forceinline__ float suffix32(const f32x16& x, f32x16& aft, float base, int hi) {
    float c0[4], c1[4];
#pragma unroll
    for (int g = 0; g < 4; ++g) { const float c = (x[4 * g] + x[4 * g + 1]) + (x[4 * g + 2] + x[4 * g + 3]);
        auto rr = __builtin_amdgcn_permlane32_swap(__float_as_uint(c), __float_as_uint(c), false, false);
        c0[g] = __uint_as_float(rr[0]); c1[g] = __uint_as_float(rr[1]); }
    float s = base;
#pragma unroll
    for (int g = 3; g >= 0; --g) { const float sx1 = s; s += c1[g]; const float sx0 = s; s += c0[g];
        const float sx = hi ? sx1 : sx0;
        aft[4 * g + 3] = sx; aft[4 * g + 2] = aft[4 * g + 3] + x[4 * g + 3]; aft[4 * g + 1] = aft[4 * g + 2] + x[4 * g + 2]; aft[4 * g] = aft[4 * g + 1] + x[4 * g + 1]; }
    return s;
}

template <int MODE, int KVB>
__device__ __forceinline__ void attn_tile(f32x16* o, float& m_reg, float& l_reg, float& R, const bf16x8* qr, const LAS char* K_lds, int vb0, const LAS float* tab, LAS float* al_l,
                                          int kb, int qlo, int qm, int tl, int r32, int hi) {
    f32x16 p0, p1; bf16x8 pa0, pa1, pa2, pa3;
    if (MODE == 0) {
        const LAS float* tp = tab + (tl + kb);
#pragma unroll
        for (int r = 0; r < 16; ++r) { const int c = (r & 3) + 8 * (r >> 2); p0[r] = tp[c]; p1[r] = tp[c + 32]; }
    } else {
#pragma unroll
        for (int r = 0; r < 16; ++r) { p0[r] = 0.f; p1[r] = 0.f; }
    }
    qkt<KVB>(p0, p1, K_lds, r32, hi, qr);
    if (MODE == 0) {
        if (kb + KVBLK - 1 > qlo) mask_tile<false>(p0, p1, qm - kb);
        float mn, alpha;
        partialSM(p0, p1, m_reg, mn, alpha);
        if (__any(alpha < 1.f)) { if (hi == 0) al_l[r32] = alpha; LDS_WAIT();
#pragma unroll
            for (int d_ = 0; d_ < 4; ++d_)
#pragma unroll
                for (int r = 0; r < 16; ++r) o[d_][r] *= al_l[crow(r, hi)]; }
        finishSM(p0, p1, alpha, l_reg, pa0, pa1, pa2, pa3);
    } else {
        f32x16 x0, x1;
#pragma unroll
        for (int r = 0; r < 16; ++r) { const float y = p0[r] * C2; const float L = __builtin_amdgcn_logf(1.0f + __builtin_amdgcn_exp2f(-fabsf(y))); const float lb = fminf(y, 0.f) - L; p0[r] = lb; x0[r] = lb - y; }
#pragma unroll
        for (int r = 0; r < 16; ++r) { const float y = p1[r] * C2; const float L = __builtin_amdgcn_logf(1.0f + __builtin_amdgcn_exp2f(-fabsf(y))); const float lb = fminf(y, 0.f) - L; p1[r] = lb; x1[r] = lb - y; }
        if (kb + KVBLK - 1 >= qlo) {
            const int dq = qm - kb; const float NEG = -__builtin_inff();
#pragma unroll
            for (int r = 0; r < 16; ++r) { const int c = (r & 3) + 8 * (r >> 2);
                if (dq - c < 1) { p0[r] = NEG; x0[r] = 0.f; }
                if (dq - c - 32 < 1) { p1[r] = NEG; x1[r] = 0.f; } }
        }
        f32x16 a0, a1;
        const float s1 = suffix32(x1, a1, R, hi);
        const float s0 = suffix32(x0, a0, s1, hi);
        R = s0;
#pragma unroll
        for (int r = 0; r < 16; ++r) { p0[r] = __builtin_amdgcn_exp2f(p0[r] + a0[r]); p1[r] = __builtin_amdgcn_exp2f(p1[r] + a1[r]); }
        PK4(p0, 0, pa0); PK4(p0, 8, pa1); PK4(p1, 0, pa2); PK4(p1, 8, pa3);
    }
    SBAR();
    pv_tile<KVB>(o, vb0, pa0, pa1, pa2, pa3);
}
template <int MODE>
__device__ __forceinline__ void attn_block(const bf16* __restrict__ Qb, const bf16* __restrict__ Kh, const bf16* __restrict__ Vh, bf16* __restrict__ Ob, int P0, LAS char* lds, int toff_mul, int toff_add, float kmax, int kcov) {
    int tid = threadIdx.x; asm volatile("" : "+v"(tid));
    const int wid = __builtin_amdgcn_readfirstlane(tid >> 6), lane = tid & 63, r32 = lane & 31, hi = lane >> 5;
    LAS char* V_lds = lds + L_V; LAS char* K_lds = lds + L_K;
    LAS float* wsf = (LAS float*)(lds + L_WS) + wid * 64; LAS float* li_l = wsf; LAS float* al_l = wsf + 32;
    const LAS float* tab = (const LAS float*)(lds + L_TAB);
    volatile LAS unsigned* flags = (volatile LAS unsigned*)(lds + L_FLAG);
    bf16x8 qr[8];
    { const bf16* qrow = Qb + (size_t)(wid * QBLK + r32) * QPITCH + hi * 8;
#pragma unroll
      for (int d0 = 0; d0 < 8; ++d0) qr[d0] = *(const GAS bf16x8*)(qrow + d0 * 16); }
    const int qlo = P0 + wid * QBLK, qpos = qlo + r32, qm = qpos - 4 * hi;
    const int NT = P0 / KVBLK + 4;
    float qn = 0.f;
    if (MODE == 0) {
#pragma unroll
        for (int d0 = 0; d0 < 8; ++d0)
#pragma unroll
            for (int e = 0; e < 8; ++e) { const float qv = __uint_as_float(((unsigned)(unsigned short)qr[d0][e]) << 16); qn += qv * qv; }
        { auto rr = __builtin_amdgcn_permlane32_swap(__float_as_uint(qn), __float_as_uint(qn), false, false); qn = __uint_as_float(rr[0]) + __uint_as_float(rr[1]); }
        qn = sqrtf(qn) * 1.002f;
    }
    const int sr = tid >> 4, sc = (tid & 15) * 8;
    const int kws = KSWZ(sr, sc * 2), vst0 = v_st(sr, sc), vst1 = v_st(32 + sr, sc);
    const int vb0 = (int)(unsigned)(uintptr_t)V_lds + v_rd_base(lane);
    const int tl = toff_mul * qpos + toff_add + 4 * hi;
    float m_reg = -1e30f, l_reg = 0.f, R = 0.f;
    f32x16 o[4];
#pragma unroll
    for (int d = 0; d < 4; ++d)
#pragma unroll
        for (int r = 0; r < 16; ++r) o[d][r] = 0.f;
    bf16x8 sk0, sk1, sv0, sv1;
#define KB_OF(it_) ((NT - 1 - (it_)) * KVBLK)
#define ST_LOAD(kb_) do { const bf16* kp = Kh + (size_t)((kb_) + sr) * QPITCH + sc; const bf16* vp = Vh + (size_t)((kb_) + sr) * QPITCH + sc; \
        sk0 = *(const GAS bf16x8*)kp; sk1 = *(const GAS bf16x8*)(kp + (size_t)32 * QPITCH); sv0 = *(const GAS bf16x8*)vp; sv1 = *(const GAS bf16x8*)(vp + (size_t)32 * QPITCH); } while (0)
#define ST_WRITE(bf_) do { *(LAS bf16x8*)(K_lds + (bf_) * SHM_K + kws) = sk0; *(LAS bf16x8*)(K_lds + (bf_) * SHM_K + kws + 32 * 256) = sk1; \
        *(LAS bf16x8*)(V_lds + (bf_) * SHM_V + vst0) = sv0; *(LAS bf16x8*)(V_lds + (bf_) * SHM_V + vst1) = sv1; } while (0)
    __syncthreads();
    ST_LOAD(KB_OF(0)); ST_WRITE(0);
    if (tid < 16) flags[tid] = 0u;
    __syncthreads();
    bool stop = false, wdone = false;
#define STEP(it_, B_, NB_) { const int kb = KB_OF(it_); const bool more = (it_) + 1 < NT; \
        if (more) ST_LOAD(KB_OF((it_) + 1)); \
        if (kb <= qlo + QBLK - 1 && !wdone) attn_tile<MODE, B_>(o, m_reg, l_reg, R, qr, K_lds, vb0, tab, al_l, kb, qlo, qm, tl, r32, hi); \
        if (more) ST_WRITE(NB_); \
        if (MODE == 1) { wdone = (kb <= qlo + QBLK - 1) && __all(R <= -160.f); if (lane == 0) flags[((it_) & 1) * 8 + wid] = wdone ? 1u : 0u; } \
        if (MODE == 0) {   \
            wdone = (kmax > 0.f) && (kb <= qlo + QBLK - 1) && kb > 0 && kb <= kcov && __all((qn * kmax + tab[kb - 1] - m_reg) * C2 < -152.f); if (lane == 0) flags[((it_) & 1) * 8 + wid] = wdone ? 1u : 0u; } \
        __syncthreads(); \
        { unsigned a_ = 1u; _Pragma("unroll") for (int w_ = 0; w_ < 8; ++w_) a_ &= flags[((it_) & 1) * 8 + w_]; stop = (a_ != 0u); } }
    for (int it = 0; it < NT; it += 2) {
        STEP(it, 0, 1)
        if (stop) break;
        STEP(it + 1, 1, 0)
        if (stop) break;
    }
#undef STEP
#undef ST_LOAD
#undef ST_WRITE
#undef KB_OF
    float rli[16];
    if (MODE == 0) {
        if (hi == 0) li_l[r32] = l_reg; LDS_WAIT();
#pragma unroll
        for (int r = 0; r < 16; ++r) rli[r] = __builtin_amdgcn_rcpf(li_l[crow(r, hi)]);
    } else {
#pragma unroll
        for (int r = 0; r < 16; ++r) rli[r] = 1.f;
    }
    bf16* Ow = Ob + (size_t)(wid * QBLK) * OPITCH;
#pragma unroll
    for (int r = 0; r < 16; ++r) { const int orow = crow(r, hi);
#pragma unroll
        for (int d0 = 0; d0 < 4; ++d0) { const float v = o[d0][r] * rli[r];
            const float vn = __shfl_xor(v, 1);
            if ((r32 & 1) == 0) *(GAS unsigned*)(Ow + (size_t)orow * OPITCH + d0 * 32 + r32) = cvtpk(v, vn); } }
}
#undef PK4
}

__device__ __forceinline__ int t5_bucket(int d) {
    if (d < 16) return d;
    int b = 16;
    b += (d >= 22); b += (d >= 30); b += (d >= 40); b += (d >= 54); b += (d >= 73); b += (d >= 99); b += (d >= 134); b += (d >= 182);
    b += (d >= 246); b += (d >= 332); b += (d >= 450); b += (d >= 609); b += (d >= 825); b += (d >= 1117); b += (d >= 1513);
    return b;
}

struct Args {
    const float* x; const float* norm_g; const float* w_gate; const float* w_up; const float* w_down;
    const float* w_in[4]; const float* b_f0; const float* b_f3; const float* w_out; const float* rel_bias; const float* final_g;
    float* out; unsigned char* ws; int ph_lo, ph_hi;
};
static_assert(sizeof(Args) == 16 * 8 + 8, "Args has no padding");

__global__ void __launch_bounds__(NWAVES * 64, 2) mk_fwd(Args a) {
    extern __shared__ __attribute__((aligned(16))) unsigned char lds_raw[];
    LAS unsigned char* lds = (LAS unsigned char*)lds_raw;
    volatile LAS unsigned* MISC = (volatile LAS unsigned*)(lds + MISC_OFF);
    const int G = gridDim.x; const int bx = blockIdx.x; const int vcu = (G % 8 == 0) ? (bx % 8) * (G / 8) + bx / 8 : bx;
    unsigned char* ws = a.ws;
    gu32* ctl = (gu32*)(ws + WS_CTL);
    if (threadIdx.x < 64) MISC[threadIdx.x] = 0u;
    __syncthreads();
    const int lo = a.ph_lo, hi = a.ph_hi;
    const int grp = bx & 7, gidx = bx >> 3;
    XcdBarrier bar, barL; bar.bar = (unsigned*)(ctl + CW_BAR); bar.x = 0; bar.st = nullptr; bar.gsize = 0; barL = bar;
    if (hi - lo > 1) { bar = xcd_barrier_post((unsigned*)(ctl + CW_BAR), MISC + 8, (unsigned)G); barL = xcd_barrier_post((unsigned*)(ctl + CW_BAR) + (1 + grp) * XCD_BAR_WORDS, MISC + 10, (unsigned)(G / 8)); }
#define RUN(k) (lo <= (k) && (k) < hi)
#define SEAM(k) do { if (RUN(k) && RUN((k) + 1)) { if ((k) == 0) xcd_barrier(bar); else xcd_barrier(barL); if (PROBE_DUP == 9) xcd_barrier(barL); } } while (0)

    bf16* const Hb = (bf16*)(ws + WS_H); bf16* const AO = (bf16*)(ws + WS_AO);
    bf16* const ACT = (bf16*)(ws + WS_ACT + (size_t)(bx & 7) * ((size_t)SEQ * (NQKV - FF) * 2)); bf16* const QKV = (bf16*)(ws + WS_ACT);
    float* const LF = (float*)(ws + WS_LF);
    const int NGW = G * NWAVES;
    int ph = 0;
#define LANE_IDS() const int tid = opaque_tid(), lane = tid & 63, wave = __builtin_amdgcn_readfirstlane(tid >> 6), gw = vcu * NWAVES + wave; (void)lane; (void)gw

    constexpr int I_G = (DM / 64) * (FF / 64), I_D = (FF / 64) * (DM / 64), I_Q = (DM / 64) * (NQKV / 64), I_O = (DM / 64) * (DM / 64);
    constexpr int PER_LAYER = 6 * I_G + I_Q + I_O;
    static_assert(I_G == I_D && PER_LAYER % 8 == 0 && I_G % 8 == 0 && I_Q % 8 == 0 && I_O % 8 == 0, "items");
    auto conv_item = [&](int it, LAS float* scr, int lane) __attribute__((always_inline)) {
            const int l = it / PER_LAYER; int r = it - l * PER_LAYER;
            if (r < 6 * I_G) {
                const int mm = r / I_G, idx = r - mm * I_G, kind = mm >> 1, f = mm & 1;
                if (kind < 2) {
                    const float* W = (kind == 0 ? a.w_gate : a.w_up) + (size_t)(l * 2 + f) * DM * FF;
                    const int nblk = FF / 64, kb = idx / nblk, nb = idx - kb * nblk, n0 = nb * 64;
                    transpose_item(W, FF, DM, (bf16*)(ws + WS_WGU + (size_t)(l * 2 + f) * SZ_WGU), kb * 64, n0, (n0 >> 7) * 256 + (n0 & 127) + kind * 128, a.norm_g + (size_t)(l * 3 + 2 * f) * DM, scr, lane);
                } else {
                    const float* W = a.w_down + (size_t)(l * 2 + f) * FF * DM;
                    const int nblk = DM / 64, kb = idx / nblk, nb = idx - kb * nblk;
                    transpose_item(W, DM, FF, (bf16*)(ws + WS_WD + (size_t)(l * 2 + f) * SZ_WD), kb * 64, nb * 64, nb * 64, nullptr, scr, lane);
                }
            } else { r -= 6 * I_G;
                if (r < I_Q) {
                    const float* W = a.w_in[l]; const int ldw = (l == 0 || l == 3) ? NQKV + NH : NQKV;
                    const int nblk = NQKV / 64, kb = r / nblk, nb = r - kb * nblk;
                    transpose_item(W, ldw, DM, (bf16*)(ws + WS_WQKV + (size_t)l * SZ_WQKV), kb * 64, nb * 64, nb * 64, a.norm_g + (size_t)(l * 3 + 1) * DM, scr, lane);
                } else { r -= I_Q;
                    const float* W = a.w_out + (size_t)l * DM * DM;
                    const int nblk = DM / 64, kb = r / nblk, nb = r - kb * nblk;
                    transpose_item(W, DM, DM, (bf16*)(ws + WS_WO + (size_t)l * SZ_WO), kb * 64, nb * 64, nb * 64, nullptr, scr, lane);
                }
            }
    };
    const int n_static = (hi - lo > 1) ? (DEPTH - 1) * PER_LAYER : DEPTH * PER_LAYER;
    if (RUN(ph)) REP(1) {
        LANE_IDS();
        LAS float* scr = (LAS float*)(lds + wave * 16640);
        for (int it = gw; it < n_static; it += NGW) conv_item(it, scr, lane);
    }
    if (RUN(ph)) REP(1) {
        LANE_IDS();
        for (int idx = bx * (NWAVES * 64) + tid; idx < 2 * 16 * DM; idx += G * NWAVES * 64) {
            const int sl = idx >> 15, n = (idx >> 11) & 15, k = idx & (DM - 1), l = sl ? 3 : 0;
            const float w = a.w_in[l][(size_t)k * (NQKV + NH) + NQKV + n] * a.norm_g[(size_t)(l * 3 + 1) * DM + k];
            ((bf16*)(ws + WS_WF))[idx] = (bf16)(cvtpk(w, 0.f) & 0xffffu);
        }
        float* const part = (float*)(ws + WS_PART);
        for (int m = gw; m < M; m += NGW) {
            const GAS f32x4* xr = (const GAS f32x4*)(a.x + (size_t)m * DM) + lane;
            f32x4 v[8]; float ss = 0.f;
#pragma unroll
            for (int j = 0; j < 8; ++j) { v[j] = xr[64 * j]; ss += (v[j].x * v[j].x + v[j].y * v[j].y) + (v[j].z * v[j].z + v[j].w * v[j].w); }
            ss = wave_sum(ss);
            GAS v2u* o8 = (GAS v2u*)(Hb + (size_t)m * DM) + lane;
#pragma unroll
            for (int j = 0; j < 8; ++j) { v2u w; w.x = cvtpk(v[j].x, v[j].y); w.y = cvtpk(v[j].z, v[j].w); o8[64 * j] = w; }
            if (lane < 32) part[(size_t)m * 32 + lane] = (lane == 0) ? ss : 0.f;
        }
    }
    SEAM(ph); ++ph;

    for (int sb = 0; sb < 3 * DEPTH; ++sb) {
        const int l = sb / 3, ty = sb - 3 * l;
        if (hi - lo > 1 && (sb == 3 * (DEPTH - 1) || sb == 3 * DEPTH - 1)) {
            LANE_IDS();
            LAS float* scr = (LAS float*)(lds + wave * 16640);
            volatile LAS unsigned* qslot = MISC + 16;
            const int qB = (sb == 3 * DEPTH - 1) ? 1 : 0;
            const unsigned qn = qB ? 3u * I_G : 3u * I_G + I_Q + I_O;
            unsigned* qctr = (unsigned*)ctl + CW_Q + qB * 128; unsigned* dctr = qctr + 64;
            unsigned mine = 0u;
            for (;;) {
                __syncthreads();
                if (tid == 0) *qslot = xb_add(qctr, 8u);
                __syncthreads();
                const unsigned base = *qslot;
                if (base >= qn) break;
                const unsigned q = base + (unsigned)wave, seg = q / (unsigned)I_G;
                const unsigned r = qB ? (2u * seg + 1u) * I_G + (q - seg * I_G) : (seg < 3u ? 2u * seg * I_G + (q - seg * I_G) : 6u * I_G + (q - 3u * I_G));
                conv_item((DEPTH - 1) * PER_LAYER + (int)r, scr, lane);
                mine += 8u;
            }
            asm volatile("s_waitcnt vmcnt(0)" ::: "memory");
            __syncthreads();
            if (tid == 0) {
                if (mine) { __builtin_amdgcn_fence(__ATOMIC_RELEASE, "agent"); asm volatile("s_waitcnt vmcnt(0)" ::: "memory"); (void)xb_add(dctr, mine); }
                XB_SPIN(xb_ld(dctr) < qn, (unsigned*)(ctl + CW_BAR));
                __builtin_amdgcn_fence(__ATOMIC_ACQUIRE, "agent");
                asm volatile("s_waitcnt vmcnt(0)" ::: "memory");
            }
            __syncthreads();
        }
        const float* xsrc = (sb == 0) ? a.x : (const float*)a.out;
        if (ty != 1) {
            const int f = ty >> 1;
            if (PROBE_DUP == 10 && RUN(ph)) {
                pg8::Gemm g{Hb, (const bf16*)(ws + WS_WGU + (size_t)(l * 2 + f) * SZ_WGU), M, NGU, DM}; pg8::StaticOrder S; S.init(M, NGU, G, bx);
                pg8::Unit u0; S.next(0, u0); pg8::build_rstd_table((LAS float*)(lds + RST_OFF), (const float*)(ws + WS_PART), u0.pm, opaque_tid());
                pg8::EpiSwiGLULocal E{pg8::EpiSwiGLU{(bf16*)(ws + WS_END) + (size_t)bx * 256 * 128, 128, (const float*)(ws + WS_PART), (const LAS float*)(lds + RST_OFF), 0}};
                pg8::gemm_phase<pg8::EpiSwiGLULocal, pg8::StaticOrder, true, true>(lds + RING_OFF, g, S, E);
            }
            if (PROBE_DUP == 8 && RUN(ph)) {
                pg8::Gemm g{Hb, (const bf16*)(ws + WS_WGU + (size_t)(l * 2 + f) * SZ_WGU), M, NGU, DM};
#if PROBE_KL == 3
                pg8::ProbeOrder S; S.init(M, NGU, G, bx);
                pg8::EpiNull E{(float*)(ws + WS_END)};
                pg8::gemm_phase<pg8::EpiNull, pg8::ProbeOrder, true, true>(lds + RING_OFF, g, S, E);
#else
                pg8::StaticOrder S; S.init(M, NGU, G, bx);
                pg8::EpiNull E{(float*)(ws + WS_END)};
                pg8::gemm_phase<pg8::EpiNull, pg8::StaticOrder, true, true>(lds + RING_OFF, g, S, E);
#endif
            }
            if (RUN(ph)) REP(3) {
                pg8::Gemm g{Hb, (const bf16*)(ws + WS_WGU + (size_t)(l * 2 + f) * SZ_WGU), M, NGU, DM}; pg8::StaticOrder S; S.init(M, NGU, G, bx);
                pg8::Unit u0; S.next(0, u0); pg8::build_rstd_table((LAS float*)(lds + RST_OFF), (const float*)(ws + WS_PART), u0.pm, opaque_tid());
                pg8::EpiSwiGLU E{ACT, FF, (const float*)(ws + WS_PART), (const LAS float*)(lds + RST_OFF), u0.pm};
                pg8::gemm_phase<pg8::EpiSwiGLU, pg8::StaticOrder, true, true>(lds + RING_OFF, g, S, E);
            }
            SEAM(ph); ++ph;
            if (RUN(ph)) REP(6) {
                pg8::Gemm g{ACT, (const bf16*)(ws + WS_WD + (size_t)(l * 2 + f) * SZ_WD), M, DM, FF}; pg8::StaticOrder S; S.init(M, DM, G, bx);
#if RESID_BF16
                pg8::EpiResidB E{(PROBE_DUP == 6 && rep_ == 0) ? (bf16*)(ws + WS_END) : Hb, (float*)(ws + WS_PART), DM, 0.5f};
                pg8::gemm_phase<pg8::EpiResidB, pg8::StaticOrder, true, true>(lds + RING_OFF, g, S, E);
#else
                pg8::EpiResid E{xsrc, (PROBE_DUP == 6 && rep_ == 0) ? (float*)(ws + WS_END) : a.out, Hb, (float*)(ws + WS_PART), DM, 0.5f};
                pg8::gemm_phase<pg8::EpiResid, pg8::StaticOrder, true, true>(lds + RING_OFF, g, S, E);
#endif
            }
            SEAM(ph); ++ph;
        } else {
            if (RUN(ph) && (l == 0 || l == 3)) {
                LANE_IDS();
                const int fr = lane & 15, fq = lane >> 4;
                const bf16* wf = (const bf16*)(ws + WS_WF) + (size_t)(l ? 1 : 0) * 16 * DM + (size_t)fr * DM + 8 * fq;
                const float* bfp = (l == 0) ? a.b_f0 : a.b_f3;
                for (int rgl = gidx * NWAVES + wave; rgl < SEQ / 16; rgl += (G / 8) * NWAVES) { const int rg = grp * (SEQ / 16) + rgl;
                    const bf16* ap = Hb + (size_t)(rg * 16 + fr) * DM + 8 * fq;
                    f32x4 acc = {0.f, 0.f, 0.f, 0.f};
#pragma unroll 8
                    for (int k0 = 0; k0 < DM; k0 += 32) { const bf16x8 av = *(const GAS bf16x8*)(ap + k0), bv = *(const GAS bf16x8*)(wf + k0);
                        acc = __builtin_amdgcn_mfma_f32_16x16x32_bf16(bv, av, acc, 0, 0, 0); }
                    const float r = pg8::row_rstd((const float*)(ws + WS_PART), rg * 16 + fr, fq);
                    const f32x4 bb = *(const GAS f32x4*)(bfp + 4 * fq);
                    f32x4 o;
#pragma unroll
                    for (int i = 0; i < 4; ++i) { const float z = acc[i] * r + bb[i]; o[i] = fminf(z, 0.f) - __logf(1.0f + __expf(-fabsf(z))); }
                    *(GAS f32x4*)(LF + (size_t)(rg * 16 + fr) * 16 + 4 * fq) = o;
                }
            }
            if (RUN(ph)) _Pragma("unroll 1") for (int rep_ = 0; rep_ < ((PROBE_DUP == 4 || PROBE_DUP == 13) ? 2 : 1); ++rep_) {
                pg8::Gemm g{Hb, (const bf16*)(ws + WS_WQKV + (size_t)l * SZ_WQKV), M, NQKV, DM}; pg8::StaticOrder S; S.init(M, NQKV, G, bx);
                pg8::Unit u0; S.next(0, u0); pg8::build_rstd_table((LAS float*)(lds + RST_OFF), (const float*)(ws + WS_PART), u0.pm, opaque_tid());
                pg8::EpiBf16 E{(PROBE_DUP == 13 && rep_ == 0) ? (bf16*)(ws + WS_END) + (size_t)bx * 256 * 256 : QKV, (PROBE_DUP == 13 && rep_ == 0) ? 256 : NQKV, (const float*)(ws + WS_PART), (const LAS float*)(lds + RST_OFF), u0.pm, (PROBE_DUP == 13 && rep_ == 0) ? 1 : 0, (l % 3 == 0) ? (unsigned*)ws + CW_KMAX + (l ? 512 : 0) : nullptr};
                pg8::gemm_phase<pg8::EpiBf16, pg8::StaticOrder, true, true>(lds + RING_OFF, g, S, E);
            }
            SEAM(ph); ++ph;
            if (RUN(ph)) REP(5) {
                LANE_IDS();
                const int mixer = l % 3;
                LAS char* al = (LAS char*)(lds + RING_OFF);
                LAS float* tab = (LAS float*)(al + att::L_TAB);
                LAS float* scan = (LAS float*)(al + att::L_SCAN);
                for (int j = gidx; j < NH * 4; j += G / 8) {
                    const int b = grp, h = j >> 2, xq = (j & 32) ? 3 - (j & 3) : (j & 3);
                    const bf16* Qh = QKV + (size_t)b * SEQ * NQKV + h * HD; const bf16* Kh = Qh + DM; const bf16* Vh = Qh + 2 * DM;
                    bf16* Oh = AO + (size_t)b * SEQ * DM + h * HD;
                    __syncthreads();
                    int tmul = 0, tadd = 0;
                    const int kcov = SEQ;
                    if (mixer == 0) {
                        const float* lf = LF + (size_t)b * SEQ * 16 + h;
                        const float v0 = lf[(size_t)(4 * tid) * 16], v1 = lf[(size_t)(4 * tid + 1) * 16], v2 = lf[(size_t)(4 * tid + 2) * 16], v3 = lf[(size_t)(4 * tid + 3) * 16];
                        const float a0 = v0, a1 = a0 + v1, a2 = a1 + v2, a3 = a2 + v3;
                        float inc = a3;
#pragma unroll
                        for (int d = 1; d < 64; d <<= 1) { const float y = __shfl_up(inc, d); if (lane >= d) inc += y; }
                        if (lane == 63) scan[wave] = inc;
                        __syncthreads();
                        float pre = inc - a3;
                        for (int w = 0; w < wave; ++w) pre += scan[w];
                        const float ns = -11.313708498984761f;
                        tab[4 * tid] = (pre + a0) * ns; tab[4 * tid + 1] = (pre + a1) * ns; tab[4 * tid + 2] = (pre + a2) * ns; tab[4 * tid + 3] = (pre + a3) * ns;
                    } else if (mixer == 1) {
                        const float* rb = a.rel_bias + h * 32;
                        for (int j = tid; j < att::TAB_N; j += NWAVES * 64) {
                            const int d = 2047 - j; float v = 0.f;
                            if (d >= 0) { const int mult = (d <= 128 ? 1 : 0) + (((d & 3) == 0 && d <= 512) ? 1 : 0) + (((d & 15) == 0) ? 1 : 0);
                                v = (mult == 0) ? -__builtin_inff() : (rb[t5_bucket(d)] + (mult == 1 ? 0.f : (mult == 2 ? 0.6931471805599453f : 1.0986122886681098f))) * 11.313708498984761f; }
                            tab[j] = v; }
                        tmul = -1; tadd = 2047;
                    }
                    float kmaxh = 0.f;
                    if (mixer == 0) {
                        unsigned* kp = (unsigned*)ws + CW_KMAX + (l ? 512 : 0) + (b * 16 + h) * 4; float k2m = 0.f;
#pragma unroll
                        for (int w = 0; w < 4; ++w) k2m += __uint_as_float(__hip_atomic_load(kp + w, __ATOMIC_RELAXED, __HIP_MEMORY_SCOPE_AGENT));
                        kmaxh = sqrtf(k2m) * 1.002f; }
#pragma unroll 1
                    for (int pass = 0; pass < 2; ++pass) {
                        const int qb = pass ? 7 - xq : xq, P0 = qb * att::QB;
                        if (mixer == 2) att::attn_block<1>(Qh + (size_t)P0 * NQKV, Kh, Vh, Oh + (size_t)P0 * DM, P0, al, 0, 0, 0.f, 0);
                        else att::attn_block<0>(Qh + (size_t)P0 * NQKV, Kh, Vh, Oh + (size_t)P0 * DM, P0, al, tmul, tadd, kmaxh, kcov);
                    }
                }
            }
            SEAM(ph); ++ph;
            if (RUN(ph)) REP(7) {
                pg8::Gemm g{AO, (const bf16*)(ws + WS_WO + (size_t)l * SZ_WO), M, DM, DM}; pg8::StaticOrder S; S.init(M, DM, G, bx);
#if RESID_BF16
                pg8::EpiResidB E{(PROBE_DUP == 7 && rep_ == 0) ? (bf16*)(ws + WS_ACT) : Hb, (float*)(ws + WS_PART), DM, 1.0f};
                pg8::gemm_phase<pg8::EpiResidB, pg8::StaticOrder, true, true>(lds + RING_OFF, g, S, E);
#else
                pg8::EpiResid E{a.out, (PROBE_DUP == 7 && rep_ == 0) ? (float*)(ws + WS_ACT) : a.out, Hb, (float*)(ws + WS_PART), DM, 1.0f};
                pg8::gemm_phase<pg8::EpiResid, pg8::StaticOrder, true, true>(lds + RING_OFF, g, S, E);
#endif
            }
            SEAM(ph); ++ph;
        }
    }
    if (RUN(ph)) {
        LANE_IDS();
        f32x4 gv[8];
#pragma unroll
        for (int j = 0; j < 8; ++j) gv[j] = *((const GAS f32x4*)a.final_g + lane + 64 * j);
        for (int ml = gidx * NWAVES + wave; ml < SEQ; ml += (G / 8) * NWAVES) { const int m = grp * SEQ + ml;
            GAS f32x4* xr = (GAS f32x4*)(a.out + (size_t)m * DM) + lane;
            f32x4 v[8]; float ss = 0.f;
#pragma unroll
            for (int j = 0; j < 8; ++j) {
#if RESID_BF16
                const v2u w = *((const GAS v2u*)(Hb + (size_t)m * DM) + lane + 64 * j);
                v[j] = (f32x4){__uint_as_float(w.x << 16), __uint_as_float(w.x & 0xffff0000u), __uint_as_float(w.y << 16), __uint_as_float(w.y & 0xffff0000u)};
#else
                v[j] = xr[64 * j];
#endif
                ss += (v[j].x * v[j].x + v[j].y * v[j].y) + (v[j].z * v[j].z + v[j].w * v[j].w); }
            const float rstd = 1.0f / sqrtf(wave_sum(ss) * (1.0f / DM) + RMS_EPS);
#pragma unroll
            for (int j = 0; j < 8; ++j) xr[64 * j] = v[j] * rstd * gv[j];
        }
    }
#undef RUN
#undef SEAM
}
constexpr int N_PHASES = 1 + DEPTH * 7 + 1;

extern "C" void kernel_launch(void* const* d_in, const int* in_sizes, int n_in, void* d_out, int out_size, void* d_ws, size_t ws_size, hipStream_t stream) {
    static int grid = 0;
    if (grid == 0) {
        if (n_in != 14 || in_sizes[0] != M * DM || out_size != M * DM || ws_size < WS_END + (PROBE_DUP == 6 ? (size_t)M * DM * 4 : 0) + (PROBE_DUP == 8 ? 4096 : 0) + (PROBE_DUP == 10 ? (size_t)256 * 65536 : 0) + ((PROBE_DUP == 13) ? (size_t)256 * 131072 : 0)) {
            fprintf(stderr, "kernel_launch: unexpected shapes (n_in %d, in0 %d, out %d, ws %zu < %zu?); nothing launched\n", n_in, n_in > 0 ? in_sizes[0] : -1, out_size, ws_size, (size_t)WS_END); grid = -1; return; }
        int dev = 0, cus = 0;
        if (hipGetDevice(&dev) != hipSuccess || hipDeviceGetAttribute(&cus, hipDeviceAttributeMultiprocessorCount, dev) != hipSuccess) { grid = -1; return; }
        if (hipFuncSetAttribute((const void*)mk_fwd, hipFuncAttributeMaxDynamicSharedMemorySize, LDS_BYTES) != hipSuccess) { fprintf(stderr, "kernel_launch: hipFuncSetAttribute failed\n"); grid = -1; return; }
        int per_cu = 0;
        if (hipOccupancyMaxActiveBlocksPerMultiprocessor(&per_cu, (const void*)mk_fwd, NWAVES * 64, LDS_BYTES) != hipSuccess || per_cu < 1)
            fprintf(stderr, "kernel_launch: note: occupancy query reports %d workgroups per CU\n", per_cu);
        (void)hipGetLastError();
        grid = cus;
        if (grid != 256) { fprintf(stderr, "kernel_launch: built for a 256-CU device (8 groups of 32 workgroups own the 8 batch elements); found %d CUs; nothing launched\n", grid); grid = -1; return; }
    }
    if (grid < 0) return;
    if (hipMemsetAsync((char*)d_ws + WS_CTL, 0, CTL_ZERO_BYTES, stream) != hipSuccess) return;
    Args a{};
    a.x = (const float*)d_in[0]; a.norm_g = (const float*)d_in[1]; a.w_gate = (const float*)d_in[2]; a.w_up = (const float*)d_in[3]; a.w_down = (const float*)d_in[4];
    a.w_in[0] = (const float*)d_in[5]; a.b_f0 = (const float*)d_in[6]; a.w_in[1] = (const float*)d_in[7]; a.w_in[2] = (const float*)d_in[8]; a.w_in[3] = (const float*)d_in[9];
    a.b_f3 = (const float*)d_in[10]; a.w_out = (const float*)d_in[11]; a.rel_bias = (const float*)d_in[12]; a.final_g = (const float*)d_in[13];
    a.out = (float*)d_out; a.ws = (unsigned char*)d_ws;
#if MK_ONE_LAUNCH
    a.ph_lo = 0; a.ph_hi = N_PHASES;
    hipLaunchKernelGGL(mk_fwd, dim3(grid), dim3(NWAVES * 64), LDS_BYTES, stream, a);
#else
    for (int p = 0; p < N_PHASES; ++p) { a.ph_lo = p; a.ph_hi = p + 1; hipLaunchKernelGGL(mk_fwd, dim3(grid), dim3(NWAVES * 64), LDS_BYTES, stream, a); }
#endif
    const hipError_t le = hipPeekAtLastError();
    if (le != hipSuccess) fprintf(stderr, "kernel_launch: launch failed: %s\n", hipGetErrorName(le));
}
```

```cpp
#include <hip/hip_runtime.h>
#include <cstdio>
#include <cstdint>

#ifndef PROBE_DUP
#define PROBE_DUP 0
#endif
#define REP(k) _Pragma("unroll 1") for (int rep_ = 0; rep_ < ((PROBE_DUP == (k)) ? 2 : 1); ++rep_)
#ifndef PROBE_KL
#define PROBE_KL 0
#endif
#ifndef EPI_RELAX
#define EPI_RELAX 0
#endif
#ifndef RESID_BF16
#define RESID_BF16 1
#endif
#ifndef MK_ONE_LAUNCH
#define MK_ONE_LAUNCH 1
#endif

namespace pg8 {
#define PG8_LAS __attribute__((address_space(3)))
typedef unsigned short bf16_t;
typedef short bf16x8 __attribute__((ext_vector_type(8)));
typedef float f32x4 __attribute__((ext_vector_type(4)));
typedef unsigned u32x4 __attribute__((ext_vector_type(4)));
constexpr int BM = 256, BK = 64, HALF = 128, HTB = HALF * BK * 2, STAGE_BYTES = 8 * HTB, NXCD = 8, WGM = 8;

__host__ __device__ __forceinline__ int lds_byte(int r, int c) { const int st = (r >> 4) * 2 + (c >> 5), rr = r & 15, cc = c & 31, ob = rr * 64 + cc * 2; return st * 1024 + (ob ^ (((ob >> 9) & 1) << 5)); }
__host__ __device__ __forceinline__ void stage_rc(int b, int& R, int& C) { const int st = b / 1024, sb = b % 1024, swz = sb ^ (((sb >> 9) & 1) << 5); R = (st >> 1) * 16 + swz / 64; C = (st & 1) * 32 + (swz % 64) / 2; }
__host__ __device__ __forceinline__ int perm32(int rho) { const int n = rho >> 4, i = rho & 15; return 8 * (i >> 2) + 4 * n + (i & 3); }

typedef __bf16 bf16x2e __attribute__((ext_vector_type(2)));
struct Unit { int pm, pn; };
struct Gemm { const bf16_t* A; const bf16_t* Bt; int M, N, K; };

struct StaticOrder {
    int nM, nN, nwg, G, c;
    __host__ __device__ void init(int M, int N, int G_, int c_) { nM = M / BM; nN = N / BM; nwg = nM * nN; G = G_; c = c_; }
    __host__ __device__ __forceinline__ bool next(int i, Unit& u) const {
        const long L = (long)i * G + c; if (L >= nwg) return false;
        int wgid = (int)L; { const int q = nwg / NXCD, r = nwg % NXCD, xcd = wgid % NXCD, off = wgid / NXCD; wgid = (xcd < r ? xcd * (q + 1) : r * (q + 1) + (xcd - r) * q) + off; }
        const int nig = WGM * nN, gid = wgid / nig, fm = gid * WGM, gsz = (nM - fm) < WGM ? (nM - fm) : WGM;
        u.pm = fm + ((wgid % nig) % gsz); u.pn = (wgid % nig) / gsz; return true;
    }
    __device__ __forceinline__ void a_ready(const Unit&) const {}
    __device__ __forceinline__ void done(const Unit&) const {}
};

typedef float f32x2c __attribute__((ext_vector_type(2)));
typedef __bf16 bf16x2c __attribute__((ext_vector_type(2)));
__device__ __forceinline__ unsigned cvt_pk_bf16(float lo, float hi) { const f32x2c v = {lo, hi}; return __builtin_bit_cast(unsigned, __builtin_convertvector(v, bf16x2c)); }

__device__ __forceinline__ float fq_sum(float s) {
    { auto rr = __builtin_amdgcn_permlane16_swap(__float_as_uint(s), __float_as_uint(s), false, false); s = __uint_as_float(rr[0]) + __uint_as_float(rr[1]); }
    { auto rr = __builtin_amdgcn_permlane32_swap(__float_as_uint(s), __float_as_uint(s), false, false); s = __uint_as_float(rr[0]) + __uint_as_float(rr[1]); }
    return s;
}
__device__ __forceinline__ float row_rstd(const float* part, int row, int fq) {
    const f32x4 a = *(const f32x4*)(part + (size_t)row * 32 + fq * 8), b = *(const f32x4*)(part + (size_t)row * 32 + fq * 8 + 4);
    const float s = fq_sum(((a[0] + a[1]) + (a[2] + a[3])) + ((b[0] + b[1]) + (b[2] + b[3])));
    return __builtin_amdgcn_rsqf(s * (1.0f / 2048.0f) + 1e-6f);
}
__device__ __forceinline__ void build_rstd_table(PG8_LAS float* rst, const float* part, int pm0, int tid) {
    if (tid < 256) { const f32x4* p = (const f32x4*)(part + (size_t)(pm0 * BM + tid) * 32); float s = 0.f;
#pragma unroll
        for (int j = 0; j < 8; ++j) { const f32x4 v = p[j]; s += (v[0] + v[1]) + (v[2] + v[3]); }
        rst[tid] = __builtin_amdgcn_rsqf(s * (1.0f / 2048.0f) + 1e-6f); }
    __syncthreads();
}
struct EpiBf16 {
    static constexpr bool PERM = true, AFTER_DRAIN = false; static constexpr int KL = 0; static constexpr int NVM = 16;
    bf16_t* O; int ldc; const float* part; const PG8_LAS float* rst; int pm0; int local;
    unsigned* kmaxp;
    __device__ __forceinline__ void operator()(const f32x4 (&acc)[2][2][4][2], const Unit& u, int wr, int wc, int fr, int fq) const {
        const int row0 = (local ? 0 : u.pm * BM) + wr * 64 + fr, col0 = (local ? 0 : u.pn * BM) + wc * 32 + 8 * fq;
        const bool kn = (kmaxp != nullptr) && u.pn >= 8 && u.pn < 16;
        float km0 = 0.f, km1 = 0.f;
        float rs[2][4];
        if (u.pm == pm0) {
#pragma unroll
            for (int ai = 0; ai < 2; ++ai)
#pragma unroll
                for (int m = 0; m < 4; ++m) rs[ai][m] = rst[wr * 64 + fr + ai * HALF + m * 16];
        } else {
#pragma unroll
            for (int ai = 0; ai < 2; ++ai)
#pragma unroll
                for (int m = 0; m < 4; ++m) rs[ai][m] = row_rstd(part, row0 + ai * HALF + m * 16, fq);
        }
#pragma unroll
        for (int ai = 0; ai < 2; ++ai)
#pragma unroll
            for (int m = 0; m < 4; ++m) { bf16_t* rowp = O + (size_t)(row0 + ai * HALF + m * 16) * ldc + col0; const float r = rs[ai][m];
#pragma unroll
                for (int bj = 0; bj < 2; ++bj) { const f32x4 v0 = acc[ai][bj][m][0] * r, v1 = acc[ai][bj][m][1] * r;
                    u32x4 w; w.x = cvt_pk_bf16(v0[0], v0[1]); w.y = cvt_pk_bf16(v0[2], v0[3]); w.z = cvt_pk_bf16(v1[0], v1[1]); w.w = cvt_pk_bf16(v1[2], v1[3]);
                    *(u32x4*)(rowp + bj * HALF) = w;
                    if (kn) { float q = __builtin_amdgcn_fdot2_f32_bf16(__builtin_bit_cast(bf16x2e, w.x), __builtin_bit_cast(bf16x2e, w.x), 0.f, false);
                        q = __builtin_amdgcn_fdot2_f32_bf16(__builtin_bit_cast(bf16x2e, w.y), __builtin_bit_cast(bf16x2e, w.y), q, false);
                        q = __builtin_amdgcn_fdot2_f32_bf16(__builtin_bit_cast(bf16x2e, w.z), __builtin_bit_cast(bf16x2e, w.z), q, false);
                        q = __builtin_amdgcn_fdot2_f32_bf16(__builtin_bit_cast(bf16x2e, w.w), __builtin_bit_cast(bf16x2e, w.w), q, false);
                        q = fq_sum(q); if (bj == 0) km0 = fmaxf(km0, q); else km1 = fmaxf(km1, q); } } }
        if (kn) {
#pragma unroll
            for (int d = 1; d < 16; d <<= 1) { km0 = fmaxf(km0, __shfl_xor(km0, d)); km1 = fmaxf(km1, __shfl_xor(km1, d)); }
            if ((fr | fq) == 0) { unsigned* kp = kmaxp + (((u.pm >> 3) * 16 + 2 * (u.pn - 8)) * 4 + wc);
                (void)__hip_atomic_fetch_max(kp, __float_as_uint(km0), __ATOMIC_RELAXED, __HIP_MEMORY_SCOPE_AGENT);
                (void)__hip_atomic_fetch_max(kp + 4, __float_as_uint(km1), __ATOMIC_RELAXED, __HIP_MEMORY_SCOPE_AGENT); }
        }
    }
};
typedef float f32x2 __attribute__((ext_vector_type(2)));
__device__ __forceinline__ f32x2 silu_mul2(f32x2 g, f32x2 u, float nrl  , float r2  ) {
    const f32x2 a = g * nrl; f32x2 e; e.x = __builtin_amdgcn_exp2f(a.x); e.y = __builtin_amdgcn_exp2f(a.y);
    const f32x2 d = e + 1.0f; f32x2 s; s.x = __builtin_amdgcn_rcpf(d.x); s.y = __builtin_amdgcn_rcpf(d.y);
    return (g * u) * (s * r2);
}
struct EpiSwiGLU {
    static constexpr bool PERM = true, AFTER_DRAIN = false; static constexpr int KL = 0; static constexpr int NVM = 8;
    bf16_t* O; int ldc; const float* part; const PG8_LAS float* rst; int pm0;
    __device__ __forceinline__ void operator()(const f32x4 (&acc)[2][2][4][2], const Unit& u, int wr, int wc, int fr, int fq) const {
        const int row0 = u.pm * BM + wr * 64 + fr, col0 = u.pn * HALF + wc * 32 + 8 * fq;
        float rs[2][4];
        if (u.pm == pm0) {
#pragma unroll
            for (int ai = 0; ai < 2; ++ai)
#pragma unroll
                for (int m = 0; m < 4; ++m) rs[ai][m] = rst[wr * 64 + fr + ai * HALF + m * 16];
        } else {
#pragma unroll
            for (int ai = 0; ai < 2; ++ai)
#pragma unroll
                for (int m = 0; m < 4; ++m) rs[ai][m] = row_rstd(part, row0 + ai * HALF + m * 16, fq);
        }
#pragma unroll
        for (int ai = 0; ai < 2; ++ai)
#pragma unroll
            for (int m = 0; m < 4; ++m) { bf16_t* rowp = O + (size_t)(row0 + ai * HALF + m * 16) * ldc + col0; const float r = rs[ai][m], nrl = r * -1.4426950408889634f, r2 = r * r;
                const f32x4 g0 = acc[ai][0][m][0], g1 = acc[ai][0][m][1], u0 = acc[ai][1][m][0], u1 = acc[ai][1][m][1];
                const f32x2 a = silu_mul2((f32x2){g0[0], g0[1]}, (f32x2){u0[0], u0[1]}, nrl, r2), b = silu_mul2((f32x2){g0[2], g0[3]}, (f32x2){u0[2], u0[3]}, nrl, r2);
                const f32x2 c = silu_mul2((f32x2){g1[0], g1[1]}, (f32x2){u1[0], u1[1]}, nrl, r2), d = silu_mul2((f32x2){g1[2], g1[3]}, (f32x2){u1[2], u1[3]}, nrl, r2);
                u32x4 w; w.x = cvt_pk_bf16(a.x, a.y); w.y = cvt_pk_bf16(b.x, b.y); w.z = cvt_pk_bf16(c.x, c.y); w.w = cvt_pk_bf16(d.x, d.y);
                *(u32x4*)rowp = w; }
    }
};
struct EpiResid {
    static constexpr bool PERM = true, AFTER_DRAIN = false; static constexpr int KL = 0; static constexpr int NVM = 32;
    const float* base; float* out; bf16_t* xb; float* part; int ldc; float alpha;
    __device__ __forceinline__ void operator()(const f32x4 (&acc)[2][2][4][2], const Unit& u, int wr, int wc, int fr, int fq) const {
        const int row0 = u.pm * BM + wr * 64 + fr, col0 = u.pn * BM + wc * 32 + 8 * fq;
#pragma unroll
        for (int ai = 0; ai < 2; ++ai)
#pragma unroll
            for (int m = 0; m < 4; ++m) { const int row = row0 + ai * HALF + m * 16; const size_t off = (size_t)row * ldc + col0; float s = 0.f;
#pragma unroll
                for (int bj = 0; bj < 2; ++bj) { const f32x4 b0 = *(const f32x4*)(base + off + bj * HALF), b1 = *(const f32x4*)(base + off + bj * HALF + 4);
                    const f32x4 o0 = b0 + alpha * acc[ai][bj][m][0], o1 = b1 + alpha * acc[ai][bj][m][1];
                    *(f32x4*)(out + off + bj * HALF) = o0; *(f32x4*)(out + off + bj * HALF + 4) = o1;
                    u32x4 w; w.x = cvt_pk_bf16(o0[0], o0[1]); w.y = cvt_pk_bf16(o0[2], o0[3]); w.z = cvt_pk_bf16(o1[0], o1[1]); w.w = cvt_pk_bf16(o1[2], o1[3]);
                    *(u32x4*)(xb + off + bj * HALF) = w;
                    s += ((o0[0] * o0[0] + o0[1] * o0[1]) + (o0[2] * o0[2] + o0[3] * o0[3])) + ((o1[0] * o1[0] + o1[1] * o1[1]) + (o1[2] * o1[2] + o1[3] * o1[3])); }
                s = fq_sum(s);
                if (fq == 0) part[(size_t)row * 32 + u.pn * 4 + wc] = s;
                if (m & 1) asm volatile("" ::: "memory"); }
    }
};

struct EpiResidB {
    static constexpr bool PERM = true, AFTER_DRAIN = false; static constexpr int KL = 0; static constexpr int NVM = 32;
    bf16_t* xb; float* part; int ldc; float alpha;
    __device__ __forceinline__ void operator()(const f32x4 (&acc)[2][2][4][2], const Unit& u, int wr, int wc, int fr, int fq) const {
        const int row0 = u.pm * BM + wr * 64 + fr, col0 = u.pn * BM + wc * 32 + 8 * fq;
#pragma unroll
        for (int ai = 0; ai < 2; ++ai)
#pragma unroll
            for (int m = 0; m < 4; ++m) { const int row = row0 + ai * HALF + m * 16; const size_t off = (size_t)row * ldc + col0; float s = 0.f;
#pragma unroll
                for (int bj = 0; bj < 2; ++bj) { const u32x4 b = *(const u32x4*)(xb + off + bj * HALF);
                    const f32x4 b0 = {__uint_as_float(b.x << 16), __uint_as_float(b.x & 0xffff0000u), __uint_as_float(b.y << 16), __uint_as_float(b.y & 0xffff0000u)};
                    const f32x4 b1 = {__uint_as_float(b.z << 16), __uint_as_float(b.z & 0xffff0000u), __uint_as_float(b.w << 16), __uint_as_float(b.w & 0xffff0000u)};
                    const f32x4 o0 = b0 + alpha * acc[ai][bj][m][0], o1 = b1 + alpha * acc[ai][bj][m][1];
                    u32x4 w; w.x = cvt_pk_bf16(o0[0], o0[1]); w.y = cvt_pk_bf16(o0[2], o0[3]); w.z = cvt_pk_bf16(o1[0], o1[1]); w.w = cvt_pk_bf16(o1[2], o1[3]);
                    *(u32x4*)(xb + off + bj * HALF) = w;
                    const f32x4 r0 = {__uint_as_float(w.x << 16), __uint_as_float(w.x & 0xffff0000u), __uint_as_float(w.y << 16), __uint_as_float(w.y & 0xffff0000u)};
                    const f32x4 r1 = {__uint_as_float(w.z << 16), __uint_as_float(w.z & 0xffff0000u), __uint_as_float(w.w << 16), __uint_as_float(w.w & 0xffff0000u)};
                    s += ((r0[0] * r0[0] + r0[1] * r0[1]) + (r0[2] * r0[2] + r0[3] * r0[3])) + ((r1[0] * r1[0] + r1[1] * r1[1]) + (r1[2] * r1[2] + r1[3] * r1[3])); }
                s = fq_sum(s);
                if (fq == 0) part[(size_t)row * 32 + u.pn * 4 + wc] = s; }
    }
};
struct ProbeOrder : StaticOrder {
    __host__ __device__ bool next(int i, Unit& u) const { const bool r = StaticOrder::next(i, u); u.pm = c & 7; u.pn = (c >> 3) & 3; return r; }
};
struct EpiSwiGLULocal {
    static constexpr bool PERM = true, AFTER_DRAIN = false; static constexpr int KL = 0; static constexpr int NVM = 8;
    EpiSwiGLU inner;
    __device__ __forceinline__ void operator()(const f32x4 (&acc)[2][2][4][2], const Unit& u, int wr, int wc, int fr, int fq) const {
        Unit v; v.pm = 0; v.pn = 0; EpiSwiGLU e = inner; e.pm0 = 0; e(acc, v, wr, wc, fr, fq);
    }
};
struct EpiNull {
    static constexpr bool PERM = true, AFTER_DRAIN = false; static constexpr int KL = PROBE_KL; static constexpr int NVM = 0;
    float* sink;
    __device__ __forceinline__ void operator()(const f32x4 (&acc)[2][2][4][2], const Unit& u, int wr, int wc, int fr, int fq) const {
        f32x4 t = {0.f, 0.f, 0.f, 0.f};
#pragma unroll
        for (int ai = 0; ai < 2; ++ai)
#pragma unroll
            for (int bj = 0; bj < 2; ++bj)
#pragma unroll
                for (int m = 0; m < 4; ++m)
#pragma unroll
                    for (int n = 0; n < 2; ++n) t += acc[ai][bj][m][n];
        if ((t[0] + t[1]) + (t[2] + t[3]) == 1.2345678e30f) sink[0] = 1.f;
    }
};
template <class Epi, class Sched, bool ALIGN_EPI = false, bool SP2 = false>
__device__ __forceinline__ void gemm_phase(PG8_LAS unsigned char* lds, const Gemm g, const Sched& S, const Epi& E) {
    int tid = threadIdx.x; asm volatile("" : "+v"(tid));
    const int wid = __builtin_amdgcn_readfirstlane(tid >> 6), lane = tid & 63, wr = wid >> 2, wc = wid & 3, fr = lane & 15, fq = lane >> 4;
    constexpr int KL_ = Epi::KL;
    const int K = g.K, nt = K / BK;
    unsigned voffA[2], voffB[2];
#pragma unroll
    for (int i = 0; i < 2; ++i) { int R, C; stage_rc(tid * 16 + i * 8192, R, C); const int Rb = Epi::PERM ? ((R & ~31) + perm32(R & 31)) : R;
        voffA[i] = (unsigned)(R * K + C) * 2u; voffB[i] = (unsigned)(Rb * K + C) * 2u; }
    const size_t kstep = (size_t)(BK * 2);
    const size_t hstep = (size_t)HALF * K * 2;
    const size_t tstep = 2 * hstep;
    const unsigned ldsw = (unsigned)wid * 1024u;
    const int aoff = lds_byte(wr * 64 + fr, fq * 8), boff = lds_byte(wc * 32 + fr, fq * 8);
#define PG8_SA(b, h) (((b) * 2 + (h)) * HTB)
#define PG8_SB(b, h) ((4 + (b) * 2 + (h)) * HTB)
#define PG8_STAGE(bufoff, gbase, voff) do { _Pragma("unroll") for (int _i = 0; _i < 2; ++_i) \
        __builtin_amdgcn_global_load_lds((const unsigned*)((const char*)(gbase) + (voff)[_i]), (PG8_LAS unsigned*)(lds + (bufoff) + ldsw + _i * 8192), 16, 0, 0); } while (0)
#define PG8_LDA(dst, b, h) do { _Pragma("unroll") for (int m = 0; m < 4; ++m) _Pragma("unroll") for (int k = 0; k < 2; ++k) dst[m][k] = *(const PG8_LAS bf16x8*)(lds + PG8_SA(b, h) + aoff + m * 2048 + k * 1024); } while (0)
#define PG8_LDB(dst, b, h) do { _Pragma("unroll") for (int n = 0; n < 2; ++n) _Pragma("unroll") for (int k = 0; k < 2; ++k) dst[n][k] = *(const PG8_LAS bf16x8*)(lds + PG8_SB(b, h) + boff + n * 2048 + k * 1024); } while (0)
#define PG8_MMA(ai, bj, At, Bt) do { __builtin_amdgcn_s_setprio(1); _Pragma("unroll") for (int m = 0; m < 4; ++m) _Pragma("unroll") for (int n = 0; n < 2; ++n) _Pragma("unroll") for (int k = 0; k < 2; ++k) \
        acc[ai][bj][m][n] = __builtin_amdgcn_mfma_f32_16x16x32_bf16(Bt[n][k], At[m][k], acc[ai][bj][m][n], 0, 0, 0); __builtin_amdgcn_s_setprio(0); } while (0)
#define PG8_WAIT_V(n) asm volatile("s_waitcnt vmcnt(" #n ")" ::: "memory")
#define PG8_WAIT_L(n) asm volatile("s_waitcnt lgkmcnt(" #n ")" ::: "memory")
#define PG8_BAR __builtin_amdgcn_s_barrier()
#define PG8_SCHED __builtin_amdgcn_sched_barrier(0)
    Unit cur, nxt; int ui = 0;
    if (!S.next(0, cur)) return;
    f32x4 acc[2][2][4][2];
#pragma unroll
    for (int a = 0; a < 2; ++a)
#pragma unroll
        for (int b = 0; b < 2; ++b)
#pragma unroll
            for (int m = 0; m < 4; ++m)
#pragma unroll
                for (int n = 0; n < 2; ++n) acc[a][b][m][n] = (f32x4){0.f, 0.f, 0.f, 0.f};
    bf16x8 At[4][2], B0[2][2], B1[2][2];
    const char* cA = (const char*)g.A + (size_t)cur.pm * tstep; const char* cB = (const char*)g.Bt + (size_t)cur.pn * tstep;
    S.a_ready(cur);
    if constexpr (SP2) {
        PG8_STAGE(PG8_SB(0, 0), cB, voffB); PG8_STAGE(PG8_SB(0, 1), cB + hstep, voffB); PG8_STAGE(PG8_SA(0, 0), cA, voffA); PG8_STAGE(PG8_SA(0, 1), cA + hstep, voffA);
        PG8_STAGE(PG8_SB(1, 0), cB + kstep, voffB); PG8_STAGE(PG8_SA(1, 0), cA + kstep, voffA); PG8_STAGE(PG8_SB(1, 1), cB + hstep + kstep, voffB);
        if (wr == 1) PG8_BAR;
        PG8_WAIT_V(8); PG8_BAR;
        PG8_WAIT_V(6); PG8_BAR;
    } else {
        PG8_STAGE(PG8_SB(0, 0), cB, voffB); PG8_STAGE(PG8_SA(0, 0), cA, voffA); PG8_STAGE(PG8_SB(0, 1), cB + hstep, voffB); PG8_STAGE(PG8_SA(0, 1), cA + hstep, voffA);
        if (wr == 1) PG8_BAR;
        PG8_WAIT_V(4); PG8_BAR;
        PG8_STAGE(PG8_SB(1, 0), cB + kstep, voffB); PG8_STAGE(PG8_SA(1, 0), cA + kstep, voffA); PG8_STAGE(PG8_SB(1, 1), cB + hstep + kstep, voffB);
        PG8_WAIT_V(6); PG8_BAR;
    }
    for (;;) {
        const bool has_next = S.next(ui + 1, nxt);
        const char* nA = has_next ? (const char*)g.A + (size_t)nxt.pm * tstep : cA; const char* nB = has_next ? (const char*)g.Bt + (size_t)nxt.pn * tstep : cB;
        for (int t = 0; t < nt; t += 2) {
            const bool last = (t == nt - 2);
            const char* a1 = cA + (size_t)(t + 1) * kstep;
            const char* a2 = last ? nA : cA + (size_t)(t + 2) * kstep; const char* b2 = last ? nB : cB + (size_t)(t + 2) * kstep;
            const char* a3 = a2 + kstep; const char* b3 = b2 + kstep;
            if (last && has_next) S.a_ready(nxt);
            if constexpr (SP2) {
#define PG8_KT_PAIR(W1_, W2_) do { \
            if (KL_ != 4) { PG8_LDB(B0, 0, 0); PG8_LDB(B1, 0, 1); } PG8_SCHED; PG8_LDA(At, 0, 0); if (KL_ != 2) PG8_STAGE(PG8_SA(1, 1), a1 + hstep, voffA); \
            W1_; PG8_WAIT_L(0); PG8_BAR; PG8_MMA(0, 0, At, B0); PG8_MMA(0, 1, At, B1); PG8_BAR; PG8_SCHED; \
            if (KL_ != 1) PG8_LDA(At, 0, 1); if (KL_ != 2) { PG8_STAGE(PG8_SB(0, 0), b2, voffB); PG8_STAGE(PG8_SB(0, 1), b2 + hstep, voffB); PG8_STAGE(PG8_SA(0, 0), a2, voffA); } \
            W2_; PG8_WAIT_L(0); PG8_BAR; PG8_MMA(1, 0, At, B0); PG8_MMA(1, 1, At, B1); PG8_BAR; PG8_SCHED; \
            if (KL_ != 4) { PG8_LDB(B0, 1, 0); PG8_LDB(B1, 1, 1); } PG8_SCHED; PG8_LDA(At, 1, 0); if (KL_ != 2) PG8_STAGE(PG8_SA(0, 1), a2 + hstep, voffA); \
            PG8_WAIT_V(8); PG8_WAIT_L(0); PG8_BAR; PG8_MMA(0, 0, At, B0); PG8_MMA(0, 1, At, B1); PG8_BAR; PG8_SCHED; \
            if (KL_ != 1) PG8_LDA(At, 1, 1); if (KL_ != 2) { PG8_STAGE(PG8_SB(1, 0), b3, voffB); PG8_STAGE(PG8_SB(1, 1), b3 + hstep, voffB); PG8_STAGE(PG8_SA(1, 0), a3, voffA); } \
            PG8_WAIT_V(8); PG8_WAIT_L(0); PG8_BAR; PG8_MMA(1, 0, At, B0); PG8_MMA(1, 1, At, B1); PG8_BAR; PG8_SCHED; } while (0)
#define PG8_WAIT_VN(n_) asm volatile("s_waitcnt vmcnt(%0)" :: "n"(n_) : "memory")
            const int relax = (EPI_RELAX && t == 0 && ui > 0) ? 1 : 0;
#define PG8_WAIT_SEL() asm volatile("s_cmp_eq_u32 %0, 0\n\ts_cbranch_scc1 .Lw8_%=\n\ts_waitcnt vmcnt(%1)\n\ts_branch .Lwd_%=\n.Lw8_%=:\n\ts_waitcnt vmcnt(8)\n.Lwd_%=:" :: "s"(__builtin_amdgcn_readfirstlane(relax)), "n"(8 + Epi::NVM) : "scc", "memory")
            PG8_KT_PAIR(PG8_WAIT_SEL(), PG8_WAIT_SEL());
#undef PG8_WAIT_SEL
#undef PG8_KT_PAIR
#undef PG8_WAIT_VN
            } else {
            PG8_LDB(B0, 0, 0); PG8_SCHED; PG8_LDA(At, 0, 0); PG8_STAGE(PG8_SA(1, 1), a1 + hstep, voffA);
            PG8_WAIT_L(8); PG8_BAR; PG8_WAIT_L(0); PG8_MMA(0, 0, At, B0); PG8_BAR; PG8_SCHED;
            PG8_LDB(B1, 0, 1); PG8_STAGE(PG8_SB(0, 0), b2, voffB);
            PG8_BAR; PG8_WAIT_L(0); PG8_MMA(0, 1, At, B1); PG8_BAR;
            PG8_LDA(At, 0, 1); PG8_STAGE(PG8_SA(0, 0), a2, voffA);
            PG8_BAR; PG8_WAIT_L(0); PG8_MMA(1, 0, At, B0); PG8_BAR; PG8_SCHED;
            PG8_STAGE(PG8_SB(0, 1), b2 + hstep, voffB);
            PG8_WAIT_V(6); PG8_BAR; PG8_MMA(1, 1, At, B1); PG8_BAR;
            PG8_LDB(B0, 1, 0); PG8_SCHED; PG8_LDA(At, 1, 0); PG8_STAGE(PG8_SA(0, 1), a2 + hstep, voffA);
            PG8_WAIT_L(8); PG8_BAR; PG8_WAIT_L(0); PG8_MMA(0, 0, At, B0); PG8_BAR; PG8_SCHED;
            PG8_LDB(B1, 1, 1); PG8_STAGE(PG8_SB(1, 0), b3, voffB);
            PG8_BAR; PG8_WAIT_L(0); PG8_MMA(0, 1, At, B1); PG8_BAR;
            PG8_LDA(At, 1, 1); PG8_STAGE(PG8_SA(1, 0), a3, voffA);
            PG8_BAR; PG8_WAIT_L(0); PG8_MMA(1, 0, At, B0); PG8_BAR; PG8_SCHED;
            PG8_STAGE(PG8_SB(1, 1), b3 + hstep, voffB);
            PG8_WAIT_V(6); PG8_BAR; PG8_MMA(1, 1, At, B1); PG8_BAR;
            }
        }
        if constexpr (ALIGN_EPI) { if (wr == 0) PG8_BAR; }
        if constexpr (!Epi::AFTER_DRAIN) { E(acc, cur, wr, wc, fr, fq); S.done(cur); }
        if (!has_next) break;
#pragma unroll
        for (int a = 0; a < 2; ++a)
#pragma unroll
            for (int b = 0; b < 2; ++b)
#pragma unroll
                for (int m = 0; m < 4; ++m)
#pragma unroll
                    for (int n = 0; n < 2; ++n) acc[a][b][m][n] = (f32x4){0.f, 0.f, 0.f, 0.f};
        cur = nxt; cA = nA; cB = nB; ++ui;
        if constexpr (ALIGN_EPI) { if (wr == 1) PG8_BAR; }
    }
    PG8_WAIT_V(0);
    if constexpr (!ALIGN_EPI) { if (wr == 0) PG8_BAR; }
    PG8_BAR;
#undef PG8_SA
#undef PG8_SB
#undef PG8_STAGE
#undef PG8_LDA
#undef PG8_LDB
#undef PG8_MMA
#undef PG8_WAIT_V
#undef PG8_WAIT_L
#undef PG8_BAR
#undef PG8_SCHED
}
}

constexpr int DM = 2048, NBATCH = 8, SEQ = 2048, DEPTH = 4, NH = 16, HD = 128, FF = 5632;
constexpr int M = NBATCH * SEQ;
constexpr int NGU = 2 * FF, NQKV = 3 * DM;
constexpr float RMS_EPS = 1e-6f;
constexpr int NWAVES = 8;

constexpr size_t MiB = 1u << 20;
constexpr size_t WS_CTL = 0, CTL_ZERO_BYTES = 1 * MiB;
constexpr size_t WS_LF = 1 * MiB;
constexpr size_t WS_PART = 2 * MiB;
constexpr size_t WS_WF = 4 * MiB;
constexpr size_t WS_WGU = 5 * MiB;
constexpr size_t SZ_WGU = (size_t)NGU * DM * 2;
constexpr size_t WS_WD = WS_WGU + 8 * SZ_WGU;
constexpr size_t SZ_WD = (size_t)DM * FF * 2;
constexpr size_t WS_WQKV = WS_WD + 8 * SZ_WD;
constexpr size_t SZ_WQKV = (size_t)NQKV * DM * 2;
constexpr size_t WS_WO = WS_WQKV + 4 * SZ_WQKV;
constexpr size_t SZ_WO = (size_t)DM * DM * 2;
constexpr size_t WS_H = WS_WO + 4 * SZ_WO;
constexpr size_t WS_AO = WS_H + (size_t)M * DM * 2;
constexpr size_t WS_ACT = WS_AO + (size_t)M * DM * 2;
constexpr size_t WS_END = WS_ACT + (size_t)M * NQKV * 2;
static_assert(WS_WGU % 256 == 0 && WS_WD % 256 == 0 && WS_WQKV % 256 == 0 && WS_WO % 256 == 0 && WS_H % 256 == 0 && WS_ACT % 256 == 0, "alignment");

constexpr int CW_TMO = 0;
constexpr int CW_BAR = 4096;
constexpr int CW_Q = 200000;
constexpr int CW_KMAX = 65536;

constexpr int RING_OFF = 0, RING_BYTES = 131072;
constexpr int LDS_BYTES = 147456;
constexpr int RST_OFF = RING_BYTES;
constexpr int MISC_OFF = LDS_BYTES - 256;

#define GAS __attribute__((address_space(1)))
#define LAS __attribute__((address_space(3)))
typedef unsigned short bf16;
typedef unsigned v4u __attribute__((ext_vector_type(4)));
typedef unsigned v2u __attribute__((ext_vector_type(2)));
typedef float f32x4 __attribute__((ext_vector_type(4)));
typedef float f32x16 __attribute__((ext_vector_type(16)));
typedef short bf16x8 __attribute__((ext_vector_type(8)));
typedef short s16x4 __attribute__((ext_vector_type(4)));
typedef __bf16 bf16x2h __attribute__((ext_vector_type(2)));
typedef GAS unsigned gu32;
#define RLX_AGENT __ATOMIC_RELAXED, __HIP_MEMORY_SCOPE_AGENT
#define LDS_WAIT() asm volatile("s_waitcnt lgkmcnt(0)" ::: "memory")
#define VM_WAIT() asm volatile("s_waitcnt vmcnt(0)" ::: "memory")
__device__ __forceinline__ unsigned cvtpk(float lo, float hi) { return pg8::cvt_pk_bf16(lo, hi); }

#define XB_TMO      128
#define XB_XCNT(j)  (256  + 64 * (j))
#define XB_XSUB(j)  (1280 + 64 * (j))
#define XB_XGEN(j)  (2304 + 64 * (j))
#define XB_TOP      3328
#define XB_TOPGEN   3392
#define XCD_BAR_WORDS 3456
#define XB_SPIN_CAP (1u << 18)
__device__ __forceinline__ unsigned xb_ld(unsigned* p)              { return __hip_atomic_load(p, __ATOMIC_RELAXED, __HIP_MEMORY_SCOPE_AGENT); }
__device__ __forceinline__ unsigned xb_add(unsigned* p, unsigned v) { return __hip_atomic_fetch_add(p, v, __ATOMIC_RELAXED, __HIP_MEMORY_SCOPE_AGENT); }
__device__ __forceinline__ unsigned xb_xcc_id() { return (unsigned)__builtin_amdgcn_s_getreg((3 << 11) | 20) & 0xFu; }
#define XB_SPIN(cond, bar) do { unsigned _sp = 0; while (cond) { __builtin_amdgcn_s_sleep(1); \
    if ((++_sp & 255u) == 0u) { if (xb_ld(&(bar)[XB_TMO])) break; if (_sp > XB_SPIN_CAP) { atomicAdd(&(bar)[XB_TMO], 1u); break; } } } } while (0)
struct XcdBarrier { unsigned* bar; unsigned x; volatile LAS unsigned* st; unsigned gsize; };
__device__ __forceinline__ XcdBarrier xcd_barrier_post(unsigned* bar, volatile LAS unsigned* st, unsigned gsize) {
    XcdBarrier b; b.bar = bar; b.x = xb_xcc_id(); b.st = st; b.gsize = gsize;
    if (threadIdx.x == 0) (void)xb_add(&bar[XB_XCNT(b.x)], 1u);
    return b;
}
__device__ __forceinline__ void xcd_barrier_complete(unsigned* bar, unsigned x, unsigned G, unsigned& nloc, unsigned& nx) {
    unsigned sum, cnt, mine, sp = 0u;
    for (;;) {
        sum = 0u; cnt = 0u; mine = 0u;
#pragma unroll
        for (unsigned j = 0; j < 16; ++j) { const unsigned c = xb_ld(&bar[XB_XCNT(j)]); sum += c; cnt += (c > 0u) ? 1u : 0u; mine = (j == x) ? c : mine; }
        if (sum == G) break;
        __builtin_amdgcn_s_sleep(1);
        if ((++sp & 255u) == 0u) { if (xb_ld(&bar[XB_TMO])) break; if (sp > XB_SPIN_CAP) { atomicAdd(&bar[XB_TMO], 1u); break; } }
    }
    nloc = mine > 0u ? mine : 1u; nx = cnt > 0u ? cnt : 1u;
}
__device__ __forceinline__ void xcd_barrier(const XcdBarrier& b) {
    asm volatile("s_waitcnt vmcnt(0)" ::: "memory");
    __syncthreads();
    if (threadIdx.x == 0) {
        unsigned* bar = b.bar;
        __builtin_amdgcn_s_waitcnt(0);
        unsigned nloc = b.st[0], nx = b.st[1];
        if (nloc == 0u) { xcd_barrier_complete(bar, b.x, b.gsize, nloc, nx); b.st[0] = nloc; b.st[1] = nx; }
        const unsigned old = xb_add(&bar[XB_XSUB(b.x)], 1u);
        const unsigned gen = old / nloc;
        if (old + 1u == (gen + 1u) * nloc) {
            __builtin_amdgcn_fence(__ATOMIC_RELEASE, "agent");
            asm volatile("s_waitcnt vmcnt(0)" ::: "memory");
            const unsigned og = xb_add(&bar[XB_TOP], 1u);
            const unsigned tg = og / nx;
            if (og + 1u == (tg + 1u) * nx) xb_add(&bar[XB_TOPGEN], 1u);
            else XB_SPIN(xb_ld(&bar[XB_TOPGEN]) == tg, bar);
            __builtin_amdgcn_fence(__ATOMIC_ACQUIRE, "agent");
            xb_add(&bar[XB_XGEN(b.x)], 1u);
            asm volatile("s_waitcnt vmcnt(0)" ::: "memory");
        } else {
            XB_SPIN(xb_ld(&bar[XB_XGEN(b.x)]) == gen, bar);
            __builtin_amdgcn_fence(__ATOMIC_ACQUIRE, "agent");
            asm volatile("s_waitcnt vmcnt(0)" ::: "memory");
        }
    }
    __syncthreads();
}

__device__ __forceinline__ void xcd_barrier_light(const XcdBarrier& b) {
    asm volatile("s_waitcnt vmcnt(0)" ::: "memory");
    __syncthreads();
    if (threadIdx.x == 0) {
        unsigned* bar = b.bar; const unsigned nloc = b.gsize;
        const unsigned old = xb_add(&bar[XB_XSUB(b.x)], 1u);
        const unsigned gen = old / nloc;
        if (old + 1u == (gen + 1u) * nloc) (void)xb_add(&bar[XB_XGEN(b.x)], 1u);
        else XB_SPIN(xb_ld(&bar[XB_XGEN(b.x)]) == gen, bar);
        asm volatile("s_waitcnt vmcnt(0)\n\tbuffer_inv sc0" ::: "memory");
    }
    __syncthreads();
}

__device__ __forceinline__ int opaque_tid() { int t = threadIdx.x; asm volatile("" : "+v"(t)); return t; }
__device__ __forceinline__ float wave_sum(float v) {
#pragma unroll
    for (int o = 1; o < 64; o <<= 1) v += __shfl_xor(v, o);
    return v;
}

__device__ __forceinline__ void transpose_item(const float* __restrict__ W, int ldw, int Kdim, bf16* __restrict__ WT, int k0, int n0, int drow0, const float* __restrict__ gk, LAS float* scr, int lane) {
    const int nl = (lane & 15) * 4, kl = lane >> 4;
    f32x4 v[16];
#pragma unroll
    for (int i = 0; i < 16; ++i) v[i] = *(const GAS f32x4*)(W + (size_t)(k0 + 4 * i + kl) * ldw + n0 + nl);
#pragma unroll
    for (int i = 0; i < 16; ++i) { const float gg = gk ? gk[k0 + 4 * i + kl] : 1.0f; LAS float* s = scr + (4 * i + kl) * 65 + nl; s[0] = v[i].x * gg; s[1] = v[i].y * gg; s[2] = v[i].z * gg; s[3] = v[i].w * gg; }
    LDS_WAIT(); asm volatile("" ::: "memory");
    const int c = lane & 7;
#pragma unroll
    for (int j = 0; j < 8; ++j) { const int n = (lane >> 3) + 8 * j; const LAS float* s = scr + (8 * c) * 65 + n;
        v4u o; o.x = cvtpk(s[0 * 65], s[1 * 65]); o.y = cvtpk(s[2 * 65], s[3 * 65]); o.z = cvtpk(s[4 * 65], s[5 * 65]); o.w = cvtpk(s[6 * 65], s[7 * 65]);
        *(GAS v4u*)(WT + (size_t)(drow0 + n) * Kdim + k0 + 8 * c) = o; }
    LDS_WAIT(); asm volatile("" ::: "memory");
}

namespace att {
constexpr int D = 128, NW = 8, QBLK = 32, KVBLK = 64, QB = 256;
constexpr int SHM_K = KVBLK * D * 2, SHM_V = KVBLK * D * 2;
constexpr int L_V = 0, L_K = 2 * SHM_V, L_WS = L_K + 2 * SHM_K, L_TAB = L_WS + NW * 64 * 4, L_SCAN = L_TAB + 2304 * 4, L_FLAG = L_SCAN + 64, L_END = L_FLAG + 64;
constexpr int TAB_N = 2304;
constexpr int QPITCH = NQKV, OPITCH = DM;
constexpr float SCALE = 0.08838834764831845f;
constexpr float C2 = 1.4426950408889634f * SCALE;
constexpr float THR = 8.f;

#define KSWZ(row, colB) ((row) * 256 + ((colB) ^ (((row) & 7) << 4)))
#define SBAR() __builtin_amdgcn_sched_barrier(0)
__device__ __forceinline__ int v_st(int k, int c) { const int kk = (k & ~0xC) | ((k & 4) << 1) | ((k & 8) >> 1); return ((kk >> 3) * 4 + (c >> 5)) * 512 + ((kk & 7) * 32 + (c & 31)) * 2; }
__device__ __forceinline__ int v_rd_base(int lane) { return ((lane & 3) << 3) | (((lane >> 2) & 3) << 6) | (((lane >> 4) & 1) << 5) | (((lane >> 5) & 1) << 8); }
constexpr int v_rd_off(int d0, int ks, int half) { return d0 * 512 + ks * 4096 + half * 2048; }
__device__ __forceinline__ int crow(int r, int hi) { return (r & 3) + 8 * (r >> 2) + 4 * hi; }

template <bool STRICT>
__device__ __forceinline__ void mask_tile(f32x16& p0, f32x16& p1, int dq) {
    const float NEG = -__builtin_inff();
    const int lim = STRICT ? 1 : 0;
#pragma unroll
    for (int r = 0; r < 16; ++r) {
        const int c = (r & 3) + 8 * (r >> 2);
        if (dq - c < lim) p0[r] = NEG;
        if (dq - c - 32 < lim) p1[r] = NEG;
    }
}
__device__ __forceinline__ void partialSM(f32x16& p0, f32x16& p1, float& m_reg, float& mn, float& alpha) {
    float pmax = p0[0];
#pragma unroll
    for (int r = 1; r < 16; ++r) pmax = fmaxf(pmax, p0[r]);
#pragma unroll
    for (int r = 0; r < 16; ++r) pmax = fmaxf(pmax, p1[r]);
    { auto rr = __builtin_amdgcn_permlane32_swap(__float_as_uint(pmax), __float_as_uint(pmax), false, false);
      pmax = fmaxf(__uint_as_float(rr[0]), __uint_as_float(rr[1])); }
    if (__builtin_expect(__all((pmax - m_reg) * SCALE <= THR), 1)) { mn = m_reg; alpha = 1.f; }
    else { mn = fmaxf(m_reg, pmax); alpha = __builtin_amdgcn_exp2f((m_reg - mn) * C2); m_reg = mn; }
    const float mnL = -mn * C2;
#pragma unroll
    for (int r = 0; r < 16; ++r) p0[r] = fmaf(p0[r], C2, mnL);
#pragma unroll
    for (int r = 0; r < 16; ++r) p1[r] = fmaf(p1[r], C2, mnL);
#pragma unroll
    for (int r = 0; r < 16; ++r) p0[r] = __builtin_amdgcn_exp2f(p0[r]);
}
#define PK4(P, B_, OUT) do { unsigned a0 = cvtpk(P[B_+0], P[B_+1]), a1 = cvtpk(P[B_+2], P[B_+3]);                          \
        unsigned b0 = cvtpk(P[B_+4], P[B_+5]), b1 = cvtpk(P[B_+6], P[B_+7]);                                             \
        auto r0 = __builtin_amdgcn_permlane32_swap(a0, b0, false, false); auto r1 = __builtin_amdgcn_permlane32_swap(a1, b1, false, false); \
        v4u w = {r0[0], r1[0], r0[1], r1[1]}; OUT = __builtin_bit_cast(bf16x8, w); } while (0)
__device__ __forceinline__ void finishSM(f32x16& p0, f32x16& p1, float alpha, float& l_reg, bf16x8& pa0, bf16x8& pa1, bf16x8& pa2, bf16x8& pa3) {
#pragma unroll
    for (int r = 0; r < 16; ++r) p1[r] = __builtin_amdgcn_exp2f(p1[r]);
    float ps = 0;
#pragma unroll
    for (int r = 0; r < 16; ++r) ps += p0[r];
#pragma unroll
    for (int r = 0; r < 16; ++r) ps += p1[r];
    { auto rr = __builtin_amdgcn_permlane32_swap(__float_as_uint(ps), __float_as_uint(ps), false, false);
      ps = __uint_as_float(rr[0]) + __uint_as_float(rr[1]); }
    l_reg = l_reg * alpha + ps;
    PK4(p0, 0, pa0); PK4(p0, 8, pa1); PK4(p1, 0, pa2); PK4(p1, 8, pa3);
}
template <int KB>
__device__ __forceinline__ void qkt(f32x16& p0, f32x16& p1, const LAS char* K_lds, int r32, int hi, const bf16x8* qr) {
    const LAS char* kb[4];
#pragma unroll
    for (int dd = 0; dd < 4; ++dd) kb[dd] = K_lds + KB * SHM_K + KSWZ(r32, (dd * 16 + hi * 8) * 2);
#pragma unroll
    for (int d0 = 0; d0 < 8; ++d0) { const LAS char* a = kb[d0 & 3] + (d0 >> 2) * 128;
        bf16x8 b0 = *reinterpret_cast<const LAS bf16x8*>(a);
        bf16x8 b1 = *reinterpret_cast<const LAS bf16x8*>(a + 32 * 256);
        p0 = __builtin_amdgcn_mfma_f32_32x32x16_bf16(b0, qr[d0], p0, 0, 0, 0);
        p1 = __builtin_amdgcn_mfma_f32_32x32x16_bf16(b1, qr[d0], p1, 0, 0, 0); }
}
template <int VB>
__device__ __forceinline__ void pv_tile(f32x16* o, int vb0, bf16x8 pa0, bf16x8 pa1, bf16x8 pa2, bf16x8 pa3) {
#define TRRD(dst, off) asm volatile("ds_read_b64_tr_b16 %0, %1 offset:%2" : "=&v"(dst) : "v"(vb0), "i"(off) : "memory")
#define PV_D0(d0) do { s16x4 l0, l1, l2, l3, h0, h1, h2, h3; constexpr int b_ = VB * SHM_V + v_rd_off(d0, 0, 0); \
        TRRD(l0, b_); TRRD(h0, b_ + 2048); TRRD(l1, b_ + 4096); TRRD(h1, b_ + 6144); TRRD(l2, b_ + 8192); TRRD(h2, b_ + 10240); TRRD(l3, b_ + 12288); TRRD(h3, b_ + 14336); \
        asm volatile("s_waitcnt lgkmcnt(0)" ::: "memory"); SBAR();   \
        o[d0] = __builtin_amdgcn_mfma_f32_32x32x16_bf16(pa0, (bf16x8){l0[0], l0[1], l0[2], l0[3], h0[0], h0[1], h0[2], h0[3]}, o[d0], 0, 0, 0);   \
        o[d0] = __builtin_amdgcn_mfma_f32_32x32x16_bf16(pa1, (bf16x8){l1[0], l1[1], l1[2], l1[3], h1[0], h1[1], h1[2], h1[3]}, o[d0], 0, 0, 0);   \
        o[d0] = __builtin_amdgcn_mfma_f32_32x32x16_bf16(pa2, (bf16x8){l2[0], l2[1], l2[2], l2[3], h2[0], h2[1], h2[2], h2[3]}, o[d0], 0, 0, 0);   \
        o[d0] = __builtin_amdgcn_mfma_f32_32x32x16_bf16(pa3, (bf16x8){l3[0], l3[1], l3[2], l3[3], h3[0], h3[1], h3[2], h3[3]}, o[d0], 0, 0, 0); } while (0)
    PV_D0(0); PV_D0(1); PV_D0(2); PV_D0(3);
#undef PV_D0
#undef TRRD
}
__device__ __forceinline__ float suffix32(const f32x16& x, f32x16& aft, float base, int hi) {
    float c0[4], c1[4];
#pragma unroll
    for (int g = 0; g < 4; ++g) { const float c = (x[4 * g] + x[4 * g + 1]) + (x[4 * g + 2] + x[4 * g + 3]);
        auto rr = __builtin_amdgcn_permlane32_swap(__float_as_uint(c), __float_as_uint(c), false, false);
        c0[g] = __uint_as_float(rr[0]); c1[g] = __uint_as_float(rr[1]); }
    float s = base;
#pragma unroll
    for (int g = 3; g >= 0; --g) { const float sx1 = s; s += c1[g]; const float sx0 = s; s += c0[g];
        const float sx = hi ? sx1 : sx0;
        aft[4 * g + 3] = sx; aft[4 * g + 2] = aft[4 * g + 3] + x[4 * g + 3]; aft[4 * g + 1] = aft[4 * g + 2] + x[4 * g + 2]; aft[4 * g] = aft[4 * g + 1] + x[4 * g + 1]; }
    return s;
}

template <int MODE, int KVB>
__device__ __forceinline__ void attn_tile(f32x16* o, float& m_reg, float& l_reg, float& R, const bf16x8* qr, const LAS char* K_lds, int vb0, const LAS float* tab, LAS float* al_l,
                                          int kb, int qlo, int qm, int tl, int r32, int hi) {
    f32x16 p0, p1; bf16x8 pa0, pa1, pa2, pa3;
    if (MODE == 0) {
        const LAS float* tp = tab + (tl + kb);
#pragma unroll
        for (int r = 0; r < 16; ++r) { const int c = (r & 3) + 8 * (r >> 2); p0[r] = tp[c]; p1[r] = tp[c + 32]; }
    } else {
#pragma unroll
        for (int r = 0; r < 16; ++r) { p0[r] = 0.f; p1[r] = 0.f; }
    }
    qkt<KVB>(p0, p1, K_lds, r32, hi, qr);
    if (MODE == 0) {
        if (kb + KVBLK - 1 > qlo) mask_tile<false>(p0, p1, qm - kb);
        float mn, alpha;
        partialSM(p0, p1, m_reg, mn, alpha);
        if (__any(alpha < 1.f)) { if (hi == 0) al_l[r32] = alpha; LDS_WAIT();
#pragma unroll
            for (int d_ = 0; d_ < 4; ++d_)
#pragma unroll
                for (int r = 0; r < 16; ++r) o[d_][r] *= al_l[crow(r, hi)]; }
        finishSM(p0, p1, alpha, l_reg, pa0, pa1, pa2, pa3);
    } else {
        f32x16 x0, x1;
#pragma unroll
        for (int r = 0; r < 16; ++r) { const float y = p0[r] * C2; const float L = __builtin_amdgcn_logf(1.0f + __builtin_amdgcn_exp2f(-fabsf(y))); const float lb = fminf(y, 0.f) - L; p0[r] = lb; x0[r] = lb - y; }
#pragma unroll
        for (int r = 0; r < 16; ++r) { const float y = p1[r] * C2; const float L = __builtin_amdgcn_logf(1.0f + __builtin_amdgcn_exp2f(-fabsf(y))); const float lb = fminf(y, 0.f) - L; p1[r] = lb; x1[r] = lb - y; }
        if (kb + KVBLK - 1 >= qlo) {
            const int dq = qm - kb; const float NEG = -__builtin_inff();
#pragma unroll
            for (int r = 0; r < 16; ++r) { const int c = (r & 3) + 8 * (r >> 2);
                if (dq - c < 1) { p0[r] = NEG; x0[r] = 0.f; }
                if (dq - c - 32 < 1) { p1[r] = NEG; x1[r] = 0.f; } }
        }
        f32x16 a0, a1;
        const float s1 = suffix32(x1, a1, R, hi);
        const float s0 = suffix32(x0, a0, s1, hi);
        R = s0;
#pragma unroll
        for (int r = 0; r < 16; ++r) { p0[r] = __builtin_amdgcn_exp2f(p0[r] + a0[r]); p1[r] = __builtin_amdgcn_exp2f(p1[r] + a1[r]); }
        PK4(p0, 0, pa0); PK4(p0, 8, pa1); PK4(p1, 0, pa2); PK4(p1, 8, pa3);
    }
    SBAR();
    pv_tile<KVB>(o, vb0, pa0, pa1, pa2, pa3);
}
template <int MODE>
__device__ __forceinline__ void attn_block(const bf16* __restrict__ Qb, const bf16* __restrict__ Kh, const bf16* __restrict__ Vh, bf16* __restrict__ Ob, int P0, LAS char* lds, int toff_mul, int toff_add, float kmax, int kcov) {
    int tid = threadIdx.x; asm volatile("" : "+v"(tid));
    const int wid = __builtin_amdgcn_readfirstlane(tid >> 6), lane = tid & 63, r32 = lane & 31, hi = lane >> 5;
    LAS char* V_lds = lds + L_V; LAS char* K_lds = lds + L_K;
    LAS float* wsf = (LAS float*)(lds + L_WS) + wid * 64; LAS float* li_l = wsf; LAS float* al_l = wsf + 32;
    const LAS float* tab = (const LAS float*)(lds + L_TAB);
    volatile LAS unsigned* flags = (volatile LAS unsigned*)(lds + L_FLAG);
    bf16x8 qr[8];
    { const bf16* qrow = Qb + (size_t)(wid * QBLK + r32) * QPITCH + hi * 8;
#pragma unroll
      for (int d0 = 0; d0 < 8; ++d0) qr[d0] = *(const GAS bf16x8*)(qrow + d0 * 16); }
    const int qlo = P0 + wid * QBLK, qpos = qlo + r32, qm = qpos - 4 * hi;
    const int NT = P0 / KVBLK + 4;
    float qn = 0.f;
    if (MODE == 0) {
#pragma unroll
        for (int d0 = 0; d0 < 8; ++d0)
#pragma unroll
            for (int e = 0; e < 8; ++e) { const float qv = __uint_as_float(((unsigned)(unsigned short)qr[d0][e]) << 16); qn += qv * qv; }
        { auto rr = __builtin_amdgcn_permlane32_swap(__float_as_uint(qn), __float_as_uint(qn), false, false); qn = __uint_as_float(rr[0]) + __uint_as_float(rr[1]); }
        qn = sqrtf(qn) * 1.002f;
    }
    const int sr = tid >> 4, sc = (tid & 15) * 8;
    const int kws = KSWZ(sr, sc * 2), vst0 = v_st(sr, sc), vst1 = v_st(32 + sr, sc);
    const int vb0 = (int)(unsigned)(uintptr_t)V_lds + v_rd_base(lane);
    const int tl = toff_mul * qpos + toff_add + 4 * hi;
    float m_reg = -1e30f, l_reg = 0.f, R = 0.f;
    f32x16 o[4];
#pragma unroll
    for (int d = 0; d < 4; ++d)
#pragma unroll
        for (int r = 0; r < 16; ++r) o[d][r] = 0.f;
    bf16x8 sk0, sk1, sv0, sv1;
#define KB_OF(it_) ((NT - 1 - (it_)) * KVBLK)
#define ST_LOAD(kb_) do { const bf16* kp = Kh + (size_t)((kb_) + sr) * QPITCH + sc; const bf16* vp = Vh + (size_t)((kb_) + sr) * QPITCH + sc; \
        sk0 = *(const GAS bf16x8*)kp; sk1 = *(const GAS bf16x8*)(kp + (size_t)32 * QPITCH); sv0 = *(const GAS bf16x8*)vp; sv1 = *(const GAS bf16x8*)(vp + (size_t)32 * QPITCH); } while (0)
#define ST_WRITE(bf_) do { *(LAS bf16x8*)(K_lds + (bf_) * SHM_K + kws) = sk0; *(LAS bf16x8*)(K_lds + (bf_) * SHM_K + kws + 32 * 256) = sk1; \
        *(LAS bf16x8*)(V_lds + (bf_) * SHM_V + vst0) = sv0; *(LAS bf16x8*)(V_lds + (bf_) * SHM_V + vst1) = sv1; } while (0)
    __syncthreads();
    ST_LOAD(KB_OF(0)); ST_WRITE(0);
    if (tid < 16) flags[tid] = 0u;
    __syncthreads();
    bool stop = false, wdone = false;
#define STEP(it_, B_, NB_) { const int kb = KB_OF(it_); const bool more = (it_) + 1 < NT; \
        if (more) ST_LOAD(KB_OF((it_) + 1)); \
        if (kb <= qlo + QBLK - 1 && !wdone) attn_tile<MODE, B_>(o, m_reg, l_reg, R, qr, K_lds, vb0, tab, al_l, kb, qlo, qm, tl, r32, hi); \
        if (more) ST_WRITE(NB_); \
        if (MODE == 1) { wdone = (kb <= qlo + QBLK - 1) && __all(R <= -160.f); if (lane == 0) flags[((it_) & 1) * 8 + wid] = wdone ? 1u : 0u; } \
        if (MODE == 0) {   \
            wdone = (kmax > 0.f) && (kb <= qlo + QBLK - 1) && kb > 0 && kb <= kcov && __all((qn * kmax + tab[kb - 1] - m_reg) * C2 < -152.f); if (lane == 0) flags[((it_) & 1) * 8 + wid] = wdone ? 1u : 0u; } \
        __syncthreads(); \
        { unsigned a_ = 1u; _Pragma("unroll") for (int w_ = 0; w_ < 8; ++w_) a_ &= flags[((it_) & 1) * 8 + w_]; stop = (a_ != 0u); } }
    for (int it = 0; it < NT; it += 2) {
        STEP(it, 0, 1)
        if (stop) break;
        STEP(it + 1, 1, 0)
        if (stop) break;
    }
#undef STEP
#undef ST_LOAD
#undef ST_WRITE
#undef KB_OF
    float rli[16];
    if (MODE == 0) {
        if (hi == 0) li_l[r32] = l_reg; LDS_WAIT();
#pragma unroll
        for (int r = 0; r < 16; ++r) rli[r] = __builtin_amdgcn_rcpf(li_l[crow(r, hi)]);
    } else {
#pragma unroll
        for (int r = 0; r < 16; ++r) rli[r] = 1.f;
    }
    bf16* Ow = Ob + (size_t)(wid * QBLK) * OPITCH;
#pragma unroll
    for (int r = 0; r < 16; ++r) { const int orow = crow(r, hi);
#pragma unroll
        for (int d0 = 0; d0 < 4; ++d0) { const float v = o[d0][r] * rli[r];
            const float vn = __shfl_xor(v, 1);
            if ((r32 & 1) == 0) *(GAS unsigned*)(Ow + (size_t)orow * OPITCH + d0 * 32 + r32) = cvtpk(v, vn); } }
}
#undef PK4
}

__device__ __forceinline__ int t5_bucket(int d) {
    if (d < 16) return d;
    int b = 16;
    b += (d >= 22); b += (d >= 30); b += (d >= 40); b += (d >= 54); b += (d >= 73); b += (d >= 99); b += (d >= 134); b += (d >= 182);
    b += (d >= 246); b += (d >= 332); b += (d >= 450); b += (d >= 609); b += (d >= 825); b += (d >= 1117); b += (d >= 1513);
    return b;
}

struct Args {
    const float* x; const float* norm_g; const float* w_gate; const float* w_up; const float* w_down;
    const float* w_in[4]; const float* b_f0; const float* b_f3; const float* w_out; const float* rel_bias; const float* final_g;
    float* out; unsigned char* ws; int ph_lo, ph_hi;
};
static_assert(sizeof(Args) == 16 * 8 + 8, "Args has no padding");

__global__ void __launch_bounds__(NWAVES * 64, 2) mk_fwd(Args a) {
    extern __shared__ __attribute__((aligned(16))) unsigned char lds_raw[];
    LAS unsigned char* lds = (LAS unsigned char*)lds_raw;
    volatile LAS unsigned* MISC = (volatile LAS unsigned*)(lds + MISC_OFF);
    const int G = gridDim.x; const int bx = blockIdx.x; const int vcu = (G % 8 == 0) ? (bx % 8) * (G / 8) + bx / 8 : bx;
    unsigned char* ws = a.ws;
    gu32* ctl = (gu32*)(ws + WS_CTL);
    if (threadIdx.x < 64) MISC[threadIdx.x] = 0u;
    __syncthreads();
    const int lo = a.ph_lo, hi = a.ph_hi;
    const int grp = bx & 7, gidx = bx >> 3;
    bool one_xcd = false;
    XcdBarrier bar, barL; bar.bar = (unsigned*)(ctl + CW_BAR); bar.x = 0; bar.st = nullptr; bar.gsize = 0; barL = bar;
    if (hi - lo > 1) { bar = xcd_barrier_post((unsigned*)(ctl + CW_BAR), MISC + 8, (unsigned)G); barL = xcd_barrier_post((unsigned*)(ctl + CW_BAR) + (1 + grp) * XCD_BAR_WORDS, MISC + 10, (unsigned)(G / 8)); }
#define RUN(k) (lo <= (k) && (k) < hi)
#define SEAM(k) do { if (RUN(k) && RUN((k) + 1)) { if ((k) == 0) xcd_barrier(bar); else if (one_xcd) xcd_barrier_light(barL); else xcd_barrier(barL); if (PROBE_DUP == 9) xcd_barrier(barL); } } while (0)

    bf16* const Hb = (bf16*)(ws + WS_H); bf16* const AO = (bf16*)(ws + WS_AO);
    bf16* const ACT = (bf16*)(ws + WS_ACT + (size_t)(bx & 7) * ((size_t)SEQ * (NQKV - FF) * 2)); bf16* const QKV = (bf16*)(ws + WS_ACT);
    float* const LF = (float*)(ws + WS_LF);
    const int NGW = G * NWAVES;
    int ph = 0;
#define LANE_IDS() const int tid = opaque_tid(), lane = tid & 63, wave = __builtin_amdgcn_readfirstlane(tid >> 6), gw = vcu * NWAVES + wave; (void)lane; (void)gw

    constexpr int I_G = (DM / 64) * (FF / 64), I_D = (FF / 64) * (DM / 64), I_Q = (DM / 64) * (NQKV / 64), I_O = (DM / 64) * (DM / 64);
    constexpr int PER_LAYER = 6 * I_G + I_Q + I_O;
    static_assert(I_G == I_D && PER_LAYER % 8 == 0 && I_G % 8 == 0 && I_Q % 8 == 0 && I_O % 8 == 0, "items");
    auto conv_item = [&](int it, LAS float* scr, int lane) __attribute__((always_inline)) {
            const int l = it / PER_LAYER; int r = it - l * PER_LAYER;
            if (r < 6 * I_G) {
                const int mm = r / I_G, idx = r - mm * I_G, kind = mm >> 1, f = mm & 1;
                if (kind < 2) {
                    const float* W = (kind == 0 ? a.w_gate : a.w_up) + (size_t)(l * 2 + f) * DM * FF;
                    const int nblk = FF / 64, kb = idx / nblk, nb = idx - kb * nblk, n0 = nb * 64;
                    transpose_item(W, FF, DM, (bf16*)(ws + WS_WGU + (size_t)(l * 2 + f) * SZ_WGU), kb * 64, n0, (n0 >> 7) * 256 + (n0 & 127) + kind * 128, a.norm_g + (size_t)(l * 3 + 2 * f) * DM, scr, lane);
                } else {
                    const float* W = a.w_down + (size_t)(l * 2 + f) * FF * DM;
                    const int nblk = DM / 64, kb = idx / nblk, nb = idx - kb * nblk;
                    transpose_item(W, DM, FF, (bf16*)(ws + WS_WD + (size_t)(l * 2 + f) * SZ_WD), kb * 64, nb * 64, nb * 64, nullptr, scr, lane);
                }
            } else { r -= 6 * I_G;
                if (r < I_Q) {
                    const float* W = a.w_in[l]; const int ldw = (l == 0 || l == 3) ? NQKV + NH : NQKV;
                    const int nblk = NQKV / 64, kb = r / nblk, nb = r - kb * nblk;
                    transpose_item(W, ldw, DM, (bf16*)(ws + WS_WQKV + (size_t)l * SZ_WQKV), kb * 64, nb * 64, nb * 64, a.norm_g + (size_t)(l * 3 + 1) * DM, scr, lane);
                } else { r -= I_Q;
                    const float* W = a.w_out + (size_t)l * DM * DM;
                    const int nblk = DM / 64, kb = r / nblk, nb = r - kb * nblk;
                    transpose_item(W, DM, DM, (bf16*)(ws + WS_WO + (size_t)l * SZ_WO), kb * 64, nb * 64, nb * 64, nullptr, scr, lane);
                }
            }
    };
    const int n_static = (hi - lo > 1) ? (DEPTH - 1) * PER_LAYER : DEPTH * PER_LAYER;
    if (RUN(ph)) REP(1) {
        LANE_IDS();
        LAS float* scr = (LAS float*)(lds + wave * 16640);
        for (int it = gw; it < n_static; it += NGW) conv_item(it, scr, lane);
    }
    if (RUN(ph)) REP(1) {
        LANE_IDS();
        for (int idx = bx * (NWAVES * 64) + tid; idx < 2 * 16 * DM; idx += G * NWAVES * 64) {
            const int sl = idx >> 15, n = (idx >> 11) & 15, k = idx & (DM - 1), l = sl ? 3 : 0;
            const float w = a.w_in[l][(size_t)k * (NQKV + NH) + NQKV + n] * a.norm_g[(size_t)(l * 3 + 1) * DM + k];
            ((bf16*)(ws + WS_WF))[idx] = (bf16)(cvtpk(w, 0.f) & 0xffffu);
        }
        float* const part = (float*)(ws + WS_PART);
        for (int m = gw; m < M; m += NGW) {
            const GAS f32x4* xr = (const GAS f32x4*)(a.x + (size_t)m * DM) + lane;
            f32x4 v[8]; float ss = 0.f;
#pragma unroll
            for (int j = 0; j < 8; ++j) { v[j] = xr[64 * j]; ss += (v[j].x * v[j].x + v[j].y * v[j].y) + (v[j].z * v[j].z + v[j].w * v[j].w); }
            ss = wave_sum(ss);
            GAS v2u* o8 = (GAS v2u*)(Hb + (size_t)m * DM) + lane;
#pragma unroll
            for (int j = 0; j < 8; ++j) { v2u w; w.x = cvtpk(v[j].x, v[j].y); w.y = cvtpk(v[j].z, v[j].w); o8[64 * j] = w; }
            if (lane < 32) part[(size_t)m * 32 + lane] = (lane == 0) ? ss : 0.f;
        }
    }
    SEAM(ph); ++ph;
    if (hi - lo > 1) {
        if (threadIdx.x == 0 && barL.st[0] == 0u) { unsigned nloc, nx; xcd_barrier_complete(barL.bar, barL.x, barL.gsize, nloc, nx); barL.st[0] = nloc; barL.st[1] = nx; }
        __syncthreads();
        one_xcd = (barL.st[1] == 1u) && (barL.st[0] == barL.gsize);
    }

    for (int sb = 0; sb < 3 * DEPTH; ++sb) {
        const int l = sb / 3, ty = sb - 3 * l;
        if (hi - lo > 1 && (sb == 3 * (DEPTH - 1) || sb == 3 * DEPTH - 1)) {
            LANE_IDS();
            LAS float* scr = (LAS float*)(lds + wave * 16640);
            volatile LAS unsigned* qslot = MISC + 16;
            const int qB = (sb == 3 * DEPTH - 1) ? 1 : 0;
            const unsigned qn = qB ? 3u * I_G : 3u * I_G + I_Q + I_O;
            unsigned* qctr = (unsigned*)ctl + CW_Q + qB * 128; unsigned* dctr = qctr + 64;
            unsigned mine = 0u;
            for (;;) {
                __syncthreads();
                if (tid == 0) *qslot = xb_add(qctr, 8u);
                __syncthreads();
                const unsigned base = *qslot;
                if (base >= qn) break;
                const unsigned q = base + (unsigned)wave, seg = q / (unsigned)I_G;
                const unsigned r = qB ? (2u * seg + 1u) * I_G + (q - seg * I_G) : (seg < 3u ? 2u * seg * I_G + (q - seg * I_G) : 6u * I_G + (q - 3u * I_G));
                conv_item((DEPTH - 1) * PER_LAYER + (int)r, scr, lane);
                mine += 8u;
            }
            asm volatile("s_waitcnt vmcnt(0)" ::: "memory");
            __syncthreads();
            if (tid == 0) {
                if (mine) { __builtin_amdgcn_fence(__ATOMIC_RELEASE, "agent"); asm volatile("s_waitcnt vmcnt(0)" ::: "memory"); (void)xb_add(dctr, mine); }
                XB_SPIN(xb_ld(dctr) < qn, (unsigned*)(ctl + CW_BAR));
                __builtin_amdgcn_fence(__ATOMIC_ACQUIRE, "agent");
                asm volatile("s_waitcnt vmcnt(0)" ::: "memory");
            }
            __syncthreads();
        }
        const float* xsrc = (sb == 0) ? a.x : (const float*)a.out;
        if (ty != 1) {
            const int f = ty >> 1;
            if (PROBE_DUP == 10 && RUN(ph)) {
                pg8::Gemm g{Hb, (const bf16*)(ws + WS_WGU + (size_t)(l * 2 + f) * SZ_WGU), M, NGU, DM}; pg8::StaticOrder S; S.init(M, NGU, G, bx);
                pg8::Unit u0; S.next(0, u0); pg8::build_rstd_table((LAS float*)(lds + RST_OFF), (const float*)(ws + WS_PART), u0.pm, opaque_tid());
                pg8::EpiSwiGLULocal E{pg8::EpiSwiGLU{(bf16*)(ws + WS_END) + (size_t)bx * 256 * 128, 128, (const float*)(ws + WS_PART), (const LAS float*)(lds + RST_OFF), 0}};
                pg8::gemm_phase<pg8::EpiSwiGLULocal, pg8::StaticOrder, true, true>(lds + RING_OFF, g, S, E);
            }
            if (PROBE_DUP == 8 && RUN(ph)) {
                pg8::Gemm g{Hb, (const bf16*)(ws + WS_WGU + (size_t)(l * 2 + f) * SZ_WGU), M, NGU, DM};
#if PROBE_KL == 3
                pg8::ProbeOrder S; S.init(M, NGU, G, bx);
                pg8::EpiNull E{(float*)(ws + WS_END)};
                pg8::gemm_phase<pg8::EpiNull, pg8::ProbeOrder, true, true>(lds + RING_OFF, g, S, E);
#else
                pg8::StaticOrder S; S.init(M, NGU, G, bx);
                pg8::EpiNull E{(float*)(ws + WS_END)};
                pg8::gemm_phase<pg8::EpiNull, pg8::StaticOrder, true, true>(lds + RING_OFF, g, S, E);
#endif
            }
            if (RUN(ph)) REP(3) {
                pg8::Gemm g{Hb, (const bf16*)(ws + WS_WGU + (size_t)(l * 2 + f) * SZ_WGU), M, NGU, DM}; pg8::StaticOrder S; S.init(M, NGU, G, bx);
                pg8::Unit u0; S.next(0, u0); pg8::build_rstd_table((LAS float*)(lds + RST_OFF), (const float*)(ws + WS_PART), u0.pm, opaque_tid());
                pg8::EpiSwiGLU E{ACT, FF, (const float*)(ws + WS_PART), (const LAS float*)(lds + RST_OFF), u0.pm};
                pg8::gemm_phase<pg8::EpiSwiGLU, pg8::StaticOrder, true, true>(lds + RING_OFF, g, S, E);
            }
            SEAM(ph); ++ph;
            if (RUN(ph)) REP(6) {
                pg8::Gemm g{ACT, (const bf16*)(ws + WS_WD + (size_t)(l * 2 + f) * SZ_WD), M, DM, FF}; pg8::StaticOrder S; S.init(M, DM, G, bx);
#if RESID_BF16
                pg8::EpiResidB E{(PROBE_DUP == 6 && rep_ == 0) ? (bf16*)(ws + WS_END) : Hb, (float*)(ws + WS_PART), DM, 0.5f};
                pg8::gemm_phase<pg8::EpiResidB, pg8::StaticOrder, true, true>(lds + RING_OFF, g, S, E);
#else
                pg8::EpiResid E{xsrc, (PROBE_DUP == 6 && rep_ == 0) ? (float*)(ws + WS_END) : a.out, Hb, (float*)(ws + WS_PART), DM, 0.5f};
                pg8::gemm_phase<pg8::EpiResid, pg8::StaticOrder, true, true>(lds + RING_OFF, g, S, E);
#endif
            }
            SEAM(ph); ++ph;
        } else {
            if (RUN(ph) && (l == 0 || l == 3)) {
                LANE_IDS();
                const int fr = lane & 15, fq = lane >> 4;
                const bf16* wf = (const bf16*)(ws + WS_WF) + (size_t)(l ? 1 : 0) * 16 * DM + (size_t)fr * DM + 8 * fq;
                const float* bfp = (l == 0) ? a.b_f0 : a.b_f3;
                for (int rgl = gidx * NWAVES + wave; rgl < SEQ / 16; rgl += (G / 8) * NWAVES) { const int rg = grp * (SEQ / 16) + rgl;
                    const bf16* ap = Hb + (size_t)(rg * 16 + fr) * DM + 8 * fq;
                    f32x4 acc = {0.f, 0.f, 0.f, 0.f};
#pragma unroll 8
                    for (int k0 = 0; k0 < DM; k0 += 32) { const bf16x8 av = *(const GAS bf16x8*)(ap + k0), bv = *(const GAS bf16x8*)(wf + k0);
                        acc = __builtin_amdgcn_mfma_f32_16x16x32_bf16(bv, av, acc, 0, 0, 0); }
                    const float r = pg8::row_rstd((const float*)(ws + WS_PART), rg * 16 + fr, fq);
                    const f32x4 bb = *(const GAS f32x4*)(bfp + 4 * fq);
                    f32x4 o;
#pragma unroll
                    for (int i = 0; i < 4; ++i) { const float z = acc[i] * r + bb[i]; o[i] = fminf(z, 0.f) - __logf(1.0f + __expf(-fabsf(z))); }
                    *(GAS f32x4*)(LF + (size_t)(rg * 16 + fr) * 16 + 4 * fq) = o;
                }
            }
            if (RUN(ph)) _Pragma("unroll 1") for (int rep_ = 0; rep_ < ((PROBE_DUP == 4 || PROBE_DUP == 13) ? 2 : 1); ++rep_) {
                pg8::Gemm g{Hb, (const bf16*)(ws + WS_WQKV + (size_t)l * SZ_WQKV), M, NQKV, DM}; pg8::StaticOrder S; S.init(M, NQKV, G, bx);
                pg8::Unit u0; S.next(0, u0); pg8::build_rstd_table((LAS float*)(lds + RST_OFF), (const float*)(ws + WS_PART), u0.pm, opaque_tid());
                pg8::EpiBf16 E{(PROBE_DUP == 13 && rep_ == 0) ? (bf16*)(ws + WS_END) + (size_t)bx * 256 * 256 : QKV, (PROBE_DUP == 13 && rep_ == 0) ? 256 : NQKV, (const float*)(ws + WS_PART), (const LAS float*)(lds + RST_OFF), u0.pm, (PROBE_DUP == 13 && rep_ == 0) ? 1 : 0, (l % 3 == 0) ? (unsigned*)ws + CW_KMAX + (l ? 512 : 0) : nullptr};
                pg8::gemm_phase<pg8::EpiBf16, pg8::StaticOrder, true, true>(lds + RING_OFF, g, S, E);
            }
            SEAM(ph); ++ph;
            if (RUN(ph)) REP(5) {
                LANE_IDS();
                const int mixer = l % 3;
                LAS char* al = (LAS char*)(lds + RING_OFF);
                LAS float* tab = (LAS float*)(al + att::L_TAB);
                LAS float* scan = (LAS float*)(al + att::L_SCAN);
                for (int j = gidx; j < NH * 4; j += G / 8) {
                    const int b = grp, h = j >> 2, xq = (j & 32) ? 3 - (j & 3) : (j & 3);
                    const bf16* Qh = QKV + (size_t)b * SEQ * NQKV + h * HD; const bf16* Kh = Qh + DM; const bf16* Vh = Qh + 2 * DM;
                    bf16* Oh = AO + (size_t)b * SEQ * DM + h * HD;
                    __syncthreads();
                    int tmul = 0, tadd = 0;
                    const int kcov = SEQ;
                    if (mixer == 0) {
                        const float* lf = LF + (size_t)b * SEQ * 16 + h;
                        const float v0 = lf[(size_t)(4 * tid) * 16], v1 = lf[(size_t)(4 * tid + 1) * 16], v2 = lf[(size_t)(4 * tid + 2) * 16], v3 = lf[(size_t)(4 * tid + 3) * 16];
                        const float a0 = v0, a1 = a0 + v1, a2 = a1 + v2, a3 = a2 + v3;
                        float inc = a3;
#pragma unroll
                        for (int d = 1; d < 64; d <<= 1) { const float y = __shfl_up(inc, d); if (lane >= d) inc += y; }
                        if (lane == 63) scan[wave] = inc;
                        __syncthreads();
                        float pre = inc - a3;
                        for (int w = 0; w < wave; ++w) pre += scan[w];
                        const float ns = -11.313708498984761f;
                        tab[4 * tid] = (pre + a0) * ns; tab[4 * tid + 1] = (pre + a1) * ns; tab[4 * tid + 2] = (pre + a2) * ns; tab[4 * tid + 3] = (pre + a3) * ns;
                    } else if (mixer == 1) {
                        const float* rb = a.rel_bias + h * 32;
                        for (int j = tid; j < att::TAB_N; j += NWAVES * 64) {
                            const int d = 2047 - j; float v = 0.f;
                            if (d >= 0) { const int mult = (d <= 128 ? 1 : 0) + (((d & 3) == 0 && d <= 512) ? 1 : 0) + (((d & 15) == 0) ? 1 : 0);
                                v = (mult == 0) ? -__builtin_inff() : (rb[t5_bucket(d)] + (mult == 1 ? 0.f : (mult == 2 ? 0.6931471805599453f : 1.0986122886681098f))) * 11.313708498984761f; }
                            tab[j] = v; }
                        tmul = -1; tadd = 2047;
                    }
                    float kmaxh = 0.f;
                    if (mixer == 0) {
                        unsigned* kp = (unsigned*)ws + CW_KMAX + (l ? 512 : 0) + (b * 16 + h) * 4; float k2m = 0.f;
#pragma unroll
                        for (int w = 0; w < 4; ++w) k2m += __uint_as_float(__hip_atomic_load(kp + w, __ATOMIC_RELAXED, __HIP_MEMORY_SCOPE_AGENT));
                        kmaxh = sqrtf(k2m) * 1.002f; }
#pragma unroll 1
                    for (int pass = 0; pass < 2; ++pass) {
                        const int qb = pass ? 7 - xq : xq, P0 = qb * att::QB;
                        if (mixer == 2) att::attn_block<1>(Qh + (size_t)P0 * NQKV, Kh, Vh, Oh + (size_t)P0 * DM, P0, al, 0, 0, 0.f, 0);
                        else att::attn_block<0>(Qh + (size_t)P0 * NQKV, Kh, Vh, Oh + (size_t)P0 * DM, P0, al, tmul, tadd, kmaxh, kcov);
                    }
                }
            }
            SEAM(ph); ++ph;
            if (RUN(ph)) REP(7) {
                pg8::Gemm g{AO, (const bf16*)(ws + WS_WO + (size_t)l * SZ_WO), M, DM, DM}; pg8::StaticOrder S; S.init(M, DM, G, bx);
#if RESID_BF16
                pg8::EpiResidB E{(PROBE_DUP == 7 && rep_ == 0) ? (bf16*)(ws + WS_ACT) : Hb, (float*)(ws + WS_PART), DM, 1.0f};
                pg8::gemm_phase<pg8::EpiResidB, pg8::StaticOrder, true, true>(lds + RING_OFF, g, S, E);
#else
                pg8::EpiResid E{a.out, (PROBE_DUP == 7 && rep_ == 0) ? (float*)(ws + WS_ACT) : a.out, Hb, (float*)(ws + WS_PART), DM, 1.0f};
                pg8::gemm_phase<pg8::EpiResid, pg8::StaticOrder, true, true>(lds + RING_OFF, g, S, E);
#endif
            }
            SEAM(ph); ++ph;
        }
    }
    if (RUN(ph)) {
        LANE_IDS();
        f32x4 gv[8];
#pragma unroll
        for (int j = 0; j < 8; ++j) gv[j] = *((const GAS f32x4*)a.final_g + lane + 64 * j);
#if RESID_BF16
        static_assert(SEQ == 8 * 32 * NWAVES, "8 rows per wave");
#pragma unroll 1
        for (int b4 = 0; b4 < 2; ++b4) {
            v2u w[4][8];
#pragma unroll
            for (int rr = 0; rr < 4; ++rr) { const int m = grp * SEQ + gidx * NWAVES + wave + (G / 8) * NWAVES * (b4 * 4 + rr);
#pragma unroll
                for (int j = 0; j < 8; ++j) w[rr][j] = *((const GAS v2u*)(Hb + (size_t)m * DM) + lane + 64 * j); }
#pragma unroll
            for (int rr = 0; rr < 4; ++rr) { const int m = grp * SEQ + gidx * NWAVES + wave + (G / 8) * NWAVES * (b4 * 4 + rr);
                GAS f32x4* xr = (GAS f32x4*)(a.out + (size_t)m * DM) + lane;
                f32x4 v[8]; float ss = 0.f;
#pragma unroll
                for (int j = 0; j < 8; ++j) { const v2u ww = w[rr][j];
                    v[j] = (f32x4){__uint_as_float(ww.x << 16), __uint_as_float(ww.x & 0xffff0000u), __uint_as_float(ww.y << 16), __uint_as_float(ww.y & 0xffff0000u)};
                    ss += (v[j].x * v[j].x + v[j].y * v[j].y) + (v[j].z * v[j].z + v[j].w * v[j].w); }
                const float rstd = 1.0f / sqrtf(wave_sum(ss) * (1.0f / DM) + RMS_EPS);
#pragma unroll
                for (int j = 0; j < 8; ++j) xr[64 * j] = v[j] * rstd * gv[j];
            }
        }
#else
        for (int ml = gidx * NWAVES + wave; ml < SEQ; ml += (G / 8) * NWAVES) { const int m = grp * SEQ + ml;
            GAS f32x4* xr = (GAS f32x4*)(a.out + (size_t)m * DM) + lane;
            f32x4 v[8]; float ss = 0.f;
#pragma unroll
            for (int j = 0; j < 8; ++j) { v[j] = xr[64 * j]; ss += (v[j].x * v[j].x + v[j].y * v[j].y) + (v[j].z * v[j].z + v[j].w * v[j].w); }
            const float rstd = 1.0f / sqrtf(wave_sum(ss) * (1.0f / DM) + RMS_EPS);
#pragma unroll
            for (int j = 0; j < 8; ++j) xr[64 * j] = v[j] * rstd * gv[j];
        }
#endif
    }
#undef RUN
#undef SEAM
}
constexpr int N_PHASES = 1 + DEPTH * 7 + 1;

extern "C" void kernel_launch(void* const* d_in, const int* in_sizes, int n_in, void* d_out, int out_size, void* d_ws, size_t ws_size, hipStream_t stream) {
    static int grid = 0;
    if (grid == 0) {
        if (n_in != 14 || in_sizes[0] != M * DM || out_size != M * DM || ws_size < WS_END + (PROBE_DUP == 6 ? (size_t)M * DM * 4 : 0) + (PROBE_DUP == 8 ? 4096 : 0) + (PROBE_DUP == 10 ? (size_t)256 * 65536 : 0) + ((PROBE_DUP == 13) ? (size_t)256 * 131072 : 0)) {
            fprintf(stderr, "kernel_launch: unexpected shapes (n_in %d, in0 %d, out %d, ws %zu < %zu?); nothing launched\n", n_in, n_in > 0 ? in_sizes[0] : -1, out_size, ws_size, (size_t)WS_END); grid = -1; return; }
        int dev = 0, cus = 0;
        if (hipGetDevice(&dev) != hipSuccess || hipDeviceGetAttribute(&cus, hipDeviceAttributeMultiprocessorCount, dev) != hipSuccess) { grid = -1; return; }
        if (hipFuncSetAttribute((const void*)mk_fwd, hipFuncAttributeMaxDynamicSharedMemorySize, LDS_BYTES) != hipSuccess) { fprintf(stderr, "kernel_launch: hipFuncSetAttribute failed\n"); grid = -1; return; }
        int per_cu = 0;
        if (hipOccupancyMaxActiveBlocksPerMultiprocessor(&per_cu, (const void*)mk_fwd, NWAVES * 64, LDS_BYTES) != hipSuccess || per_cu < 1)
            fprintf(stderr, "kernel_launch: note: occupancy query reports %d workgroups per CU\n", per_cu);
        (void)hipGetLastError();
        grid = cus;
        if (grid != 256) { fprintf(stderr, "kernel_launch: built for a 256-CU device (8 groups of 32 workgroups own the 8 batch elements); found %d CUs; nothing launched\n", grid); grid = -1; return; }
    }
    if (grid < 0) return;
    if (hipMemsetAsync((char*)d_ws + WS_CTL, 0, CTL_ZERO_BYTES, stream) != hipSuccess) return;
    Args a{};
    a.x = (const float*)d_in[0]; a.norm_g = (const float*)d_in[1]; a.w_gate = (const float*)d_in[2]; a.w_up = (const float*)d_in[3]; a.w_down = (const float*)d_in[4];
    a.w_in[0] = (const float*)d_in[5]; a.b_f0 = (const float*)d_in[6]; a.w_in[1] = (const float*)d_in[7]; a.w_in[2] = (const float*)d_in[8]; a.w_in[3] = (const float*)d_in[9];
    a.b_f3 = (const float*)d_in[10]; a.w_out = (const float*)d_in[11]; a.rel_bias = (const float*)d_in[12]; a.final_g = (const float*)d_in[13];
    a.out = (float*)d_out; a.ws = (unsigned char*)d_ws;
#if MK_ONE_LAUNCH
    a.ph_lo = 0; a.ph_hi = N_PHASES;
    hipLaunchKernelGGL(mk_fwd, dim3(grid), dim3(NWAVES * 64), LDS_BYTES, stream, a);
#else
    for (int p = 0; p < N_PHASES; ++p) { a.ph_lo = p; a.ph_hi = p + 1; hipLaunchKernelGGL(mk_fwd, dim3(grid), dim3(NWAVES * 64), LDS_BYTES, stream, a); }
#endif
    const hipError_t le = hipPeekAtLastError();
    if (le != hipSuccess) fprintf(stderr, "kernel_launch: launch failed: %s\n", hipGetErrorName(le));
}
```
